# Optimizing an MI355X kernel written in HIP

```python
import jax, jax.numpy as jnp
from jax import lax
import numpy as np

D_MODEL = 4096
BATCH = 4
SEQ = 4096
DEPTH = 4
DEC_BATCH = 8
DEC_SEQ = 16
PAST_LEN = 4096

CHUNK = 64
N_META = 16
SSD_EXPAND = 2
D_INNER = SSD_EXPAND * D_MODEL
HEAD_DIM = 64
N_HEADS = D_INNER // HEAD_DIM
N_GROUPS = 8
HEADS_PER_GROUP = N_HEADS // N_GROUPS
D_STATE = 128
SSD_CONV = 4
CONV_DIM = D_INNER + 2 * N_GROUPS * D_STATE
SSD_PROJ = 2 * D_INNER + 2 * N_GROUPS * D_STATE + N_HEADS
SC_WIDTH = D_MODEL
SC_CONV = 3
SC_PROJ = 4 * SC_WIDTH
N_SSD = (DEPTH + 1) // 2
N_SC = DEPTH // 2
EPS = 1e-5
DT_MIN = 1e-3
DT_MAX = 1e-1

kernel_name = 'hybrid_ssd_shortconv_stream_step'


def rmsnorm(x, w):
    xf = x.astype(jnp.float32)
    y = xf * lax.rsqrt(jnp.mean(xf * xf, axis=-1, keepdims=True) + EPS)
    return (y * w.astype(jnp.float32)).astype(x.dtype)


def causal_dwconv(u, buf, w):
    K = w.shape[0]
    L = u.shape[1]
    full = jnp.concatenate([buf.astype(u.dtype), u], axis=1)
    out = full[:, 0:L] * w[0]
    for k in range(1, K):
        out = out + full[:, k:k + L] * w[k]
    return out, full[:, L:]


def ssd_scan(xdt, a, bm, cm, h0):
    b, L = a.shape[:2]
    nc = L // CHUNK

    def to_chunks(t):
        return jnp.moveaxis(t.reshape((b, nc, CHUNK) + t.shape[2:]), 1, 0)

    causal = jnp.tril(jnp.ones((CHUNK, CHUNK), dtype=bool))[:, :, None, None]

    def step(h, inp):
        xc, ac, bc, cc = inp
        a_cs = jnp.cumsum(ac, axis=1)
        seg = a_cs[:, :, None] - a_cs[:, None, :]
        decay = jnp.exp(jnp.where(causal, seg, -jnp.inf))
        cb = jnp.einsum('btgn,bsgn->btsg', cc, bc)
        y = jnp.einsum('btsg,btsgh,bsghp->btghp', cb, decay, xc)
        y = y + jnp.einsum('btgn,bghpn->btghp', cc, h) * jnp.exp(a_cs)[..., None]
        to_end = jnp.exp(a_cs[:, -1:] - a_cs)
        h = h * jnp.exp(a_cs[:, -1])[..., None, None] + jnp.einsum('bsgn,bsgh,bsghp->bghpn', bc, to_end, xc)
        return h, y

    h, ys = lax.scan(step, h0, (to_chunks(xdt), to_chunks(a), to_chunks(bm), to_chunks(cm)))
    y = jnp.moveaxis(ys, 0, 1).reshape(xdt.shape)
    return y, h


def ssd_mixer(u, conv_buf, h0, w_in, conv_w, conv_b, dt_bias, a_log, d_skip, norm_w, w_out):
    b, L, _ = u.shape
    f32 = jnp.float32
    proj = u @ w_in
    z, xbc, dt_raw = jnp.split(proj, [D_INNER, D_INNER + CONV_DIM], axis=-1)
    xbc, new_buf = causal_dwconv(xbc, conv_buf, conv_w)
    xbc = jax.nn.silu(xbc + conv_b)
    xs, bm, cm = jnp.split(xbc, [D_INNER, D_INNER + N_GROUPS * D_STATE], axis=-1)
    xs = xs.astype(f32).reshape(b, L, N_GROUPS, HEADS_PER_GROUP, HEAD_DIM)
    bm = bm.astype(f32).reshape(b, L, N_GROUPS, D_STATE)
    cm = cm.astype(f32).reshape(b, L, N_GROUPS, D_STATE)
    dt = jax.nn.softplus(dt_raw.astype(f32) + dt_bias.astype(f32)).reshape(b, L, N_GROUPS, HEADS_PER_GROUP)
    A = -jnp.exp(a_log.astype(f32)).reshape(N_GROUPS, HEADS_PER_GROUP)
    pad = (-L) % CHUNK
    def padf(t):
        return jnp.pad(t, [(0, 0), (pad, 0)] + [(0, 0)] * (t.ndim - 2))
    h0g = h0.astype(f32).reshape(b, N_GROUPS, HEADS_PER_GROUP, HEAD_DIM, D_STATE)
    y, h = ssd_scan(padf(xs * dt[..., None]), padf(dt * A), padf(bm), padf(cm), h0g)
    y = y[:, pad:] + xs * d_skip.astype(f32).reshape(N_GROUPS, HEADS_PER_GROUP, 1)
    y = y.reshape(b, L, N_GROUPS, D_INNER // N_GROUPS) * jax.nn.silu(z.astype(f32)).reshape(b, L, N_GROUPS, D_INNER // N_GROUPS)
    y = y * lax.rsqrt(jnp.mean(y * y, axis=-1, keepdims=True) + EPS)
    y = (y.reshape(b, L, D_INNER) * norm_w.astype(f32)).astype(u.dtype)
    h = h.reshape(b, N_HEADS, HEAD_DIM, D_STATE).astype(u.dtype)
    return y @ w_out, new_buf, h


def shortconv_mixer(u, conv_buf, w_in, conv_w, w_out):
    g, bgate, cgate, v = jnp.split(u @ w_in, 4, axis=-1)
    cv, new_buf = causal_dwconv(cgate * v, conv_buf, conv_w)
    y = jax.nn.silu(g) * bgate * cv
    return y @ w_out, new_buf


def trunk(h, ssm_states, ssd_bufs, sc_bufs, ln_w, ssd_w_in, ssd_conv_w, ssd_conv_b, ssd_dt_bias,
          ssd_a_log, ssd_d_skip, ssd_norm_w, ssd_w_out, sc_w_in, sc_conv_w, sc_w_out, final_norm_w):
    new_ssm, new_ssd_buf, new_sc_buf = [], [], []
    for i in range(DEPTH):
        j = i // 2
        u = rmsnorm(h, ln_w[i])
        if i % 2 == 0:
            out, buf, st = ssd_mixer(u, ssd_bufs[j], ssm_states[j], ssd_w_in[j], ssd_conv_w[j], ssd_conv_b[j],
                                     ssd_dt_bias[j], ssd_a_log[j], ssd_d_skip[j], ssd_norm_w[j], ssd_w_out[j])
            new_ssm.append(st)
            new_ssd_buf.append(buf)
        else:
            out, buf = shortconv_mixer(u, sc_bufs[j], sc_w_in[j], sc_conv_w[j], sc_w_out[j])
            new_sc_buf.append(buf)
        h = h + out
    y = rmsnorm(h, final_norm_w)
    return y, jnp.stack(new_ssm), jnp.stack(new_ssd_buf), jnp.stack(new_sc_buf)


def setup_inputs(seed: int = 0) -> dict:
    key = jax.random.key(seed)
    ks = jax.random.split(key, 24)
    f32 = jnp.float32
    nrm = lambda k, s, sc: jax.random.normal(k, s, f32) * sc
    dt0 = jnp.exp(jax.random.uniform(ks[10], (N_SSD, N_HEADS), f32, np.log(DT_MIN), np.log(DT_MAX)))
    return {
        'x_prompt': nrm(ks[0], (BATCH, SEQ, D_MODEL), 1.0),
        'x_sample': nrm(ks[1], (DEC_BATCH, DEC_SEQ, D_MODEL), 1.0),
        'state_ssm': nrm(ks[2], (N_SSD, DEC_BATCH, N_HEADS, HEAD_DIM, D_STATE), 0.1),
        'state_ssd_conv': nrm(ks[3], (N_SSD, DEC_BATCH, SSD_CONV - 1, CONV_DIM), 1.0),
        'state_sc_conv': nrm(ks[4], (N_SC, DEC_BATCH, SC_CONV - 1, SC_WIDTH), 1.0),
        'meta_tokens': nrm(ks[5], (N_META, D_MODEL), 1.0),
        'ln_w': 1.0 + nrm(ks[6], (DEPTH, D_MODEL), 0.02),
        'ssd_w_in': nrm(ks[7], (N_SSD, D_MODEL, SSD_PROJ), D_MODEL ** -0.5),
        'ssd_conv_w': nrm(ks[8], (N_SSD, SSD_CONV, CONV_DIM), SSD_CONV ** -0.5),
        'ssd_conv_b': nrm(ks[9], (N_SSD, CONV_DIM), 0.02),
        'ssd_dt_bias': dt0 + jnp.log(-jnp.expm1(-dt0)),
        'ssd_a_log': jnp.log(jax.random.uniform(ks[11], (N_SSD, N_HEADS), f32, 1.0, 16.0)),
        'ssd_d_skip': 1.0 + nrm(ks[12], (N_SSD, N_HEADS), 0.1),
        'ssd_norm_w': 1.0 + nrm(ks[13], (N_SSD, D_INNER), 0.02),
        'ssd_w_out': nrm(ks[14], (N_SSD, D_INNER, D_MODEL), D_INNER ** -0.5),
        'sc_w_in': nrm(ks[15], (N_SC, D_MODEL, SC_PROJ), D_MODEL ** -0.5),
        'sc_conv_w': nrm(ks[16], (N_SC, SC_CONV, SC_WIDTH), SC_CONV ** -0.5),
        'sc_w_out': nrm(ks[17], (N_SC, SC_WIDTH, D_MODEL), SC_WIDTH ** -0.5),
        'final_norm_w': 1.0 + nrm(ks[18], (D_MODEL,), 0.02),
    }


def reference(x_prompt, x_sample, state_ssm, state_ssd_conv, state_sc_conv, meta_tokens, ln_w, ssd_w_in,
              ssd_conv_w, ssd_conv_b, ssd_dt_bias, ssd_a_log, ssd_d_skip, ssd_norm_w, ssd_w_out,
              sc_w_in, sc_conv_w, sc_w_out, final_norm_w):
    weights = (ln_w, ssd_w_in, ssd_conv_w, ssd_conv_b, ssd_dt_bias, ssd_a_log, ssd_d_skip, ssd_norm_w,
               ssd_w_out, sc_w_in, sc_conv_w, sc_w_out, final_norm_w)
    dt = x_prompt.dtype
    b = x_prompt.shape[0]
    meta = jnp.broadcast_to(meta_tokens.astype(dt)[None], (b, N_META, D_MODEL))
    h_p = jnp.concatenate([meta, x_prompt], axis=1)
    ssm0 = jnp.zeros((N_SSD, b, N_HEADS, HEAD_DIM, D_STATE), dt)
    ssdbuf0 = jnp.zeros((N_SSD, b, SSD_CONV - 1, CONV_DIM), dt)
    scbuf0 = jnp.zeros((N_SC, b, SC_CONV - 1, SC_WIDTH), dt)
    y_p, ssm_p, ssdbuf_p, scbuf_p = trunk(h_p, ssm0, ssdbuf0, scbuf0, *weights)
    y_prompt = y_p[:, N_META:]
    y_sample, ssm_s, ssdbuf_s, scbuf_s = trunk(x_sample, state_ssm, state_ssd_conv, state_sc_conv, *weights)
    return (y_prompt, y_sample, ssm_p, ssdbuf_p, scbuf_p, ssm_s, ssdbuf_s, scbuf_s)
```

```cpp
#include <hip/hip_runtime.h>
#include <cstdio>
#include <cstdint>

#ifndef MK_N_LAUNCHES
#define MK_N_LAUNCHES 1
#endif

namespace pg8 {
#define PG8_LAS __attribute__((address_space(3)))
typedef unsigned short bf16_t;
typedef short bf16x8 __attribute__((ext_vector_type(8)));
typedef float f32x4 __attribute__((ext_vector_type(4)));
typedef unsigned u32x4 __attribute__((ext_vector_type(4)));
constexpr int M_MAIN_PANELS = 64;
constexpr int BM = 256, BK = 64, HALF = 128, HTB = HALF * BK * 2  , STAGE_BYTES = 8 * HTB, NXCD = 8, WGM = 8;

__host__ __device__ __forceinline__ int lds_byte(int r, int c) { const int st = (r >> 4) * 2 + (c >> 5), rr = r & 15, cc = c & 31, ob = rr * 64 + cc * 2; return st * 1024 + (ob ^ (((ob >> 9) & 1) << 5)); }
__host__ __device__ __forceinline__ void stage_rc(int b, int& R, int& C) { const int st = b / 1024, sb = b % 1024, swz = sb ^ (((sb >> 9) & 1) << 5); R = (st >> 1) * 16 + swz / 64; C = (st & 1) * 32 + (swz % 64) / 2; }
__host__ __device__ __forceinline__ int perm32(int rho) { const int n = rho >> 4, i = rho & 15; return 8 * (i >> 2) + 4 * n + (i & 3); }

struct Unit { int pm, pn, kt0, nkt; };
struct Gemm { const bf16_t* A; const bf16_t* Bt; int M, N, K; };

struct StaticOrder {
    int nM, nN, nwg, G, c, nktf;
    __host__ __device__ void init(int M, int N, int K, int G_, int c_) { nM = M / BM; nN = N / BM; nwg = nM * nN; G = G_; c = c_; nktf = K / BK; }
    __host__ __device__ __forceinline__ void main_unit(int L, Unit& u) const {
        int wgid = L; { const int q = nwg / NXCD, r = nwg % NXCD, xcd = wgid % NXCD, off = wgid / NXCD; wgid = (xcd < r ? xcd * (q + 1) : r * (q + 1) + (xcd - r) * q) + off; }
        const int nig = WGM * nN, gid = wgid / nig, fm = gid * WGM, gsz = (nM - fm) < WGM ? (nM - fm) : WGM;
        u.pm = fm + ((wgid % nig) % gsz); u.pn = (wgid % nig) / gsz; u.kt0 = 0; u.nkt = nktf;
    }
    __host__ __device__ __forceinline__ bool next(int i, Unit& u) const {
        const long L = (long)i * G + c; if (L >= nwg) return false;
        main_unit((int)L, u); return true;
    }
    __device__ __forceinline__ void a_ready(const Unit&) const {}
    __device__ __forceinline__ void done(const Unit&) const {}
    __device__ __forceinline__ unsigned fetch(int) const { return 0u; }
    __device__ __forceinline__ void commit(int, unsigned) const {}
    __device__ __forceinline__ bool resolve(int i, Unit& u) const { return next(i, u); }
};
struct TailSplitOrder : StaticOrder {
    int KS;
    __host__ __device__ __forceinline__ bool next(int i, Unit& u) const {
        const long L = (long)i * G + c; const bool is_main = L < nwg; const long mi = L - nwg;
        if (!is_main && mi >= (long)nN * KS) return false;
        Unit a; main_unit(is_main ? (int)L : 0, a);
        const int mn = nktf / KS, mpn = (int)(mi / KS), mks = (int)(mi % KS);
        u.pm = is_main ? a.pm : nM; u.pn = is_main ? a.pn : mpn; u.kt0 = is_main ? 0 : mks * mn; u.nkt = is_main ? nktf : mn;
        return true;
    }
    __device__ __forceinline__ bool resolve(int i, Unit& u) const { return next(i, u); }
};

struct DynOrder : TailSplitOrder {
    unsigned* ctr; PG8_LAS unsigned* slot; bool dyn;
    __device__ __forceinline__ void setup(unsigned* ctr_, PG8_LAS unsigned* slot_) { ctr = ctr_; slot = slot_; dyn = (G % 8 == 0) && G >= 8; }
    __device__ __forceinline__ bool entry(int k, Unit& u) const {
        const int x = c & 7; const int nmain = (nwg - x + 7) / 8; const bool is_main = k < nmain; const long mi = (long)(k - nmain) * 8 + x;
        if (!is_main && (KS == 0 || mi >= (long)nN * KS)) return false;
        Unit a; main_unit(is_main ? k * 8 + x : 0, a);
        const int ks_ = KS ? KS : 1, mn = nktf / ks_, mpn = (int)(mi / ks_), mks = (int)(mi % ks_);
        u.pm = is_main ? a.pm : nM; u.pn = is_main ? a.pn : mpn; u.kt0 = is_main ? 0 : mks * mn; u.nkt = is_main ? nktf : mn;
        return true;
    }
    __device__ __forceinline__ bool next(int i, Unit& u) const { return dyn ? entry(c >> 3, u) : TailSplitOrder::next(i, u); }
    __device__ __forceinline__ unsigned fetch(int) const { unsigned k = 0u; if (dyn && threadIdx.x == 0) k = (unsigned)(G >> 3) + __hip_atomic_fetch_add(ctr + 64 * (c & 7), 1u, __ATOMIC_RELAXED, __HIP_MEMORY_SCOPE_AGENT); return k; }
    __device__ __forceinline__ void commit(int ui, unsigned k) const { if (dyn && threadIdx.x == 0) slot[(ui + 1) & 1] = k; }
    __device__ __forceinline__ bool resolve(int i, Unit& u) const { if (!dyn) return TailSplitOrder::next(i, u); const int k = __builtin_amdgcn_readfirstlane((int)slot[i & 1]); return entry(k, u); }
};

__device__ __forceinline__ unsigned cvt_pk_bf16(float lo, float hi) { unsigned r; asm volatile("v_cvt_pk_bf16_f32 %0, %1, %2" : "=v"(r) : "v"(lo), "v"(hi)); return r; }

struct EpiSsdIn {
    static constexpr bool PERM = true, AFTER_DRAIN = false, KSCALE = false;
    bf16_t* Z; bf16_t* XBC; float* DTRAW; const float* RSTD;
    __device__ __forceinline__ void operator()(const f32x4 (&acc)[2][2][4][2], const Unit& u, int wr, int wc, int fr, int fq) const {
        const int row0 = u.pm * BM + wr * 64 + fr;
        if (u.pn < 32) {
            const int col0 = u.pn * BM + wc * 32 + 8 * fq;
            float rsv[2][4];
#pragma unroll
            for (int ai = 0; ai < 2; ++ai)
#pragma unroll
                for (int m = 0; m < 4; ++m) rsv[ai][m] = RSTD[row0 + ai * HALF + m * 16];
#pragma unroll
            for (int ai = 0; ai < 2; ++ai)
#pragma unroll
                for (int m = 0; m < 4; ++m) { bf16_t* rowp = Z + (size_t)(row0 + ai * HALF + m * 16) * 8192 + col0; const float rs = rsv[ai][m];
#pragma unroll
                    for (int bj = 0; bj < 2; ++bj) { float g[8];
#pragma unroll
                        for (int e = 0; e < 8; ++e) { const float x = acc[ai][bj][m][e >> 2][e & 3] * rs; g[e] = x * __builtin_amdgcn_rcpf(1.f + __builtin_amdgcn_exp2f(-1.44269504f * x)); }
                        u32x4 w; w.x = cvt_pk_bf16(g[0], g[1]); w.y = cvt_pk_bf16(g[2], g[3]); w.z = cvt_pk_bf16(g[4], g[5]); w.w = cvt_pk_bf16(g[6], g[7]);
                        *(u32x4*)(rowp + bj * HALF) = w; } }
        } else if (u.pn < 72) {
            const int col0 = (u.pn - 32) * BM + wc * 32 + 8 * fq;
#pragma unroll
            for (int ai = 0; ai < 2; ++ai)
#pragma unroll
                for (int m = 0; m < 4; ++m) { bf16_t* rowp = XBC + (size_t)(row0 + ai * HALF + m * 16) * 10240 + col0;
#pragma unroll
                    for (int bj = 0; bj < 2; ++bj) { const f32x4 v0 = acc[ai][bj][m][0], v1 = acc[ai][bj][m][1];
                        u32x4 w; w.x = cvt_pk_bf16(v0[0], v0[1]); w.y = cvt_pk_bf16(v0[2], v0[3]); w.z = cvt_pk_bf16(v1[0], v1[1]); w.w = cvt_pk_bf16(v1[2], v1[3]);
                        *(u32x4*)(rowp + bj * HALF) = w; } }
        } else {
            const int col0 = wc * 32 + 8 * fq;
#pragma unroll
            for (int ai = 0; ai < 2; ++ai)
#pragma unroll
                for (int m = 0; m < 4; ++m) { float* rowp = DTRAW + (size_t)(row0 + ai * HALF + m * 16) * 128 + col0;
                    *(f32x4*)(rowp) = acc[ai][0][m][0]; *(f32x4*)(rowp + 4) = acc[ai][0][m][1]; }
        }
    }
};
struct EpiBf16Plain {
    static constexpr bool PERM = true, AFTER_DRAIN = false, KSCALE = false;
    bf16_t* O; int ldc;
    __device__ __forceinline__ void operator()(const f32x4 (&acc)[2][2][4][2], const Unit& u, int wr, int wc, int fr, int fq) const {
        const int row0 = u.pm * BM + wr * 64 + fr, col0 = u.pn * BM + wc * 32 + 8 * fq;
#pragma unroll
        for (int ai = 0; ai < 2; ++ai)
#pragma unroll
            for (int m = 0; m < 4; ++m) { bf16_t* rowp = O + (size_t)(row0 + ai * HALF + m * 16) * ldc + col0;
#pragma unroll
                for (int bj = 0; bj < 2; ++bj) { const f32x4 v0 = acc[ai][bj][m][0], v1 = acc[ai][bj][m][1];
                    u32x4 w; w.x = cvt_pk_bf16(v0[0], v0[1]); w.y = cvt_pk_bf16(v0[2], v0[3]); w.z = cvt_pk_bf16(v1[0], v1[1]); w.w = cvt_pk_bf16(v1[2], v1[3]);
                    *(u32x4*)(rowp + bj * HALF) = w; } }
    }
};
struct EpiScIn {
    static constexpr bool PERM = true, AFTER_DRAIN = false, KSCALE = false;
    bf16_t* GC; const float* RSTD; float* SLAB;
    __device__ __forceinline__ void operator()(const f32x4 (&acc)[2][2][4][2], const Unit& u, int wr, int wc, int fr, int fq) const {
        const int j0 = u.pn * 64 + wc * 16 + fq * 4;
        if (u.pm >= M_MAIN_PANELS) {
            float* sl = SLAB + (size_t)(u.kt0 / u.nkt) * (256 * 16384) + (size_t)(wr * 64 + fr) * 16384 + j0;
#pragma unroll
            for (int ai = 0; ai < 2; ++ai)
#pragma unroll
                for (int m = 0; m < 4; ++m) { float* p = sl + (size_t)(ai * HALF + m * 16) * 16384;
                    *(f32x4*)(p) = acc[ai][0][m][0]; *(f32x4*)(p + 4096) = acc[ai][0][m][1]; *(f32x4*)(p + 8192) = acc[ai][1][m][0]; *(f32x4*)(p + 12288) = acc[ai][1][m][1]; }
            return;
        }
        const int row0 = u.pm * BM + wr * 64 + fr;
        float rsv[2][4];
#pragma unroll
        for (int ai = 0; ai < 2; ++ai)
#pragma unroll
            for (int m = 0; m < 4; ++m) rsv[ai][m] = RSTD[row0 + ai * HALF + m * 16];
#pragma unroll
        for (int ai = 0; ai < 2; ++ai)
#pragma unroll
            for (int m = 0; m < 4; ++m) { const int row = row0 + ai * HALF + m * 16; const float rs = rsv[ai][m], rs2 = rs * rs;
                const f32x4 g = acc[ai][0][m][0], b = acc[ai][0][m][1], c = acc[ai][1][m][0], v = acc[ai][1][m][1]; float gb[4], cv[4];
#pragma unroll
                for (int e = 0; e < 4; ++e) { const float x = g[e] * rs; gb[e] = x * __builtin_amdgcn_rcpf(1.f + __builtin_amdgcn_exp2f(-1.44269504f * x)) * (b[e] * rs); cv[e] = c[e] * v[e] * rs2; }
                u32x4 w; w.x = cvt_pk_bf16(gb[0], gb[1]); w.y = cvt_pk_bf16(gb[2], gb[3]); w.z = cvt_pk_bf16(cv[0], cv[1]); w.w = cvt_pk_bf16(cv[2], cv[3]);
                *(u32x4*)(GC + (size_t)row * 8192 + 2 * j0) = w; }
    }
};
struct EpiNone {
    static constexpr bool PERM = true, AFTER_DRAIN = false, KSCALE = false;
    __device__ __forceinline__ void operator()(const f32x4 (&acc)[2][2][4][2], const Unit&, int, int, int, int) const {
#pragma unroll
        for (int ai = 0; ai < 2; ++ai)
#pragma unroll
            for (int bj = 0; bj < 2; ++bj)
#pragma unroll
                for (int m = 0; m < 4; ++m) { asm volatile("" :: "v"(acc[ai][bj][m][0]), "v"(acc[ai][bj][m][1])); }
    }
};
__device__ __forceinline__ void kscale_prep(const float* CG, const Unit& u, PG8_LAS float* tbl) {
    int tid = threadIdx.x; asm volatile("" : "+v"(tid));
    if (tid < 256) { const float* p = CG + ((size_t)u.pm * BM + tid) * 8; const f32x4 a = *(const f32x4*)p, b = *(const f32x4*)(p + 4);
        f32x4 ra, rb; ra[0] = b[3]; ra[1] = a[0] * __builtin_amdgcn_rcpf(a[1]); ra[2] = a[1] * __builtin_amdgcn_rcpf(a[2]); ra[3] = a[2] * __builtin_amdgcn_rcpf(a[3]);
        rb[0] = a[3] * __builtin_amdgcn_rcpf(b[0]); rb[1] = b[0] * __builtin_amdgcn_rcpf(b[1]); rb[2] = b[1] * __builtin_amdgcn_rcpf(b[2]); rb[3] = b[2] * __builtin_amdgcn_rcpf(b[3]);
        *(PG8_LAS f32x4*)(tbl + tid * 8) = ra; *(PG8_LAS f32x4*)(tbl + tid * 8 + 4) = rb; }
}
__device__ __forceinline__ void kscale_step(f32x4 (&acc)[2][2][4][2], const PG8_LAS float* tbl, int g, int, int) {
    int tz = threadIdx.x; asm volatile("" : "+v"(tz)); const int wr = tz >> 8, fr = tz & 15;
#pragma unroll
    for (int ai = 0; ai < 2; ++ai)
#pragma unroll
        for (int m = 0; m < 4; ++m) { const int r = ai * HALF + wr * 64 + m * 16 + fr; const float ratio = tbl[r * 8 + g];
#pragma unroll
            for (int bj = 0; bj < 2; ++bj)
#pragma unroll
                for (int n = 0; n < 2; ++n) acc[ai][bj][m][n] = acc[ai][bj][m][n] * ratio; }
}
struct EpiResid {
    static constexpr bool PERM = true, AFTER_DRAIN = false, KSCALE = false;
    bf16_t* H; float* SSQ; float* SLAB;
    __device__ __forceinline__ void operator()(const f32x4 (&acc)[2][2][4][2], const Unit& u, int wr, int wc, int fr, int fq) const {
        const int row0 = u.pm * BM + wr * 64 + fr, col0 = u.pn * BM + wc * 32 + 8 * fq;
        if (u.pm >= M_MAIN_PANELS) {
            float* sl = SLAB + (size_t)(u.kt0 / u.nkt) * (256 * 4096) + (size_t)(wr * 64 + fr) * 4096 + col0;
#pragma unroll
            for (int ai = 0; ai < 2; ++ai)
#pragma unroll
                for (int m = 0; m < 4; ++m)
#pragma unroll
                    for (int bj = 0; bj < 2; ++bj) { float* p = sl + (size_t)(ai * HALF + m * 16) * 4096 + bj * HALF; *(f32x4*)p = acc[ai][bj][m][0]; *(f32x4*)(p + 4) = acc[ai][bj][m][1]; }
            return;
        }
        const unsigned off0 = ((unsigned)row0 * 4096u + (unsigned)col0) * 2u;
        const char* hb = (const char*)H;
#pragma unroll
        for (int ai = 0; ai < 2; ++ai) {
            u32x4 old[4][2];
#pragma unroll
            for (int m = 0; m < 4; ++m)
#pragma unroll
                for (int bj = 0; bj < 2; ++bj) old[m][bj] = *(const u32x4*)(hb + (off0 + (unsigned)((ai * HALF + m * 16) * 4096 + bj * HALF) * 2u));
#pragma unroll
            for (int m = 0; m < 4; ++m) { const int row = row0 + ai * HALF + m * 16; float ss = 0.f;
#pragma unroll
                for (int bj = 0; bj < 2; ++bj) { const u32x4 o = old[m][bj];
                    f32x4 v0 = acc[ai][bj][m][0], v1 = acc[ai][bj][m][1];
                    v0[0] += __uint_as_float(o.x << 16); v0[1] += __uint_as_float(o.x & 0xffff0000u); v0[2] += __uint_as_float(o.y << 16); v0[3] += __uint_as_float(o.y & 0xffff0000u);
                    v1[0] += __uint_as_float(o.z << 16); v1[1] += __uint_as_float(o.z & 0xffff0000u); v1[2] += __uint_as_float(o.w << 16); v1[3] += __uint_as_float(o.w & 0xffff0000u);
                    ss += (v0[0] * v0[0] + v0[1] * v0[1]) + (v0[2] * v0[2] + v0[3] * v0[3]) + (v1[0] * v1[0] + v1[1] * v1[1]) + (v1[2] * v1[2] + v1[3] * v1[3]);
                    u32x4 w; w.x = cvt_pk_bf16(v0[0], v0[1]); w.y = cvt_pk_bf16(v0[2], v0[3]); w.z = cvt_pk_bf16(v1[0], v1[1]); w.w = cvt_pk_bf16(v1[2], v1[3]);
                    *(u32x4*)((char*)H + (off0 + (unsigned)((ai * HALF + m * 16) * 4096 + bj * HALF) * 2u)) = w; }
                ss += __shfl_xor(ss, 16); ss += __shfl_xor(ss, 32);
                if (fq == 0) SSQ[(size_t)row * 64 + u.pn * 4 + wc] = ss; }
        }
    }
};

struct EpiResidN {
    static constexpr bool PERM = true, AFTER_DRAIN = false, KSCALE = true;
    EpiResid R; const float* CG;
    __device__ __forceinline__ void prep(const Unit& u, PG8_LAS float* tbl) const { kscale_prep(CG, u, tbl); }
    __device__ __forceinline__ void operator()(f32x4 (&acc)[2][2][4][2], const Unit& u, int, int, int, int, const PG8_LAS float* tbl) const {
        int tz = threadIdx.x; asm volatile("" : "+v"(tz)); const int wid = tz >> 6, lane = tz & 63, wr = wid >> 2, wc = wid & 3, fr = lane & 15, fq = lane >> 4;
        const int g = (u.pm >= M_MAIN_PANELS) ? (u.kt0 >> 4) : 7;
#pragma unroll
        for (int ai = 0; ai < 2; ++ai)
#pragma unroll
            for (int m = 0; m < 4; ++m) { const PG8_LAS float* tr = tbl + (ai * HALF + wr * 64 + m * 16 + fr) * 8; float c = tr[0];
                for (int k = 7; k > g; --k) c *= tr[k];
#pragma unroll
                for (int bj = 0; bj < 2; ++bj)
#pragma unroll
                    for (int n = 0; n < 2; ++n) acc[ai][bj][m][n] = acc[ai][bj][m][n] * c; }
        R(acc, u, wr, wc, fr, fq);
    }
};

template <class Epi, class Sched, bool ALIGN_EPI = false, bool SP2 = false>
__device__ __forceinline__ void gemm_phase(PG8_LAS unsigned char* lds, const Gemm g, const Sched& S, const Epi& E) {
    const int tid = threadIdx.x, wid = __builtin_amdgcn_readfirstlane(tid >> 6), lane = tid & 63, wr = wid >> 2, wc = wid & 3, fr = lane & 15, fq = lane >> 4;
    const int K = g.K;
    unsigned voffA, voffB;
    { int R, C; stage_rc(tid * 16, R, C); const int Rb = Epi::PERM ? ((R & ~31) + perm32(R & 31)) : R; voffA = (unsigned)(R * K + C) * 2u; voffB = (unsigned)(Rb * K + C) * 2u; }
    const size_t rstep = (size_t)64 * K * 2;
    const size_t kstep = (size_t)(BK * 2);
    const size_t hstep = (size_t)HALF * K * 2;
    const size_t tstep = 2 * hstep;
    const unsigned ldsw = (unsigned)wid * 1024u;
    const int aoff = lds_byte(wr * 64 + fr, fq * 8), boff = lds_byte(wc * 32 + fr, fq * 8);
#define PG8_SA(b, h) (((b) * 2 + (h)) * HTB)
#define PG8_SB(b, h) ((4 + (b) * 2 + (h)) * HTB)
#define PG8_STAGE(bufoff, gbase, voff) do { _Pragma("unroll") for (int _i = 0; _i < 2; ++_i) \
        __builtin_amdgcn_global_load_lds((const unsigned*)((const char*)(gbase) + (size_t)_i * rstep + (voff)), (PG8_LAS unsigned*)(lds + (bufoff) + ldsw + _i * 8192), 16, 0, 0); } while (0)
#define PG8_LDA(dst, b, h) do { _Pragma("unroll") for (int m = 0; m < 4; ++m) _Pragma("unroll") for (int k = 0; k < 2; ++k) dst[m][k] = *(const PG8_LAS bf16x8*)(lds + PG8_SA(b, h) + aoff + m * 2048 + k * 1024); } while (0)
#define PG8_LDB(dst, b, h) do { _Pragma("unroll") for (int n = 0; n < 2; ++n) _Pragma("unroll") for (int k = 0; k < 2; ++k) dst[n][k] = *(const PG8_LAS bf16x8*)(lds + PG8_SB(b, h) + boff + n * 2048 + k * 1024); } while (0)
#define PG8_MMA(ai, bj, At, Bt) do { __builtin_amdgcn_s_setprio(1); _Pragma("unroll") for (int m = 0; m < 4; ++m) _Pragma("unroll") for (int n = 0; n < 2; ++n) _Pragma("unroll") for (int k = 0; k < 2; ++k) \
        acc[ai][bj][m][n] = __builtin_amdgcn_mfma_f32_16x16x32_bf16(Bt[n][k], At[m][k], acc[ai][bj][m][n], 0, 0, 0); __builtin_amdgcn_s_setprio(0); } while (0)
#define PG8_WAIT_V(n) asm volatile("s_waitcnt vmcnt(" #n ")" ::: "memory")
#define PG8_WAIT_L(n) asm volatile("s_waitcnt lgkmcnt(" #n ")" ::: "memory")
#define PG8_BAR __builtin_amdgcn_s_barrier()
#define PG8_SCHED __builtin_amdgcn_sched_barrier(0)
    Unit cur, nxt; int ui = 0;
    if (!S.next(0, cur)) return;
    PG8_LAS float* const ktbl = (PG8_LAS float*)(lds + STAGE_BYTES);
    f32x4 acc[2][2][4][2];
#pragma unroll
    for (int a = 0; a < 2; ++a)
#pragma unroll
        for (int b = 0; b < 2; ++b)
#pragma unroll
            for (int m = 0; m < 4; ++m)
#pragma unroll
                for (int n = 0; n < 2; ++n) acc[a][b][m][n] = (f32x4){0.f, 0.f, 0.f, 0.f};
    bf16x8 At[4][2], B0[2][2], B1[2][2];
    const char* cA = (const char*)g.A + (size_t)cur.pm * tstep + (size_t)cur.kt0 * kstep; const char* cB = (const char*)g.Bt + (size_t)cur.pn * tstep + (size_t)cur.kt0 * kstep;
    S.a_ready(cur);
    if constexpr (Epi::KSCALE) E.prep(cur, ktbl);
    if constexpr (SP2) {
        PG8_STAGE(PG8_SB(0, 0), cB, voffB); PG8_STAGE(PG8_SB(0, 1), cB + hstep, voffB); PG8_STAGE(PG8_SA(0, 0), cA, voffA); PG8_STAGE(PG8_SA(0, 1), cA + hstep, voffA);
        if (wr == 1) PG8_BAR;
        PG8_WAIT_V(2); PG8_BAR;
        PG8_STAGE(PG8_SB(1, 0), cB + kstep, voffB); PG8_STAGE(PG8_SA(1, 0), cA + kstep, voffA); PG8_STAGE(PG8_SB(1, 1), cB + hstep + kstep, voffB);
        PG8_WAIT_V(6); PG8_BAR;
    } else {
        PG8_STAGE(PG8_SB(0, 0), cB, voffB); PG8_STAGE(PG8_SA(0, 0), cA, voffA); PG8_STAGE(PG8_SB(0, 1), cB + hstep, voffB); PG8_STAGE(PG8_SA(0, 1), cA + hstep, voffA);
        if (wr == 1) PG8_BAR;
        PG8_WAIT_V(4); PG8_BAR;
        PG8_STAGE(PG8_SB(1, 0), cB + kstep, voffB); PG8_STAGE(PG8_SA(1, 0), cA + kstep, voffA); PG8_STAGE(PG8_SB(1, 1), cB + hstep + kstep, voffB);
        PG8_WAIT_V(6); PG8_BAR;
    }
    for (;;) {
        const unsigned kclaim = S.fetch(ui);
        bool has_next = false; const char* nA = cA; const char* nB = cB;
        const int nt = cur.nkt;
        for (int t = 0; t < nt; t += 2) {
            const bool last = (t == nt - 2);
            if (t == (nt > 4 ? 2 : 0)) S.commit(ui, kclaim);
            if (last) { has_next = S.resolve(ui + 1, nxt);
                if (has_next) { nA = (const char*)g.A + (size_t)nxt.pm * tstep + (size_t)nxt.kt0 * kstep; nB = (const char*)g.Bt + (size_t)nxt.pn * tstep + (size_t)nxt.kt0 * kstep; } }
            const char* a1 = cA + (size_t)(t + 1) * kstep;
            const char* a2 = last ? nA : cA + (size_t)(t + 2) * kstep; const char* b2 = last ? nB : cB + (size_t)(t + 2) * kstep;
            const char* a3 = a2 + kstep; const char* b3 = b2 + kstep;
            if (last && has_next) S.a_ready(nxt);
            if constexpr (Epi::KSCALE) { const int kt = cur.kt0 + t; if (t > 0 && (kt & 15) == 0) kscale_step(acc, ktbl + (ui & 1) * 2048, kt >> 4, wr, fr); }
            if constexpr (SP2) {
            PG8_LDB(B0, 0, 0); PG8_LDB(B1, 0, 1); PG8_SCHED; PG8_LDA(At, 0, 0); PG8_STAGE(PG8_SA(1, 1), a1 + hstep, voffA);
            PG8_WAIT_V(8); PG8_WAIT_L(0); PG8_BAR; PG8_MMA(0, 0, At, B0); PG8_MMA(0, 1, At, B1); PG8_BAR; PG8_SCHED;
            PG8_LDA(At, 0, 1); PG8_STAGE(PG8_SB(0, 0), b2, voffB); PG8_STAGE(PG8_SB(0, 1), b2 + hstep, voffB); PG8_STAGE(PG8_SA(0, 0), a2, voffA);
            PG8_WAIT_V(8); PG8_WAIT_L(0); PG8_BAR; PG8_MMA(1, 0, At, B0); PG8_MMA(1, 1, At, B1); PG8_BAR; PG8_SCHED;
            PG8_LDB(B0, 1, 0); PG8_LDB(B1, 1, 1); PG8_SCHED; PG8_LDA(At, 1, 0); PG8_STAGE(PG8_SA(0, 1), a2 + hstep, voffA);
            PG8_WAIT_V(8); PG8_WAIT_L(0); PG8_BAR; PG8_MMA(0, 0, At, B0); PG8_MMA(0, 1, At, B1); PG8_BAR; PG8_SCHED;
            PG8_LDA(At, 1, 1); PG8_STAGE(PG8_SB(1, 0), b3, voffB); PG8_STAGE(PG8_SB(1, 1), b3 + hstep, voffB); PG8_STAGE(PG8_SA(1, 0), a3, voffA);
            PG8_WAIT_V(8); PG8_WAIT_L(0); PG8_BAR; PG8_MMA(1, 0, At, B0); PG8_MMA(1, 1, At, B1); PG8_BAR; PG8_SCHED;
            } else {
            PG8_LDB(B0, 0, 0); PG8_SCHED; PG8_LDA(At, 0, 0); PG8_STAGE(PG8_SA(1, 1), a1 + hstep, voffA);
            PG8_WAIT_L(8); PG8_BAR; PG8_WAIT_L(0); PG8_MMA(0, 0, At, B0); PG8_BAR; PG8_SCHED;
            PG8_LDB(B1, 0, 1); PG8_STAGE(PG8_SB(0, 0), b2, voffB);
            PG8_BAR; PG8_WAIT_L(0); PG8_MMA(0, 1, At, B1); PG8_BAR;
            PG8_LDA(At, 0, 1); PG8_STAGE(PG8_SA(0, 0), a2, voffA);
            PG8_BAR; PG8_WAIT_L(0); PG8_MMA(1, 0, At, B0); PG8_BAR; PG8_SCHED;
            PG8_STAGE(PG8_SB(0, 1), b2 + hstep, voffB);
            PG8_WAIT_V(6); PG8_BAR; PG8_MMA(1, 1, At, B1); PG8_BAR;
            PG8_LDB(B0, 1, 0); PG8_SCHED; PG8_LDA(At, 1, 0); PG8_STAGE(PG8_SA(0, 1), a2 + hstep, voffA);
            PG8_WAIT_L(8); PG8_BAR; PG8_WAIT_L(0); PG8_MMA(0, 0, At, B0); PG8_BAR; PG8_SCHED;
            PG8_LDB(B1, 1, 1); PG8_STAGE(PG8_SB(1, 0), b3, voffB);
            PG8_BAR; PG8_WAIT_L(0); PG8_MMA(0, 1, At, B1); PG8_BAR;
            PG8_LDA(At, 1, 1); PG8_STAGE(PG8_SA(1, 0), a3, voffA);
            PG8_BAR; PG8_WAIT_L(0); PG8_MMA(1, 0, At, B0); PG8_BAR; PG8_SCHED;
            PG8_STAGE(PG8_SB(1, 1), b3 + hstep, voffB);
            PG8_WAIT_V(6); PG8_BAR; PG8_MMA(1, 1, At, B1); PG8_BAR;
            }
        }
        if constexpr (ALIGN_EPI) { if (wr == 0) PG8_BAR; }
        if constexpr (Epi::KSCALE) { E(acc, cur, wr, wc, fr, fq, ktbl + (ui & 1) * 2048); if (has_next) E.prep(nxt, ktbl + ((ui + 1) & 1) * 2048); }
        else E(acc, cur, wr, wc, fr, fq);
        S.done(cur);
        if (!has_next) break;
#pragma unroll
        for (int a = 0; a < 2; ++a)
#pragma unroll
            for (int b = 0; b < 2; ++b)
#pragma unroll
                for (int m = 0; m < 4; ++m)
#pragma unroll
                    for (int n = 0; n < 2; ++n) acc[a][b][m][n] = (f32x4){0.f, 0.f, 0.f, 0.f};
        cur = nxt; cA = nA; cB = nB; ++ui;
        if constexpr (ALIGN_EPI) { if (wr == 1) PG8_BAR; }
    }
    PG8_WAIT_V(0);
    if constexpr (!ALIGN_EPI) { if (wr == 0) PG8_BAR; }
    PG8_BAR;
#undef PG8_SA
#undef PG8_SB
#undef PG8_STAGE
#undef PG8_LDA
#undef PG8_LDB
#undef PG8_MMA
#undef PG8_WAIT_V
#undef PG8_WAIT_L
#undef PG8_BAR
#undef PG8_SCHED
}
}

constexpr int D = 4096, DI = 8192, NH = 128, HD = 64, NG = 8, DS = 128, CONVD = 10240;
constexpr int SSD_PROJ = 18560, SSD_PROJ_PAD = 18688, SC_PROJ = 16384;
constexpr int NB = 4, SEQ = 4096, NMETA = 16, NSB = 8, LS = 16;
constexpr int ROW_META = 16384, ROW_SAMPLE = 16448, M_REAL = 16576, M_PAD = 16640, M_MAIN = 16384;
constexpr int NSEG = 1036;
constexpr float EPS = 1e-5f;
constexpr int NWAVES = 8;

constexpr size_t MiB = 1u << 20;
constexpr size_t WS_CTL = 0, CTL_ZERO_BYTES = 1 * MiB;
constexpr size_t SZ_W_SSD_IN1 = (size_t)SSD_PROJ_PAD * D * 2, SZ_W_SSD_OUT1 = (size_t)D * DI * 2, SZ_W_SC_IN1 = (size_t)SC_PROJ * D * 2, SZ_W_SC_OUT1 = (size_t)D * D * 2;
constexpr size_t WS_W_SSD_IN = 1 * MiB;
constexpr size_t WS_W_SSD_OUT = WS_W_SSD_IN + 2 * SZ_W_SSD_IN1;
constexpr size_t WS_W_SC_IN = WS_W_SSD_OUT + 2 * SZ_W_SSD_OUT1;
constexpr size_t WS_W_SC_OUT = WS_W_SC_IN + 2 * SZ_W_SC_IN1;
constexpr size_t WS_H = WS_W_SC_OUT + 2 * SZ_W_SC_OUT1;
constexpr size_t WS_SSQ = WS_H + (size_t)M_PAD * D * 2;
constexpr size_t WS_PROJ = WS_SSQ + (size_t)M_PAD * 64 * 4;
constexpr size_t SZ_Z = (size_t)M_PAD * DI * 2, SZ_XBC = (size_t)M_PAD * CONVD * 2, SZ_DT = (size_t)M_PAD * NH * 4;
constexpr size_t WS_Z = WS_PROJ, WS_XBC = WS_Z + SZ_Z, WS_DTRAW = WS_XBC + SZ_XBC;
constexpr size_t WS_GC = WS_PROJ;
constexpr size_t WS_XACT = WS_DTRAW + SZ_DT;
constexpr size_t WS_YN = WS_XACT;
constexpr size_t WS_DT = WS_XACT + SZ_XBC;
constexpr size_t WS_Y = WS_DT + SZ_DT;
constexpr size_t WS_YSQ = WS_Y + SZ_Z;
constexpr size_t WS_RSTD = WS_YSQ + 4 * SZ_DT;
constexpr size_t WS_SLAB = WS_RSTD + (size_t)M_PAD * 4;
constexpr size_t WS_CG = WS_SLAB + (size_t)16 * 256 * 4096 * 4;
constexpr size_t WS_END = WS_CG + (size_t)M_PAD * 8 * 4;
static_assert((size_t)M_PAD * SC_PROJ * 2 <= SZ_Z + SZ_XBC + SZ_DT, "SC projection overlays the SSD projection region");
static_assert(WS_END % 256 == 0 && WS_XACT % 256 == 0 && WS_Y % 256 == 0, "alignment");
constexpr int CW_BAR = 4096;

constexpr size_t O_YP = 0, O_YS = O_YP + (size_t)NB * SEQ * D, O_SSM_P = O_YS + (size_t)NSB * LS * D, O_CONV_P = O_SSM_P + (size_t)2 * NB * NH * HD * DS,
                 O_SC_P = O_CONV_P + (size_t)2 * NB * 3 * CONVD, O_SSM_S = O_SC_P + (size_t)2 * NB * 2 * D, O_CONV_S = O_SSM_S + (size_t)2 * NSB * NH * HD * DS,
                 O_SC_S = O_CONV_S + (size_t)2 * NSB * 3 * CONVD, O_END = O_SC_S + (size_t)2 * NSB * 2 * D;

constexpr int RING_OFF = 0, RING_BYTES = 131072;
constexpr int LDS_BYTES = 163840;
constexpr int SMALL_OFF = 147456;
constexpr int LDSCTL_OFF = LDS_BYTES - 512, MISC_OFF = LDSCTL_OFF + 320;

#define GAS __attribute__((address_space(1)))
#define LAS __attribute__((address_space(3)))
typedef unsigned short bf16;
typedef unsigned v4u __attribute__((ext_vector_type(4)));
typedef unsigned v2u __attribute__((ext_vector_type(2)));
typedef float f32x4 __attribute__((ext_vector_type(4)));
typedef float f32x2 __attribute__((ext_vector_type(2)));
typedef GAS unsigned gu32;
#define RLX_AGENT __ATOMIC_RELAXED, __HIP_MEMORY_SCOPE_AGENT
#define LDS_WAIT() asm volatile("s_waitcnt lgkmcnt(0)" ::: "memory")
#define VM_WAIT() asm volatile("s_waitcnt vmcnt(0)" ::: "memory")
__device__ __forceinline__ unsigned pk2(float lo, float hi) { return pg8::cvt_pk_bf16(lo, hi); }
__device__ __forceinline__ float bflo(unsigned u) { return __uint_as_float(u << 16); }
__device__ __forceinline__ float bfhi(unsigned u) { return __uint_as_float(u & 0xffff0000u); }
__device__ __forceinline__ void unpack8(const v4u w, float (&f)[8]) { f[0] = bflo(w.x); f[1] = bfhi(w.x); f[2] = bflo(w.y); f[3] = bfhi(w.y); f[4] = bflo(w.z); f[5] = bfhi(w.z); f[6] = bflo(w.w); f[7] = bfhi(w.w); }
__device__ __forceinline__ v4u pack8(const float (&f)[8]) { v4u o; o.x = pk2(f[0], f[1]); o.y = pk2(f[2], f[3]); o.z = pk2(f[4], f[5]); o.w = pk2(f[6], f[7]); return o; }
__device__ __forceinline__ float silu_f(float x) { return x * __builtin_amdgcn_rcpf(1.f + __expf(-x)); }
__device__ __forceinline__ float softplus_f(float x) { return fmaxf(x, 0.f) + log1pf(__expf(-fabsf(x))); }

#define XB_TMO      128
#define XB_XCNT(j)  (256  + 64 * (j))
#define XB_XSUB(j)  (1280 + 64 * (j))
#define XB_XGEN(j)  (2304 + 64 * (j))
#define XB_TOP      3328
#define XB_TOPGEN   3392
#define XCD_BAR_WORDS 3456
#define XB_SPIN_CAP (1u << 18)
__device__ __forceinline__ unsigned xb_ld(unsigned* p)              { return __hip_atomic_load(p, __ATOMIC_RELAXED, __HIP_MEMORY_SCOPE_AGENT); }
__device__ __forceinline__ unsigned xb_add(unsigned* p, unsigned v) { return __hip_atomic_fetch_add(p, v, __ATOMIC_RELAXED, __HIP_MEMORY_SCOPE_AGENT); }
__device__ __forceinline__ unsigned xb_xcc_id() { return (unsigned)__builtin_amdgcn_s_getreg((3 << 11) | 20) & 0xFu; }
#define XB_SPIN(cond, bar) do { unsigned _sp = 0; while (cond) { __builtin_amdgcn_s_sleep(1); \
    if ((++_sp & 255u) == 0u) { if (xb_ld(&(bar)[XB_TMO])) break; if (_sp > XB_SPIN_CAP) { atomicAdd(&(bar)[XB_TMO], 1u); break; } } } } while (0)
struct XcdBarrier { unsigned* bar; unsigned x; volatile LAS unsigned* st; };
__device__ __forceinline__ XcdBarrier xcd_barrier_post(unsigned* bar, volatile LAS unsigned* st) {
    XcdBarrier b; b.bar = bar; b.x = xb_xcc_id(); b.st = st;
    if (threadIdx.x == 0) (void)xb_add(&bar[XB_XCNT(b.x)], 1u);
    return b;
}
__device__ __forceinline__ void xcd_barrier_complete(unsigned* bar, unsigned x, unsigned& nloc, unsigned& nx) {
    const unsigned G = gridDim.x * gridDim.y * gridDim.z;
    unsigned sum, cnt, mine, sp = 0u;
    for (;;) {
        sum = 0u; cnt = 0u; mine = 0u;
#pragma unroll
        for (unsigned j = 0; j < 16; ++j) { const unsigned c = xb_ld(&bar[XB_XCNT(j)]); sum += c; cnt += (c > 0u) ? 1u : 0u; mine = (j == x) ? c : mine; }
        if (sum == G) break;
        __builtin_amdgcn_s_sleep(1);
        if ((++sp & 255u) == 0u) { if (xb_ld(&bar[XB_TMO])) break; if (sp > XB_SPIN_CAP) { atomicAdd(&bar[XB_TMO], 1u); break; } }
    }
    nloc = mine > 0u ? mine : 1u; nx = cnt > 0u ? cnt : 1u;
}
__device__ __forceinline__ void xcd_barrier(const XcdBarrier& b) {
    asm volatile("s_waitcnt vmcnt(0)" ::: "memory");
    __syncthreads();
    if (threadIdx.x == 0) {
        unsigned* bar = b.bar;
        __builtin_amdgcn_s_waitcnt(0);
        unsigned nloc = b.st[0], nx = b.st[1];
        if (nloc == 0u) { xcd_barrier_complete(bar, b.x, nloc, nx); b.st[0] = nloc; b.st[1] = nx; }
        const unsigned old = xb_add(&bar[XB_XSUB(b.x)], 1u);
        const unsigned gen = old / nloc;
        if (old + 1u == (gen + 1u) * nloc) {
            __builtin_amdgcn_fence(__ATOMIC_RELEASE, "agent");
            asm volatile("s_waitcnt vmcnt(0)" ::: "memory");
            const unsigned og = xb_add(&bar[XB_TOP], 1u);
            const unsigned tg = og / nx;
            if (og + 1u == (tg + 1u) * nx) xb_add(&bar[XB_TOPGEN], 1u);
            else XB_SPIN(xb_ld(&bar[XB_TOPGEN]) == tg, bar);
            __builtin_amdgcn_fence(__ATOMIC_ACQUIRE, "agent");
            xb_add(&bar[XB_XGEN(b.x)], 1u);
            asm volatile("s_waitcnt vmcnt(0)" ::: "memory");
        } else {
            XB_SPIN(xb_ld(&bar[XB_XGEN(b.x)]) == gen, bar);
            __builtin_amdgcn_fence(__ATOMIC_ACQUIRE, "agent");
            asm volatile("s_waitcnt vmcnt(0)" ::: "memory");
        }
    }
    __syncthreads();
}

struct Args { const float* in[19]; float* out; unsigned char* ws; int ph_lo, ph_hi; };
struct Frame {
    LAS unsigned char* lds;
    int tid, lane, wave, vcu, G;
    GAS unsigned char* ws; GAS float* out;
};
template <class T> __device__ __forceinline__ GAS T* uni(T* p) { const unsigned long long v = (unsigned long long)p; const unsigned lo = __builtin_amdgcn_readfirstlane((unsigned)v), hi = __builtin_amdgcn_readfirstlane((unsigned)(v >> 32)); return (GAS T*)(((unsigned long long)hi << 32) | lo); }
__device__ __forceinline__ float wave_sum(float v) {
#pragma unroll
    for (int o = 1; o < 64; o <<= 1) v += __shfl_xor(v, o);
    return v;
}

__host__ __device__ __forceinline__ int sc_in_row(int wcol) { const int type = wcol >> 12, j = wcol & 4095, pn = j >> 6, jj = j & 63; return 256 * pn + 128 * (type >> 1) + 32 * (jj >> 4) + 8 * ((jj >> 2) & 3) + 4 * (type & 1) + (jj & 3); }
template <int SCPERM>
__device__ __forceinline__ void p0_transpose_item(const float* W, int K, int N, const float* ksc, bf16* WT, LAS float* scr, int item, int lane) {
    const int nblk = N / 32, kb = item / nblk, nb = item % nblk, k0 = 64 * kb, n0 = 32 * nb;
#pragma unroll 8
    for (int i = 0; i < 32; ++i) { const int kk = 2 * i + (lane >> 5); scr[kk * 33 + (lane & 31)] = __builtin_nontemporal_load(W + (size_t)(k0 + kk) * N + n0 + (lane & 31)) * ksc[k0 + kk]; }
    LDS_WAIT(); asm volatile("" ::: "memory");
    const int c = lane & 7;
#pragma unroll
    for (int j = 0; j < 4; ++j) { const int n = (lane >> 3) + 8 * j; const LAS float* s = scr + (8 * c) * 33 + n;
        v4u o; o.x = pk2(s[0 * 33], s[1 * 33]); o.y = pk2(s[2 * 33], s[3 * 33]); o.z = pk2(s[4 * 33], s[5 * 33]); o.w = pk2(s[6 * 33], s[7 * 33]);
        const int drow = SCPERM ? sc_in_row(n0 + n) : (n0 + n);
        __builtin_nontemporal_store(o, (v4u*)(WT + (size_t)drow * K + k0 + 8 * c)); }
    LDS_WAIT(); asm volatile("" ::: "memory");
}
constexpr int I_A = (D / 64) * (SSD_PROJ / 32), I_B = (DI / 64) * (D / 32), I_C = (D / 64) * (SC_PROJ / 32), I_D = (D / 64) * (D / 32), I_L = I_A + I_B + I_C + I_D;
constexpr int LATE0_BEGIN = I_L, LATE0_COUNT = 26000;
constexpr int LATE1_BEGIN = I_L + I_A, LATE1_COUNT = 26000;
static_assert(LATE0_COUNT <= I_A && LATE1_COUNT <= I_B + I_C, "late ranges");
__device__ __forceinline__ void p0_item(Frame& F, const Args& A, LAS float* scr, int it) {
    const int j = it / I_L; int r = it % I_L;
    if (r < I_A) { p0_transpose_item<0>(A.in[7] + (size_t)j * D * SSD_PROJ, D, SSD_PROJ, A.in[6] + (size_t)(2 * j) * D, (bf16*)(F.ws + WS_W_SSD_IN + j * SZ_W_SSD_IN1), scr, r, F.lane); return; } r -= I_A;
    if (r < I_B) { p0_transpose_item<0>(A.in[14] + (size_t)j * DI * D, DI, D, A.in[13] + (size_t)j * DI, (bf16*)(F.ws + WS_W_SSD_OUT + j * SZ_W_SSD_OUT1), scr, r, F.lane); return; } r -= I_B;
    if (r < I_C) { p0_transpose_item<1>(A.in[15] + (size_t)j * D * SC_PROJ, D, SC_PROJ, A.in[6] + (size_t)(2 * j + 1) * D, (bf16*)(F.ws + WS_W_SC_IN + j * SZ_W_SC_IN1), scr, r, F.lane); return; } r -= I_C;
    { const float* W = A.in[17] + (size_t)j * D * D; bf16* WT = (bf16*)(F.ws + WS_W_SC_OUT + j * SZ_W_SC_OUT1);
      const int nblk = D / 32, kb = r / nblk, nb = r % nblk, k0 = 64 * kb, n0 = 32 * nb; const int lane = F.lane;
#pragma unroll 8
      for (int i = 0; i < 32; ++i) { const int kk = 2 * i + (lane >> 5); scr[kk * 33 + (lane & 31)] = __builtin_nontemporal_load(W + (size_t)(k0 + kk) * D + n0 + (lane & 31)); }
      LDS_WAIT(); asm volatile("" ::: "memory");
      const int c = lane & 7;
#pragma unroll
      for (int jj = 0; jj < 4; ++jj) { const int n = (lane >> 3) + 8 * jj; const LAS float* s = scr + (8 * c) * 33 + n;
          v4u o; o.x = pk2(s[0 * 33], s[1 * 33]); o.y = pk2(s[2 * 33], s[3 * 33]); o.z = pk2(s[4 * 33], s[5 * 33]); o.w = pk2(s[6 * 33], s[7 * 33]);
          __builtin_nontemporal_store(o, (v4u*)(WT + (size_t)(n0 + n) * D + k0 + 8 * c)); }
      LDS_WAIT(); asm volatile("" ::: "memory"); }
}
__device__ __forceinline__ void late_convert(Frame& F, const Args& A, int begin, int count) {
    constexpr int NWG1 = (M_PAD / 256) * (SSD_PROJ_PAD / 256);
    const int rem = NWG1 % F.G, c = (int)blockIdx.x;
    LAS float* scr = (LAS float*)(F.lds + RING_OFF + F.wave * 16384);
    if (rem == 0) { const int gw = F.vcu * NWAVES + F.wave; for (int it = gw; it < count; it += F.G * NWAVES) p0_item(F, A, scr, begin + it); return; }
    if (c < rem) return;
    const int rank = (c - rem) * NWAVES + F.wave, nw = (F.G - rem) * NWAVES;
    for (int it = rank; it < count; it += nw) p0_item(F, A, scr, begin + it);
}
__device__ __forceinline__ void p0_prologue(Frame& F, const Args& A) {
    LAS float* scr = (LAS float*)(F.lds + RING_OFF + F.wave * 16384);
    const int gw = F.vcu * NWAVES + F.wave, NGW = F.G * NWAVES;
    constexpr int N_EARLY = 2 * I_L - LATE0_COUNT - LATE1_COUNT;
    for (int e = gw; e < N_EARLY; e += NGW) {
        int it = e; if (it >= LATE0_BEGIN) it += LATE0_COUNT; if (it >= LATE1_BEGIN) it += LATE1_COUNT;
        p0_item(F, A, scr, it);
    }
    { const size_t gt = (size_t)F.vcu * 512 + F.tid, GT = (size_t)F.G * 512;
      for (size_t i = gt; i < (size_t)2 * 128 * D / 8; i += GT) { const size_t j = i / (128 * D / 8), o = i % (128 * D / 8);
          *(v4u*)(F.ws + WS_W_SSD_IN + j * SZ_W_SSD_IN1 + (size_t)SSD_PROJ * D * 2 + o * 16) = (v4u){0u, 0u, 0u, 0u}; } }
    bf16* H = (bf16*)(F.ws + WS_H); float* SSQ = (float*)(F.ws + WS_SSQ);
    for (int m = gw; m < M_PAD; m += NGW) {
        const float* src = nullptr;
        if (m < ROW_META) src = A.in[0] + (size_t)m * D;
        else if (m < ROW_SAMPLE) src = A.in[5] + (size_t)((m - ROW_META) & 15) * D;
        else if (m < M_REAL) src = A.in[1] + (size_t)(m - ROW_SAMPLE) * D;
        float s = 0.f;
        f32x4 xa[8], xb[8];
#pragma unroll
        for (int jj = 0; jj < 8; ++jj) {
            if (src) { xa[jj] = __builtin_nontemporal_load((const f32x4*)(src + 8 * (64 * jj + F.lane))); xb[jj] = __builtin_nontemporal_load((const f32x4*)(src + 8 * (64 * jj + F.lane) + 4)); }
            else { xa[jj] = (f32x4){0.f, 0.f, 0.f, 0.f}; xb[jj] = xa[jj]; } }
#pragma unroll
        for (int jj = 0; jj < 8; ++jj) {
            const float f[8] = {xa[jj][0], xa[jj][1], xa[jj][2], xa[jj][3], xb[jj][0], xb[jj][1], xb[jj][2], xb[jj][3]};
#pragma unroll
            for (int e = 0; e < 8; ++e) s += f[e] * f[e];
            *(v4u*)(H + (size_t)m * D + 8 * (64 * jj + F.lane)) = pack8(f);
        }
        s = wave_sum(s);
        SSQ[(size_t)m * 64 + F.lane] = (F.lane == 0) ? s : 0.f;
        if (F.lane == 0) ((float*)(F.ws + WS_RSTD))[m] = rsqrtf(s * (1.f / D) + EPS);
    }
}

struct Seg { int row0, b, k, is_sample, is_last; };
__device__ __forceinline__ Seg seg_decode(int seg) {
    Seg s;
    if (seg < NB * 257) { s.b = seg / 257; s.k = seg % 257; s.is_sample = 0; s.is_last = (s.k == 256);
        s.row0 = (s.k == 0) ? ROW_META + 16 * s.b : s.b * SEQ + 16 * (s.k - 1); }
    else { s.b = seg - NB * 257; s.k = -1; s.is_sample = 1; s.is_last = 1; s.row0 = ROW_SAMPLE + 16 * s.b; }
    return s;
}
__device__ __forceinline__ int seg_halo(const Seg& s, int d) {
    if (s.is_sample || s.k == 0) return -1;
    if (s.k == 1) return ROW_META + 16 * s.b + 16 - d;
    return s.row0 - d;
}
__device__ __forceinline__ float row_rstd8(const float* SSQ, int row, int sub) {
    float s = 0.f;
    if (row >= 0) { const f32x4 a = *(const f32x4*)(SSQ + (size_t)row * 64 + sub * 8), b = *(const f32x4*)(SSQ + (size_t)row * 64 + sub * 8 + 4);
        s = (a[0] + a[1]) + (a[2] + a[3]) + (b[0] + b[1]) + (b[2] + b[3]); }
    s += __shfl_xor(s, 1); s += __shfl_xor(s, 2); s += __shfl_xor(s, 4);
    return row >= 0 ? rsqrtf(s * (1.f / D) + EPS) : 0.f;
}

__device__ __forceinline__ void ssd_conv_phase(Frame& F, const Args& A, int j) {
    const GAS unsigned char* XBCb = F.ws + WS_XBC; GAS unsigned char* XACTb = F.ws + WS_XACT;
    const float* DTRAW = (const float*)(F.ws + WS_DTRAW); float* DT = (float*)(F.ws + WS_DT); const float* RSTD = (const float*)(F.ws + WS_RSTD);
    const float* cw = A.in[8] + (size_t)j * 4 * CONVD; const float* cb = A.in[9] + (size_t)j * CONVD; const float* dtb = A.in[10] + (size_t)j * NH;
    const float* st_in = A.in[3] + (size_t)j * NSB * 3 * CONVD;
    const int NHW = 2 * F.G, hw = 2 * F.vcu + (F.wave >> 2), tl = F.tid & 255;
    const int hpart = hw % 5, rank = hw / 5, nranks = (NHW - hpart + 4) / 5;
    const int c0 = hpart * 2048 + tl * 8; const unsigned voff = (unsigned)c0 * 2u;
#define XBC_ROW(r) (__builtin_nontemporal_load((const GAS v4u*)(XBCb + (size_t)(r) * (CONVD * 2) + voff)))
    float w[4][8], bias[8];
#pragma unroll
    for (int k = 0; k < 4; ++k) { const f32x4 a = *(const f32x4*)(cw + (size_t)k * CONVD + c0), b = *(const f32x4*)(cw + (size_t)k * CONVD + c0 + 4);
        w[k][0] = a[0]; w[k][1] = a[1]; w[k][2] = a[2]; w[k][3] = a[3]; w[k][4] = b[0]; w[k][5] = b[1]; w[k][6] = b[2]; w[k][7] = b[3]; }
    { const f32x4 a = *(const f32x4*)(cb + c0), b = *(const f32x4*)(cb + c0 + 4); bias[0] = a[0]; bias[1] = a[1]; bias[2] = a[2]; bias[3] = a[3]; bias[4] = b[0]; bias[5] = b[1]; bias[6] = b[2]; bias[7] = b[3]; }
    for (int seg = rank; seg < NSEG; seg += nranks) {
        const Seg s = seg_decode(seg);
        float r3[8], r2[8], r1[8];
#pragma unroll
        for (int d = 3; d >= 1; --d) {
            float (&dst)[8] = (d == 3) ? r3 : (d == 2) ? r2 : r1;
            if (s.is_sample) { const float* p = st_in + ((size_t)s.b * 3 + (3 - d)) * CONVD + c0; const f32x4 a = *(const f32x4*)p, b = *(const f32x4*)(p + 4);
                dst[0] = a[0]; dst[1] = a[1]; dst[2] = a[2]; dst[3] = a[3]; dst[4] = b[0]; dst[5] = b[1]; dst[6] = b[2]; dst[7] = b[3]; }
            else { const int hr = seg_halo(s, d);
                if (hr >= 0) { unpack8(XBC_ROW(hr), dst); const float rs = RSTD[hr];
#pragma unroll
                    for (int e = 0; e < 8; ++e) dst[e] *= rs; }
                else {
#pragma unroll
                    for (int e = 0; e < 8; ++e) dst[e] = 0.f; } }
        }
        v4u rawv[16]; float rsv[16];
#pragma unroll
        for (int i = 0; i < 16; ++i) { rawv[i] = XBC_ROW(s.row0 + i); rsv[i] = RSTD[s.row0 + i]; }
#pragma unroll
        for (int i = 0; i < 16; ++i) {
            float cur[8], o[8]; unpack8(rawv[i], cur); const float rs = rsv[i];
#pragma unroll
            for (int e = 0; e < 8; ++e) { cur[e] *= rs; const float v = __builtin_fmaf(w[3][e], cur[e], __builtin_fmaf(w[2][e], r1[e], __builtin_fmaf(w[1][e], r2[e], __builtin_fmaf(w[0][e], r3[e], bias[e])))); o[e] = silu_f(v);
                r3[e] = r2[e]; r2[e] = r1[e]; r1[e] = cur[e]; }
            *(GAS v4u*)(XACTb + (size_t)(s.row0 + i) * (CONVD * 2) + voff) = pack8(o);
        }
        if (s.is_last) {
            GAS float* ob = F.out + (s.is_sample ? O_CONV_S + ((size_t)j * NSB + s.b) * 3 * CONVD : O_CONV_P + ((size_t)j * NB + s.b) * 3 * CONVD) + c0;
            *(GAS f32x4*)(ob) = (f32x4){r3[0], r3[1], r3[2], r3[3]}; *(GAS f32x4*)(ob + 4) = (f32x4){r3[4], r3[5], r3[6], r3[7]};
            *(GAS f32x4*)(ob + CONVD) = (f32x4){r2[0], r2[1], r2[2], r2[3]}; *(GAS f32x4*)(ob + CONVD + 4) = (f32x4){r2[4], r2[5], r2[6], r2[7]};
            *(GAS f32x4*)(ob + 2 * CONVD) = (f32x4){r1[0], r1[1], r1[2], r1[3]}; *(GAS f32x4*)(ob + 2 * CONVD + 4) = (f32x4){r1[4], r1[5], r1[6], r1[7]};
        }
    }
#undef XBC_ROW
    for (size_t i = (size_t)F.vcu * 512 + F.tid; i < (size_t)M_REAL * (NH / 8); i += (size_t)F.G * 512) { const size_t row = i >> 4; const int h0 = (int)(i & 15) * 8; const float rs = RSTD[row];
        const f32x4 a = *(const f32x4*)(DTRAW + row * NH + h0), b = *(const f32x4*)(DTRAW + row * NH + h0 + 4);
        const f32x4 ba = *(const f32x4*)(dtb + h0), bb = *(const f32x4*)(dtb + h0 + 4);
        f32x4 oa, ob;
#pragma unroll
        for (int e = 0; e < 4; ++e) { oa[e] = softplus_f(a[e] * rs + ba[e]); ob[e] = softplus_f(b[e] * rs + bb[e]); }
        *(f32x4*)(DT + row * NH + h0) = oa; *(f32x4*)(DT + row * NH + h0 + 4) = ob; }
}

typedef short s16x4 __attribute__((ext_vector_type(4)));
typedef short bf16x8 __attribute__((ext_vector_type(8)));
#define MFMA16(a, b, c) __builtin_amdgcn_mfma_f32_16x16x32_bf16((a), (b), (c), 0, 0, 0)
__device__ __forceinline__ bf16x8 frag_row(const LAS unsigned char* base, int stride, int row, int kbyte) { return *(const LAS bf16x8*)(base + row * stride + kbyte); }
__device__ __forceinline__ bf16x8 frag_tr(const LAS unsigned char* base, int stride, int k0, int c0, int lane) {
    const int g = lane >> 4, i16 = lane & 15, qq = i16 >> 2, pp = i16 & 3;
    const LAS unsigned char* p = base + (k0 + 8 * g + qq) * stride + (c0 + 4 * pp) * 2;
    const s16x4 lo = __builtin_amdgcn_ds_read_tr16_b64_v4i16((LAS s16x4*)p);
    const s16x4 hi = __builtin_amdgcn_ds_read_tr16_b64_v4i16((LAS s16x4*)(p + 4 * stride));
    return __builtin_shufflevector(lo, hi, 0, 1, 2, 3, 4, 5, 6, 7);
}
__device__ __forceinline__ void ssd_scan_phase(Frame& F, const Args& A, int j) {
    constexpr int S128 = 272, S64 = 144;
    constexpr int OFF_B = 0, OFF_C = 17408, OFF_XD = 34816, OFF_XE = 53248, OFF_L = 71680, OFF_H = 90112, OFF_XD2 = 124928;
    constexpr int SM_ACS = 0, SM_EA = 128, SM_DTD = 256, SM_DTE = 384, SM_ETOT = 512, SM_V = 520, SM_U = 648, SM_STRIDE = 1040;
#define LDS_BARRIER() do { asm volatile("s_waitcnt lgkmcnt(0)" ::: "memory"); __builtin_amdgcn_s_barrier(); asm volatile("" ::: "memory"); } while (0)
    LAS unsigned char* const L = F.lds;
    LAS float* const SM = (LAS float*)(F.lds + SMALL_OFF);
    const bf16* XACT = (const bf16*)(F.ws + WS_XACT); const float* DT = (const float*)(F.ws + WS_DT); bf16* Y = (bf16*)(F.ws + WS_Y);
    const bf16* Z = (const bf16*)(F.ws + WS_Z); float* YSQ = (float*)(F.ws + WS_YSQ);
    LAS float* const PS = SM + 2 * SM_STRIDE;
    const float* a_log = A.in[11] + (size_t)j * NH; const float* d_skip = A.in[12] + (size_t)j * NH;
    const int tid = F.tid, lane = F.lane, w = F.wave, hh = w >> 2, pt = w & 3, q = lane >> 4, l16 = lane & 15;
    for (int item = F.vcu; item < (NB + NSB) * 64; item += F.G) {
        const int is_sample = item >= NB * 64, idx = is_sample ? item - NB * 64 : item, b = idx >> 6, hp = idx & 63, nblocks = is_sample ? 1 : 65;
        const int head = 2 * hp + hh, g = hp >> 3;
        const float Dh = d_skip[head];
        const int sm_h = (w == 4) ? 1 : (w == 6) ? 0 : -1;
        const int head_s = 2 * hp + (sm_h > 0 ? 1 : 0); const float A_own = -__expf(a_log[head_s]);
        f32x4 hacc[8];
        if (is_sample) { const float* sp = A.in[2] + ((((size_t)j * NSB + b) * NH + head) * HD + 16 * pt + l16) * DS + 4 * q;
#pragma unroll
            for (int n8 = 0; n8 < 8; ++n8) hacc[n8] = *(const f32x4*)(sp + 16 * n8); }
        else {
#pragma unroll
            for (int n8 = 0; n8 < 8; ++n8) hacc[n8] = (f32x4){0.f, 0.f, 0.f, 0.f}; }
        v4u pbc[4], px[2];
        int row0 = is_sample ? ROW_SAMPLE + 16 * b : ROW_META + 16 * b, nt = 16;
#define SCAN_PREFETCH(r0_, nt_) do { \
            _Pragma("unroll") for (int k_ = 0; k_ < 4; ++k_) { const int i_ = tid + 512 * k_, mat_ = i_ >> 10, r_ = (i_ >> 4) & 63, c8_ = i_ & 15; \
                pbc[k_] = (r_ < (nt_)) ? *(const v4u*)(XACT + (size_t)((r0_) + r_) * CONVD + DI + mat_ * (NG * DS) + g * DS + c8_ * 8) : (v4u){0u, 0u, 0u, 0u}; } \
            _Pragma("unroll") for (int k_ = 0; k_ < 2; ++k_) { const int i_ = tid + 512 * k_, h2_ = i_ >> 9, r_ = (i_ >> 3) & 63, c8_ = i_ & 7; \
                px[k_] = (r_ < (nt_)) ? *(const v4u*)(XACT + (size_t)((r0_) + r_) * CONVD + (2 * hp + h2_) * HD + c8_ * 8) : (v4u){0u, 0u, 0u, 0u}; } } while (0)
#define SCAN_DTLOAD(r0_, nt_) ((sm_h >= 0 && lane < (nt_)) ? DT[(size_t)((r0_) + lane) * NH + head_s] : 0.f)
#define SCAN_SMALL(dtv_, par_) do { if (sm_h >= 0) { const int hh = sm_h; LAS float* sm_ = SM + (par_) * SM_STRIDE; \
            const float dt_ = (dtv_); float acs_ = dt_ * (A_own * 1.44269504f); \
            _Pragma("unroll") for (int o_ = 1; o_ < 64; o_ <<= 1) { const float v_ = __shfl_up(acs_, o_); if (lane >= o_) acs_ += v_; } \
            const float r0_ = __shfl(acs_, 15), r1_ = __shfl(acs_, 31), r2_ = __shfl(acs_, 47), atot_ = __shfl(acs_, 63); \
            const float myr_ = lane < 16 ? r0_ : lane < 32 ? r1_ : lane < 48 ? r2_ : atot_;              \
            sm_[SM_ACS + hh * 64 + lane] = acs_; sm_[SM_EA + hh * 64 + lane] = __builtin_amdgcn_exp2f(acs_); sm_[SM_DTD + hh * 64 + lane] = dt_; sm_[SM_DTE + hh * 64 + lane] = dt_ * __builtin_amdgcn_exp2f(atot_ - acs_); \
            sm_[SM_V + hh * 64 + lane] = dt_ * __builtin_amdgcn_exp2f(myr_ - acs_); \
            sm_[SM_U + hh * 192 + lane] = __builtin_amdgcn_exp2f(fminf(acs_ - r0_, 0.f)); sm_[SM_U + hh * 192 + 64 + lane] = __builtin_amdgcn_exp2f(fminf(acs_ - r1_, 0.f)); sm_[SM_U + hh * 192 + 128 + lane] = __builtin_amdgcn_exp2f(fminf(acs_ - r2_, 0.f)); \
            if (lane == 0) sm_[SM_ETOT + hh] = __builtin_amdgcn_exp2f(atot_); } } while (0)
#define SCAN_STAGE(par_) do { const LAS float* sm_ = SM + (par_) * SM_STRIDE; \
            _Pragma("unroll") for (int k_ = 0; k_ < 4; ++k_) { const int i_ = tid + 512 * k_, mat_ = i_ >> 10, r_ = (i_ >> 4) & 63, c8_ = i_ & 15; \
                *(LAS v4u*)(L + (mat_ ? OFF_C : OFF_B) + r_ * S128 + c8_ * 16) = pbc[k_]; } \
            _Pragma("unroll") for (int k_ = 0; k_ < 2; ++k_) { const int i_ = tid + 512 * k_, h2_ = i_ >> 9, r_ = (i_ >> 3) & 63, c8_ = i_ & 7; \
                float f_[8], e_[8]; unpack8(px[k_], f_); const float se_ = sm_[SM_DTE + h2_ * 64 + r_]; \
                _Pragma("unroll") for (int e2_ = 0; e2_ < 8; ++e2_) { e_[e2_] = f_[e2_] * se_; } \
                *(LAS v4u*)(L + ((par_) ? OFF_XD2 : OFF_XD) + h2_ * 64 * S64 + r_ * S64 + c8_ * 16) = px[k_]; *(LAS v4u*)(L + OFF_XE + h2_ * 64 * S64 + r_ * S64 + c8_ * 16) = pack8(e_); } } while (0)
#define SCAN_WRITE_HS() do { _Pragma("unroll") for (int n8 = 0; n8 < 8; ++n8) { v2u hw_; hw_.x = pk2(hacc[n8][0], hacc[n8][1]); hw_.y = pk2(hacc[n8][2], hacc[n8][3]); \
            *(LAS v2u*)(L + OFF_H + hh * 64 * S128 + (16 * pt + l16) * S128 + (16 * n8 + 4 * q) * 2) = hw_; } } while (0)
        LDS_BARRIER();
        { const float dt0 = SCAN_DTLOAD(row0, nt); SCAN_PREFETCH(row0, nt); SCAN_SMALL(dt0, 0); }
        float dtA = (nblocks > 1) ? SCAN_DTLOAD(b * SEQ, 64) : 0.f;
        LDS_BARRIER();
        SCAN_STAGE(0);
        SCAN_WRITE_HS();
        int row0p = row0, ntp = nt;
        for (int blk = 0; blk < nblocks; ++blk) {
            const int par = blk & 1; const LAS float* sm = SM + par * SM_STRIDE;
            const bool has_next = blk + 1 < nblocks; const int row0n = b * SEQ + 64 * blk, ntn = 64;
            LDS_BARRIER();
            if (has_next) { SCAN_PREFETCH(row0n, ntn); }
            const float dtB = (blk + 2 < nblocks) ? SCAN_DTLOAD(b * SEQ + 64 * (blk + 1), 64) : 0.f;
            if (blk > 0 && sm_h >= 0) { const float sq = (PS[(sm_h * 4 + 0) * 64 + lane] + PS[(sm_h * 4 + 1) * 64 + lane]) + (PS[(sm_h * 4 + 2) * 64 + lane] + PS[(sm_h * 4 + 3) * 64 + lane]);
                if (lane < ntp) YSQ[(size_t)(row0p + lane) * NH + head_s] = sq; }
            v2u ez[4];
#pragma unroll
            for (int jt = 0; jt < 4; ++jt) { const int t = 16 * jt + l16; const size_t row = (size_t)(row0 + (t < nt ? t : 0));
                ez[jt] = *(const v2u*)(Z + row * DI + head * HD + 16 * pt + 4 * q); }
            { const int it_ = w >> 1, jt0 = 2 * (w & 1);
              if (it_ <= jt0 + 1) {
                  f32x4 g0 = (f32x4){0.f, 0.f, 0.f, 0.f}, g1 = g0;
#pragma unroll
                  for (int ks = 0; ks < 4; ++ks) { const int kb = (32 * ks + 8 * q) * 2;
                      const bf16x8 a = frag_row(L + OFF_B, S128, 16 * it_ + l16, kb), b1 = frag_row(L + OFF_C, S128, 16 * (jt0 + 1) + l16, kb);
                      g1 = MFMA16(a, b1, g1);
                      if (it_ <= jt0) { const bf16x8 b0 = frag_row(L + OFF_C, S128, 16 * jt0 + l16, kb); g0 = MFMA16(a, b0, g0); } }
#pragma unroll
                  for (int h2 = 0; h2 < 2; ++h2) {
#pragma unroll
                      for (int x = 0; x < 2; ++x) { const int jt = jt0 + x, t = 16 * jt + l16; const f32x4 gg = x ? g1 : g0; float v[4];
                          if (it_ > jt) { v[0] = 0.f; v[1] = 0.f; v[2] = 0.f; v[3] = 0.f; }
                          else if (it_ == jt) { const f32x4 as = *(const LAS f32x4*)(sm + SM_ACS + h2 * 64 + 16 * it_ + 4 * q), ds = *(const LAS f32x4*)(sm + SM_DTD + h2 * 64 + 16 * it_ + 4 * q); const float at = sm[SM_ACS + h2 * 64 + t];
#pragma unroll
                              for (int r = 0; r < 4; ++r) { const int s_ = 16 * it_ + 4 * q + r; v[r] = (s_ <= t) ? gg[r] * (ds[r] * __builtin_amdgcn_exp2f(at - as[r])) : 0.f; } }
                          else { const f32x4 vs = *(const LAS f32x4*)(sm + SM_V + h2 * 64 + 16 * it_ + 4 * q); const float ut = sm[SM_U + h2 * 192 + it_ * 64 + t];
#pragma unroll
                              for (int r = 0; r < 4; ++r) v[r] = gg[r] * (ut * vs[r]); }
                          if (it_ <= jt || ((it_ & 1) && it_ == jt + 1)) { v2u lw; lw.x = pk2(v[0], v[1]); lw.y = pk2(v[2], v[3]);
                              *(LAS v2u*)(L + OFF_L + h2 * 64 * S64 + t * S64 + (16 * it_ + 4 * q) * 2) = lw; } } } } }
            f32x4 yacc[4];
#pragma unroll
            for (int jt = 0; jt < 4; ++jt) yacc[jt] = (f32x4){0.f, 0.f, 0.f, 0.f};
#pragma unroll
            for (int ks = 0; ks < 4; ++ks) { const int kb = (32 * ks + 8 * q) * 2; const bf16x8 a = frag_row(L + OFF_H + hh * 64 * S128, S128, 16 * pt + l16, kb);
#pragma unroll
                for (int jt = 0; jt < 4; ++jt) { const bf16x8 bb = frag_row(L + OFF_C, S128, 16 * jt + l16, kb); yacc[jt] = MFMA16(a, bb, yacc[jt]); } }
#pragma unroll
            for (int jt = 0; jt < 4; ++jt) { const float ea = sm[SM_EA + hh * 64 + 16 * jt + l16]; yacc[jt] = yacc[jt] * ea; }
            { const float etot = sm[SM_ETOT + hh];
#pragma unroll
              for (int n8 = 0; n8 < 8; ++n8) hacc[n8] = hacc[n8] * etot;
#pragma unroll
              for (int ks = 0; ks < 2; ++ks) { const bf16x8 bb = frag_tr(L + OFF_XE + hh * 64 * S64, S64, 32 * ks, 16 * pt, lane);
#pragma unroll
                  for (int n8 = 0; n8 < 8; ++n8) { const bf16x8 a = frag_tr(L + OFF_B, S128, 32 * ks, 16 * n8, lane); hacc[n8] = MFMA16(a, bb, hacc[n8]); } } }
            if (has_next) { SCAN_SMALL(dtA, par ^ 1); }
            dtA = dtB;
            LDS_BARRIER();
#pragma unroll
            for (int ks = 0; ks < 2; ++ks) { const bf16x8 a = frag_tr(L + (par ? OFF_XD2 : OFF_XD) + hh * 64 * S64, S64, 32 * ks, 16 * pt, lane); const int kb = (32 * ks + 8 * q) * 2;
#pragma unroll
                for (int jt = 0; jt < 4; ++jt) { if (ks == 1 && jt < 2) continue;
                    const bf16x8 bb = frag_row(L + OFF_L + hh * 64 * S64, S64, 16 * jt + l16, kb); yacc[jt] = MFMA16(a, bb, yacc[jt]); } }
            SCAN_WRITE_HS();
#pragma unroll
            for (int jt = 0; jt < 4; ++jt) { const int t = 16 * jt + l16;
                const v2u xv = *(const LAS v2u*)(L + (par ? OFF_XD2 : OFF_XD) + hh * 64 * S64 + t * S64 + (16 * pt + 4 * q) * 2);
                const float o0 = (yacc[jt][0] + Dh * bflo(xv.x)) * bflo(ez[jt].x), o1 = (yacc[jt][1] + Dh * bfhi(xv.x)) * bfhi(ez[jt].x);
                const float o2 = (yacc[jt][2] + Dh * bflo(xv.y)) * bflo(ez[jt].y), o3 = (yacc[jt][3] + Dh * bfhi(xv.y)) * bfhi(ez[jt].y);
                float ss = (o0 * o0 + o1 * o1) + (o2 * o2 + o3 * o3); ss += __shfl_xor(ss, 16); ss += __shfl_xor(ss, 32);
                if (q == 0) PS[(hh * 4 + pt) * 64 + t] = ss;
                if (t < nt) { v2u ow; ow.x = pk2(o0, o1); ow.y = pk2(o2, o3);
                    *(v2u*)(Y + (size_t)(row0 + t) * DI + head * HD + 16 * pt + 4 * q) = ow; } }
            if (has_next) { SCAN_STAGE(par ^ 1); }
            row0p = row0; ntp = nt; row0 = row0n; nt = ntn;
        }
        LDS_BARRIER();
        if (sm_h >= 0) { const float sq = (PS[(sm_h * 4 + 0) * 64 + lane] + PS[(sm_h * 4 + 1) * 64 + lane]) + (PS[(sm_h * 4 + 2) * 64 + lane] + PS[(sm_h * 4 + 3) * 64 + lane]);
            if (lane < ntp) YSQ[(size_t)(row0p + lane) * NH + head_s] = sq; }
        { GAS float* op = F.out + (is_sample ? O_SSM_S + ((((size_t)j * NSB + b) * NH + head) * HD + 16 * pt + l16) * DS : O_SSM_P + ((((size_t)j * NB + b) * NH + head) * HD + 16 * pt + l16) * DS) + 4 * q;
#pragma unroll
          for (int n8 = 0; n8 < 8; ++n8) *(GAS f32x4*)(op + 16 * n8) = hacc[n8]; }
#undef SCAN_PREFETCH
#undef SCAN_DTLOAD
#undef SCAN_SMALL
#undef SCAN_STAGE
#undef SCAN_WRITE_HS
    }
}

__device__ __forceinline__ void ssd_scale_phase(Frame& F) {
    const float* YSQ = (const float*)(F.ws + WS_YSQ); float* CG = (float*)(F.ws + WS_CG);
    const int gw = F.vcu * NWAVES + F.wave, NGW = F.G * NWAVES;
    for (int m = gw; m < M_PAD; m += NGW) {
        f32x2 v = *(const f32x2*)(YSQ + (size_t)m * NH + 2 * F.lane);
        float sq = (m < M_REAL) ? v[0] + v[1] : 0.f;
        sq += __shfl_xor(sq, 1); sq += __shfl_xor(sq, 2); sq += __shfl_xor(sq, 4);
        if ((F.lane & 7) == 0) CG[(size_t)m * 8 + (F.lane >> 3)] = rsqrtf(sq * (1.f / 1024.f) + EPS);
    }
}

__device__ __forceinline__ void sc_tail_sum(const float* SLAB, int r, int type, int c0, float (&f)[8]) {
#pragma unroll
    for (int e = 0; e < 8; ++e) f[e] = 0.f;
#pragma unroll
    for (int k = 0; k < 4; ++k) { const float* p = SLAB + (size_t)k * (256 * 16384) + (size_t)r * 16384 + type * 4096 + c0; const f32x4 a = *(const f32x4*)p, b = *(const f32x4*)(p + 4);
        f[0] += a[0]; f[1] += a[1]; f[2] += a[2]; f[3] += a[3]; f[4] += b[0]; f[5] += b[1]; f[6] += b[2]; f[7] += b[3]; }
}
__device__ __forceinline__ void sc_elem_phase(Frame& F, const Args& A, int j) {
    const bf16* GC = (const bf16*)(F.ws + WS_GC); const float* SLAB = (const float*)(F.ws + WS_SLAB);
    bf16* Y = (bf16*)(F.ws + WS_Y); const float* RSTD = (const float*)(F.ws + WS_RSTD);
    const float* cw = A.in[16] + (size_t)j * 3 * D; const float* st_in = A.in[4] + (size_t)j * NSB * 2 * D;
    const bool tail_wg = (F.G > 24) && (F.vcu < 12);
    const int c0 = tail_wg ? F.wave * 512 + F.lane * 8 : F.tid * 8;
    float w[3][8];
#pragma unroll
    for (int k = 0; k < 3; ++k) { const f32x4 a = *(const f32x4*)(cw + (size_t)k * D + c0), b = *(const f32x4*)(cw + (size_t)k * D + c0 + 4);
        w[k][0] = a[0]; w[k][1] = a[1]; w[k][2] = a[2]; w[k][3] = a[3]; w[k][4] = b[0]; w[k][5] = b[1]; w[k][6] = b[2]; w[k][7] = b[3]; }
    if (tail_wg || F.G <= 24) {
        for (int t = tail_wg ? F.vcu : 0; t < 12; t += tail_wg ? 12 : 1) {
          for (int sl = tail_wg ? 0 : 0; sl < (tail_wg ? 1 : 8); ++sl) {
            const int cc = tail_wg ? c0 : sl * 512 + F.lane * 8;
            if (!tail_wg && F.wave != 0) continue;
            if (!tail_wg && F.vcu != 0) continue;
            const int seg = (t < 4) ? t * 257 : NB * 257 + (t - 4);
            const Seg s = seg_decode(seg);
            float ww[3][8];
#pragma unroll
            for (int k = 0; k < 3; ++k) { const f32x4 a = *(const f32x4*)(cw + (size_t)k * D + cc), b = *(const f32x4*)(cw + (size_t)k * D + cc + 4);
                ww[k][0] = a[0]; ww[k][1] = a[1]; ww[k][2] = a[2]; ww[k][3] = a[3]; ww[k][4] = b[0]; ww[k][5] = b[1]; ww[k][6] = b[2]; ww[k][7] = b[3]; }
            float r2[8], r1[8];
            if (s.is_sample) {
#pragma unroll
                for (int d = 2; d >= 1; --d) { float (&dst)[8] = (d == 2) ? r2 : r1; const float* p = st_in + ((size_t)s.b * 2 + (2 - d)) * D + cc; const f32x4 a = *(const f32x4*)p, b = *(const f32x4*)(p + 4);
                    dst[0] = a[0]; dst[1] = a[1]; dst[2] = a[2]; dst[3] = a[3]; dst[4] = b[0]; dst[5] = b[1]; dst[6] = b[2]; dst[7] = b[3]; } }
            else {
#pragma unroll
                for (int e = 0; e < 8; ++e) { r2[e] = 0.f; r1[e] = 0.f; } }
            for (int i = 0; i < 16; ++i) { const int row = s.row0 + i; const float rs = RSTD[row], rs2 = rs * rs;
                float gf[8], bf[8], cf[8], vf[8], o[8];
                sc_tail_sum(SLAB, row - ROW_META, 0, cc, gf); sc_tail_sum(SLAB, row - ROW_META, 1, cc, bf); sc_tail_sum(SLAB, row - ROW_META, 2, cc, cf); sc_tail_sum(SLAB, row - ROW_META, 3, cc, vf);
#pragma unroll
                for (int e = 0; e < 8; ++e) { const float cv = cf[e] * vf[e] * rs2; const float conv = ww[0][e] * r2[e] + ww[1][e] * r1[e] + ww[2][e] * cv;
                    o[e] = silu_f(gf[e] * rs) * (bf[e] * rs) * conv; r2[e] = r1[e]; r1[e] = cv; }
                *(v4u*)(Y + (size_t)row * D + cc) = pack8(o); }
            if (s.is_last) {
                GAS float* ob = F.out + O_SC_S + ((size_t)j * NSB + s.b) * 2 * D + cc;
                *(GAS f32x4*)(ob) = (f32x4){r2[0], r2[1], r2[2], r2[3]}; *(GAS f32x4*)(ob + 4) = (f32x4){r2[4], r2[5], r2[6], r2[7]};
                *(GAS f32x4*)(ob + D) = (f32x4){r1[0], r1[1], r1[2], r1[3]}; *(GAS f32x4*)(ob + D + 4) = (f32x4){r1[4], r1[5], r1[6], r1[7]}; }
          }
        }
        if (tail_wg) return;
    }
    const int nwg = tail_wg ? 0 : (F.G > 24 ? F.G - 12 : F.G), rank = (F.G > 24) ? F.vcu - 12 : F.vcu;
    for (int n = rank; n < NB * 256; n += nwg) {
        const int b = n >> 8, k = (n & 255) + 1; const int row0 = b * SEQ + 16 * (k - 1);
        float r2[8], r1[8];
#pragma unroll
        for (int d = 2; d >= 1; --d) {
            float (&dst)[8] = (d == 2) ? r2 : r1;
            const int hr = (k == 1) ? ROW_META + 16 * b + 16 - d : row0 - d;
            if (hr >= ROW_META) { float cf[8], vf[8]; sc_tail_sum(SLAB, hr - ROW_META, 2, c0, cf); sc_tail_sum(SLAB, hr - ROW_META, 3, c0, vf); const float rs = RSTD[hr], rs2 = rs * rs;
#pragma unroll
                for (int e = 0; e < 8; ++e) dst[e] = cf[e] * vf[e] * rs2; }
            else { const v4u q0 = *(const v4u*)(GC + (size_t)hr * 8192 + 2 * c0), q1 = *(const v4u*)(GC + (size_t)hr * 8192 + 2 * c0 + 8);
                dst[0] = bflo(q0.z); dst[1] = bfhi(q0.z); dst[2] = bflo(q0.w); dst[3] = bfhi(q0.w); dst[4] = bflo(q1.z); dst[5] = bfhi(q1.z); dst[6] = bflo(q1.w); dst[7] = bfhi(q1.w); }
        }
        v4u q0v[16], q1v[16];
#pragma unroll
        for (int i = 0; i < 16; ++i) { const size_t off = (size_t)(row0 + i) * D + c0; q0v[i] = __builtin_nontemporal_load((const v4u*)(GC + 2 * off)); q1v[i] = __builtin_nontemporal_load((const v4u*)(GC + 2 * off + 8)); }
#pragma unroll
        for (int i = 0; i < 16; ++i) { const size_t off = (size_t)(row0 + i) * D + c0; const v4u q0 = q0v[i], q1 = q1v[i];
            const float gb[8] = {bflo(q0.x), bfhi(q0.x), bflo(q0.y), bfhi(q0.y), bflo(q1.x), bfhi(q1.x), bflo(q1.y), bfhi(q1.y)};
            const float cv[8] = {bflo(q0.z), bfhi(q0.z), bflo(q0.w), bfhi(q0.w), bflo(q1.z), bfhi(q1.z), bflo(q1.w), bfhi(q1.w)}; float o[8];
#pragma unroll
            for (int e = 0; e < 8; ++e) { o[e] = gb[e] * __builtin_fmaf(w[2][e], cv[e], __builtin_fmaf(w[1][e], r1[e], w[0][e] * r2[e])); r2[e] = r1[e]; r1[e] = cv[e]; }
            *(v4u*)(Y + off) = pack8(o); }
        if (k == 256) {
            GAS float* ob = F.out + O_SC_P + ((size_t)j * NB + b) * 2 * D + c0;
            *(GAS f32x4*)(ob) = (f32x4){r2[0], r2[1], r2[2], r2[3]}; *(GAS f32x4*)(ob + 4) = (f32x4){r2[4], r2[5], r2[6], r2[7]};
            *(GAS f32x4*)(ob + D) = (f32x4){r1[0], r1[1], r1[2], r1[3]}; *(GAS f32x4*)(ob + D + 4) = (f32x4){r1[4], r1[5], r1[6], r1[7]}; }
    }
}

__device__ __forceinline__ void final_phase(Frame& F, const Args& A) {
    const bf16* H = (const bf16*)(F.ws + WS_H); const float* RSTD = (const float*)(F.ws + WS_RSTD); const float* fw = A.in[18];
    const int gw = F.vcu * NWAVES + F.wave, NGW = F.G * NWAVES;
    for (int mm = gw; mm < NB * SEQ + NSB * LS; mm += NGW) {
        const int m = (mm < NB * SEQ) ? mm : mm + (ROW_SAMPLE - ROW_META);
        const float rs = RSTD[m];
        GAS float* orow = F.out + (size_t)mm * D;
        v4u hv[8];
#pragma unroll
        for (int jj = 0; jj < 8; ++jj) hv[jj] = __builtin_nontemporal_load((const v4u*)(H + (size_t)m * D + 8 * (64 * jj + F.lane)));
#pragma unroll
        for (int jj = 0; jj < 8; ++jj) { const int c = 8 * (64 * jj + F.lane); float f[8]; unpack8(hv[jj], f);
            const f32x4 wa = *(const f32x4*)(fw + c), wb = *(const f32x4*)(fw + c + 4);
            __builtin_nontemporal_store((f32x4){f[0] * rs * wa[0], f[1] * rs * wa[1], f[2] * rs * wa[2], f[3] * rs * wa[3]}, (GAS f32x4*)(orow + c));
            __builtin_nontemporal_store((f32x4){f[4] * rs * wb[0], f[5] * rs * wb[1], f[6] * rs * wb[2], f[7] * rs * wb[3]}, (GAS f32x4*)(orow + c + 4)); }
    }
}

__device__ __forceinline__ void tail_fixup_phase(Frame& F) {
    bf16* H = (bf16*)(F.ws + WS_H); float* SSQ = (float*)(F.ws + WS_SSQ); const float* SLAB = (const float*)(F.ws + WS_SLAB); float* RSTD = (float*)(F.ws + WS_RSTD);
    LAS float* red = (LAS float*)(F.lds + SMALL_OFF);
    for (int r = F.vcu; r < 256; r += F.G) {
        const int row = ROW_META + r; const int c = F.tid * 8;
        float f[8]; unpack8(*(const v4u*)(H + (size_t)row * D + c), f);
#pragma unroll
        for (int k = 0; k < 16; ++k) { const float* p = SLAB + (size_t)k * (256 * 4096) + (size_t)r * 4096 + c; const f32x4 a = *(const f32x4*)p, b = *(const f32x4*)(p + 4);
            f[0] += a[0]; f[1] += a[1]; f[2] += a[2]; f[3] += a[3]; f[4] += b[0]; f[5] += b[1]; f[6] += b[2]; f[7] += b[3]; }
        float ss = 0.f;
#pragma unroll
        for (int e = 0; e < 8; ++e) ss += f[e] * f[e];
        *(v4u*)(H + (size_t)row * D + c) = pack8(f);
        ss = wave_sum(ss);
        __syncthreads();
        if (F.lane == 0) red[F.wave] = ss;
        __syncthreads();
        if (F.tid < 64) { float t = 0.f;
#pragma unroll
            for (int k = 0; k < NWAVES; ++k) t += red[k];
            SSQ[(size_t)row * 64 + F.tid] = (F.tid == 0) ? t : 0.f; if (F.tid == 0) RSTD[row] = rsqrtf(t * (1.f / D) + EPS); }
    }
    { const int gw = F.vcu * NWAVES + F.wave, NGW = F.G * NWAVES;
      for (int m = gw; m < M_MAIN; m += NGW) { const float t = wave_sum(SSQ[(size_t)m * 64 + F.lane]); if (F.lane == 0) RSTD[m] = rsqrtf(t * (1.f / D) + EPS); } }
}

enum { T_PRO = 0, T_G1 = 1, T_CONV = 2, T_SCAN = 3, T_NORM = 4, T_G2 = 5, T_FIX2 = 6, T_G3 = 7, T_SCE = 8, T_G4 = 9, T_FIX4 = 10, T_FIN = 11 };
constexpr int N_PHASES = 22;
#ifndef PROBE_TYPES
#define PROBE_TYPES 0
#endif
#define REPS(T) (((PROBE_TYPES >> (T)) & 1) ? 2 : 1)

__global__ void __launch_bounds__(NWAVES * 64, 2) trunk_fwd(Args args) {
    extern __shared__ __attribute__((aligned(16))) unsigned char lds[];
    Frame F;
    F.lds = (LAS unsigned char*)lds;
    F.tid = threadIdx.x; F.lane = F.tid & 63; F.wave = __builtin_amdgcn_readfirstlane(F.tid >> 6);
    F.G = gridDim.x; { const int bx = blockIdx.x; F.vcu = (F.G % 8 == 0) ? (bx % 8) * (F.G / 8) + bx / 8 : bx; }
    const Args& A = args;
    F.ws = uni(args.ws); F.out = uni(args.out);
    for (int u = F.tid; u < (LDS_BYTES - LDSCTL_OFF) / 4; u += NWAVES * 64) ((LAS unsigned*)(F.lds + LDSCTL_OFF))[u] = 0u;
    __syncthreads();
    XcdBarrier bar; bar.bar = (unsigned*)(F.ws + WS_CTL) + CW_BAR; bar.x = 0; bar.st = nullptr;
    const int lo = args.ph_lo, hi = args.ph_hi;
    if (hi - lo > 1) bar = xcd_barrier_post((unsigned*)(F.ws + WS_CTL) + CW_BAR, (volatile LAS unsigned*)(F.lds + MISC_OFF) + 8);
#ifndef PH_OFF
#define PH_OFF(k) 0
#endif
#define IN(k) (!PH_OFF(k) && lo <= (k) && (k) < hi)
#define SEAM(k) do { if (IN(k) && IN((k) + 1)) xcd_barrier(bar); } while (0)

    if (IN(0)) { for (int rep = 0; rep < REPS(T_PRO); ++rep) p0_prologue(F, A); } SEAM(0);

#define LAYER_PAIR(lp) do {\
        const int pb = 1 + 10 * lp;\
        if (IN(pb + 0)) {\
            pg8::Gemm g{(const pg8::bf16_t*)(F.ws + WS_H), (const pg8::bf16_t*)(F.ws + WS_W_SSD_IN + lp * SZ_W_SSD_IN1), M_PAD, SSD_PROJ_PAD, D};\
            pg8::StaticOrder S; S.init(M_PAD, SSD_PROJ_PAD, D, F.G, (int)blockIdx.x);\
            pg8::EpiSsdIn E{(pg8::bf16_t*)(F.ws + WS_Z), (pg8::bf16_t*)(F.ws + WS_XBC), (float*)(F.ws + WS_DTRAW), (const float*)(F.ws + WS_RSTD)};\
            pg8::gemm_phase<pg8::EpiSsdIn, pg8::StaticOrder, true, true>(F.lds + RING_OFF, g, S, E);\
            if (REPS(T_G1) > 1) { pg8::EpiNone E0; pg8::gemm_phase<pg8::EpiNone, pg8::StaticOrder, true, true>(F.lds + RING_OFF, g, S, E0); }\
            late_convert(F, A, lp == 0 ? LATE0_BEGIN : LATE1_BEGIN, lp == 0 ? LATE0_COUNT : LATE1_COUNT);\
        } SEAM(pb + 0);\
        if (IN(pb + 1)) { for (int rep = 0; rep < REPS(T_CONV); ++rep) ssd_conv_phase(F, A, lp); } SEAM(pb + 1);\
        if (IN(pb + 2)) { for (int rep = 0; rep < REPS(T_SCAN); ++rep) ssd_scan_phase(F, A, lp); } SEAM(pb + 2);\
        if (IN(pb + 3)) { ssd_scale_phase(F); } SEAM(pb + 3);\
        if (IN(pb + 4)) {\
            pg8::Gemm g{(const pg8::bf16_t*)(F.ws + WS_Y), (const pg8::bf16_t*)(F.ws + WS_W_SSD_OUT + lp * SZ_W_SSD_OUT1), M_MAIN, D, DI};\
            pg8::TailSplitOrder S; S.init(M_MAIN, D, DI, F.G, (int)blockIdx.x); S.KS = 16;\
            pg8::EpiResidN E{pg8::EpiResid{(pg8::bf16_t*)(F.ws + WS_H), (float*)(F.ws + WS_SSQ), (float*)(F.ws + WS_SLAB)}, (const float*)(F.ws + WS_CG)};\
            pg8::gemm_phase<pg8::EpiResidN, pg8::TailSplitOrder, true, true>(F.lds + RING_OFF, g, S, E);\
        } SEAM(pb + 4);\
        if (IN(pb + 5)) { tail_fixup_phase(F); } SEAM(pb + 5);\
        if (IN(pb + 6)) {\
            pg8::Gemm g{(const pg8::bf16_t*)(F.ws + WS_H), (const pg8::bf16_t*)(F.ws + WS_W_SC_IN + lp * SZ_W_SC_IN1), M_MAIN, SC_PROJ, D};\
            pg8::TailSplitOrder S; S.init(M_MAIN, SC_PROJ, D, F.G, (int)blockIdx.x); S.KS = 4;\
            pg8::EpiScIn E{(pg8::bf16_t*)(F.ws + WS_GC), (const float*)(F.ws + WS_RSTD), (float*)(F.ws + WS_SLAB)};\
            if (REPS(T_G3) > 1) { pg8::EpiNone E0; pg8::gemm_phase<pg8::EpiNone, pg8::TailSplitOrder, true, true>(F.lds + RING_OFF, g, S, E0); }\
            pg8::gemm_phase<pg8::EpiScIn, pg8::TailSplitOrder, true, true>(F.lds + RING_OFF, g, S, E);\
        } SEAM(pb + 6);\
        if (IN(pb + 7)) { for (int rep = 0; rep < REPS(T_SCE); ++rep) sc_elem_phase(F, A, lp); } SEAM(pb + 7);\
        if (IN(pb + 8)) {\
            pg8::Gemm g{(const pg8::bf16_t*)(F.ws + WS_Y), (const pg8::bf16_t*)(F.ws + WS_W_SC_OUT + lp * SZ_W_SC_OUT1), M_MAIN, D, D};\
            pg8::TailSplitOrder S; S.init(M_MAIN, D, D, F.G, (int)blockIdx.x); S.KS = 16;\
            pg8::EpiResid E{(pg8::bf16_t*)(F.ws + WS_H), (float*)(F.ws + WS_SSQ), (float*)(F.ws + WS_SLAB)};\
            if (REPS(T_G4) > 1) { pg8::EpiNone E0; pg8::gemm_phase<pg8::EpiNone, pg8::TailSplitOrder, true, true>(F.lds + RING_OFF, g, S, E0); }\
            pg8::gemm_phase<pg8::EpiResid, pg8::TailSplitOrder, true, true>(F.lds + RING_OFF, g, S, E);\
        } SEAM(pb + 8);\
        if (IN(pb + 9)) { tail_fixup_phase(F); } SEAM(pb + 9);\
    } while (0)
    LAYER_PAIR(0);
    LAYER_PAIR(1);
#undef LAYER_PAIR
    if (IN(21)) { for (int rep = 0; rep < REPS(T_FIN); ++rep) final_phase(F, A); }
#undef IN
#undef SEAM
}

extern "C" void kernel_launch(void* const* d_in, const int* in_sizes, int n_in, void* d_out, int out_size, void* d_ws, size_t ws_size, hipStream_t stream) {
    static int grid = 0;
    if (grid == 0) {
        if (n_in != 19 || (size_t)out_size != O_END || ws_size < WS_END) { fprintf(stderr, "kernel_launch: unexpected shapes: n_in %d out %d ws %zu (need %zu)\n", n_in, out_size, ws_size, (size_t)WS_END); grid = -1; return; }
        int dev = 0, cus = 0, per_cu = 0;
        if (hipGetDevice(&dev) != hipSuccess || hipDeviceGetAttribute(&cus, hipDeviceAttributeMultiprocessorCount, dev) != hipSuccess) { grid = -1; return; }
        if (hipFuncSetAttribute((const void*)trunk_fwd, hipFuncAttributeMaxDynamicSharedMemorySize, LDS_BYTES) != hipSuccess) { fprintf(stderr, "kernel_launch: hipFuncSetAttribute failed\n"); grid = -1; return; }
        if (hipOccupancyMaxActiveBlocksPerMultiprocessor(&per_cu, (const void*)trunk_fwd, NWAVES * 64, LDS_BYTES) != hipSuccess || per_cu < 1)
            fprintf(stderr, "kernel_launch: occupancy query reports %d workgroups per CU\n", per_cu);
        (void)hipGetLastError();
        grid = cus;
    }
    if (grid < 0) return;
    if (hipMemsetAsync((char*)d_ws + WS_CTL, 0, CTL_ZERO_BYTES, stream) != hipSuccess) return;
    Args a{};
    for (int i = 0; i < 19; ++i) a.in[i] = (const float*)d_in[i];
    a.out = (float*)d_out; a.ws = (unsigned char*)d_ws;
#if MK_N_LAUNCHES == 1
    a.ph_lo = 0; a.ph_hi = N_PHASES;
    hipLaunchKernelGGL(trunk_fwd, dim3(grid), dim3(NWAVES * 64), LDS_BYTES, stream, a);
#else
    for (int ph = 0; ph < N_PHASES; ++ph) { a.ph_lo = ph; a.ph_hi = ph + 1; hipLaunchKernelGGL(trunk_fwd, dim3(grid), dim3(NWAVES * 64), LDS_BYTES, stream, a); }
#endif
}
```

```cpp
#include <hip/hip_runtime.h>
#include <cstdio>
#include <cstdint>

#ifndef MK_N_LAUNCHES
#define MK_N_LAUNCHES 1
#endif

namespace pg8 {
#define PG8_LAS __attribute__((address_space(3)))
typedef unsigned short bf16_t;
typedef short bf16x8 __attribute__((ext_vector_type(8)));
typedef float f32x4 __attribute__((ext_vector_type(4)));
typedef unsigned u32x4 __attribute__((ext_vector_type(4)));
constexpr int M_MAIN_PANELS = 64;
constexpr int BM = 256, BK = 64, HALF = 128, HTB = HALF * BK * 2  , STAGE_BYTES = 8 * HTB, NXCD = 8, WGM = 8;

__host__ __device__ __forceinline__ int lds_byte(int r, int c) { const int st = (r >> 4) * 2 + (c >> 5), rr = r & 15, cc = c & 31, ob = rr * 64 + cc * 2; return st * 1024 + (ob ^ (((ob >> 9) & 1) << 5)); }
__host__ __device__ __forceinline__ void stage_rc(int b, int& R, int& C) { const int st = b / 1024, sb = b % 1024, swz = sb ^ (((sb >> 9) & 1) << 5); R = (st >> 1) * 16 + swz / 64; C = (st & 1) * 32 + (swz % 64) / 2; }
__host__ __device__ __forceinline__ int perm32(int rho) { const int n = rho >> 4, i = rho & 15; return 8 * (i >> 2) + 4 * n + (i & 3); }

struct Unit { int pm, pn, kt0, nkt; };
struct Gemm { const bf16_t* A; const bf16_t* Bt; int M, N, K; };

struct StaticOrder {
    int nM, nN, nwg, G, c, nktf;
    __host__ __device__ void init(int M, int N, int K, int G_, int c_) { nM = M / BM; nN = N / BM; nwg = nM * nN; G = G_; c = c_; nktf = K / BK; }
    __host__ __device__ __forceinline__ void main_unit(int L, Unit& u) const {
        int wgid = L; { const int q = nwg / NXCD, r = nwg % NXCD, xcd = wgid % NXCD, off = wgid / NXCD; wgid = (xcd < r ? xcd * (q + 1) : r * (q + 1) + (xcd - r) * q) + off; }
        const int nig = WGM * nN, ngrp = (nM / WGM) > 0 ? (nM / WGM) : 1; int gid = wgid / nig; gid = gid < ngrp ? gid : ngrp - 1;
        const int fm = gid * WGM, gsz = (gid == ngrp - 1) ? (nM - fm) : WGM, w = wgid - gid * nig;
        u.pm = fm + (w % gsz); u.pn = w / gsz; u.kt0 = 0; u.nkt = nktf;
    }
    __host__ __device__ __forceinline__ bool next(int i, Unit& u) const {
        const long L = (long)i * G + c; if (L >= nwg) return false;
        main_unit((int)L, u); return true;
    }
    __device__ __forceinline__ void a_ready(const Unit&) const {}
    __device__ __forceinline__ void done(const Unit&) const {}
    __device__ __forceinline__ unsigned fetch(int) const { return 0u; }
    __device__ __forceinline__ void commit(int, unsigned) const {}
    __device__ __forceinline__ bool resolve(int i, Unit& u) const { return next(i, u); }
};
struct TailSplitOrder : StaticOrder {
    int KS;
    __host__ __device__ __forceinline__ bool next(int i, Unit& u) const {
        const long L = (long)i * G + c; const bool is_main = L < nwg; const long mi = L - nwg;
        if (!is_main && mi >= (long)nN * KS) return false;
        Unit a; main_unit(is_main ? (int)L : 0, a);
        const int mn = nktf / KS, mpn = (int)(mi / KS), mks = (int)(mi % KS);
        u.pm = is_main ? a.pm : nM; u.pn = is_main ? a.pn : mpn; u.kt0 = is_main ? 0 : mks * mn; u.nkt = is_main ? nktf : mn;
        return true;
    }
    __device__ __forceinline__ bool resolve(int i, Unit& u) const { return next(i, u); }
};

struct DynOrder : TailSplitOrder {
    unsigned* ctr; PG8_LAS unsigned* slot; bool dyn;
    __device__ __forceinline__ void setup(unsigned* ctr_, PG8_LAS unsigned* slot_) { ctr = ctr_; slot = slot_; dyn = (G % 8 == 0) && G >= 8; }
    __device__ __forceinline__ bool entry(int k, Unit& u) const {
        const int x = c & 7; const int nmain = (nwg - x + 7) / 8; const bool is_main = k < nmain; const long mi = (long)(k - nmain) * 8 + x;
        if (!is_main && (KS == 0 || mi >= (long)nN * KS)) return false;
        Unit a; main_unit(is_main ? k * 8 + x : 0, a);
        const int ks_ = KS ? KS : 1, mn = nktf / ks_, mpn = (int)(mi / ks_), mks = (int)(mi % ks_);
        u.pm = is_main ? a.pm : nM; u.pn = is_main ? a.pn : mpn; u.kt0 = is_main ? 0 : mks * mn; u.nkt = is_main ? nktf : mn;
        return true;
    }
    __device__ __forceinline__ bool next(int i, Unit& u) const { return dyn ? entry(c >> 3, u) : TailSplitOrder::next(i, u); }
    __device__ __forceinline__ unsigned fetch(int) const { unsigned k = 0u; if (dyn && threadIdx.x == 0) k = (unsigned)(G >> 3) + __hip_atomic_fetch_add(ctr + 64 * (c & 7), 1u, __ATOMIC_RELAXED, __HIP_MEMORY_SCOPE_AGENT); return k; }
    __device__ __forceinline__ void commit(int ui, unsigned k) const { if (dyn && threadIdx.x == 0) slot[(ui + 1) & 1] = k; }
    __device__ __forceinline__ bool resolve(int i, Unit& u) const { if (!dyn) return TailSplitOrder::next(i, u); const int k = __builtin_amdgcn_readfirstlane((int)slot[i & 1]); return entry(k, u); }
};

__device__ __forceinline__ unsigned cvt_pk_bf16(float lo, float hi) { unsigned r; asm volatile("v_cvt_pk_bf16_f32 %0, %1, %2" : "=v"(r) : "v"(lo), "v"(hi)); return r; }

struct EpiSsdIn {
    static constexpr bool PERM = true, AFTER_DRAIN = false, KSCALE = false;
    bf16_t* Z; bf16_t* XBC; float* DTRAW; const float* RSTD;
    __device__ __forceinline__ void operator()(const f32x4 (&acc)[2][2][4][2], const Unit& u, int wr, int wc, int fr, int fq) const {
        const int row0 = u.pm * BM + wr * 64 + fr;
        if (u.pn < 32) {
            const int col0 = u.pn * BM + wc * 32 + 8 * fq;
            float rsv[2][4];
#pragma unroll
            for (int ai = 0; ai < 2; ++ai)
#pragma unroll
                for (int m = 0; m < 4; ++m) rsv[ai][m] = RSTD[row0 + ai * HALF + m * 16];
#pragma unroll
            for (int ai = 0; ai < 2; ++ai)
#pragma unroll
                for (int m = 0; m < 4; ++m) { bf16_t* rowp = Z + (size_t)(row0 + ai * HALF + m * 16) * 8192 + col0; const float rs = rsv[ai][m];
#pragma unroll
                    for (int bj = 0; bj < 2; ++bj) { float g[8];
#pragma unroll
                        for (int e = 0; e < 8; ++e) { const float x = acc[ai][bj][m][e >> 2][e & 3] * rs; g[e] = x * __builtin_amdgcn_rcpf(1.f + __builtin_amdgcn_exp2f(-1.44269504f * x)); }
                        u32x4 w; w.x = cvt_pk_bf16(g[0], g[1]); w.y = cvt_pk_bf16(g[2], g[3]); w.z = cvt_pk_bf16(g[4], g[5]); w.w = cvt_pk_bf16(g[6], g[7]);
                        *(u32x4*)(rowp + bj * HALF) = w; } }
        } else if (u.pn < 72) {
            const int col0 = (u.pn - 32) * BM + wc * 32 + 8 * fq;
#pragma unroll
            for (int ai = 0; ai < 2; ++ai)
#pragma unroll
                for (int m = 0; m < 4; ++m) { bf16_t* rowp = XBC + (size_t)(row0 + ai * HALF + m * 16) * 10240 + col0;
#pragma unroll
                    for (int bj = 0; bj < 2; ++bj) { const f32x4 v0 = acc[ai][bj][m][0], v1 = acc[ai][bj][m][1];
                        u32x4 w; w.x = cvt_pk_bf16(v0[0], v0[1]); w.y = cvt_pk_bf16(v0[2], v0[3]); w.z = cvt_pk_bf16(v1[0], v1[1]); w.w = cvt_pk_bf16(v1[2], v1[3]);
                        *(u32x4*)(rowp + bj * HALF) = w; } }
        } else {
            const int col0 = wc * 32 + 8 * fq;
#pragma unroll
            for (int ai = 0; ai < 2; ++ai)
#pragma unroll
                for (int m = 0; m < 4; ++m) { float* rowp = DTRAW + (size_t)(row0 + ai * HALF + m * 16) * 128 + col0;
                    *(f32x4*)(rowp) = acc[ai][0][m][0]; *(f32x4*)(rowp + 4) = acc[ai][0][m][1]; }
        }
    }
};
struct EpiBf16Plain {
    static constexpr bool PERM = true, AFTER_DRAIN = false, KSCALE = false;
    bf16_t* O; int ldc;
    __device__ __forceinline__ void operator()(const f32x4 (&acc)[2][2][4][2], const Unit& u, int wr, int wc, int fr, int fq) const {
        const int row0 = u.pm * BM + wr * 64 + fr, col0 = u.pn * BM + wc * 32 + 8 * fq;
#pragma unroll
        for (int ai = 0; ai < 2; ++ai)
#pragma unroll
            for (int m = 0; m < 4; ++m) { bf16_t* rowp = O + (size_t)(row0 + ai * HALF + m * 16) * ldc + col0;
#pragma unroll
                for (int bj = 0; bj < 2; ++bj) { const f32x4 v0 = acc[ai][bj][m][0], v1 = acc[ai][bj][m][1];
                    u32x4 w; w.x = cvt_pk_bf16(v0[0], v0[1]); w.y = cvt_pk_bf16(v0[2], v0[3]); w.z = cvt_pk_bf16(v1[0], v1[1]); w.w = cvt_pk_bf16(v1[2], v1[3]);
                    *(u32x4*)(rowp + bj * HALF) = w; } }
    }
};
struct EpiScIn {
    static constexpr bool PERM = true, AFTER_DRAIN = false, KSCALE = false;
    bf16_t* GC; const float* RSTD; float* SLAB;
    __device__ __forceinline__ void operator()(const f32x4 (&acc)[2][2][4][2], const Unit& u, int wr, int wc, int fr, int fq) const {
        const int j0 = u.pn * 64 + wc * 16 + fq * 4;
        if (u.pm >= M_MAIN_PANELS) {
            float* sl = SLAB + (size_t)(u.kt0 / u.nkt) * (256 * 16384) + (size_t)(wr * 64 + fr) * 16384 + j0;
#pragma unroll
            for (int ai = 0; ai < 2; ++ai)
#pragma unroll
                for (int m = 0; m < 4; ++m) { float* p = sl + (size_t)(ai * HALF + m * 16) * 16384;
                    *(f32x4*)(p) = acc[ai][0][m][0]; *(f32x4*)(p + 4096) = acc[ai][0][m][1]; *(f32x4*)(p + 8192) = acc[ai][1][m][0]; *(f32x4*)(p + 12288) = acc[ai][1][m][1]; }
            return;
        }
        const int row0 = u.pm * BM + wr * 64 + fr;
        float rsv[2][4];
#pragma unroll
        for (int ai = 0; ai < 2; ++ai)
#pragma unroll
            for (int m = 0; m < 4; ++m) rsv[ai][m] = RSTD[row0 + ai * HALF + m * 16];
#pragma unroll
        for (int ai = 0; ai < 2; ++ai)
#pragma unroll
            for (int m = 0; m < 4; ++m) { const int row = row0 + ai * HALF + m * 16; const float rs = rsv[ai][m], rs2 = rs * rs;
                const f32x4 g = acc[ai][0][m][0], b = acc[ai][0][m][1], c = acc[ai][1][m][0], v = acc[ai][1][m][1]; float gb[4], cv[4];
#pragma unroll
                for (int e = 0; e < 4; ++e) { const float x = g[e] * rs; gb[e] = x * __builtin_amdgcn_rcpf(1.f + __builtin_amdgcn_exp2f(-1.44269504f * x)) * (b[e] * rs); cv[e] = c[e] * v[e] * rs2; }
                u32x4 w; w.x = cvt_pk_bf16(gb[0], gb[1]); w.y = cvt_pk_bf16(gb[2], gb[3]); w.z = cvt_pk_bf16(cv[0], cv[1]); w.w = cvt_pk_bf16(cv[2], cv[3]);
                *(u32x4*)(GC + (size_t)row * 8192 + 2 * j0) = w; }
    }
};
struct EpiNone {
    static constexpr bool PERM = true, AFTER_DRAIN = false, KSCALE = false;
    __device__ __forceinline__ void operator()(const f32x4 (&acc)[2][2][4][2], const Unit&, int, int, int, int) const {
#pragma unroll
        for (int ai = 0; ai < 2; ++ai)
#pragma unroll
            for (int bj = 0; bj < 2; ++bj)
#pragma unroll
                for (int m = 0; m < 4; ++m) { asm volatile("" :: "v"(acc[ai][bj][m][0]), "v"(acc[ai][bj][m][1])); }
    }
};
__device__ __forceinline__ void kscale_prep(const float* CG, const Unit& u, PG8_LAS float* tbl) {
    int tid = threadIdx.x; asm volatile("" : "+v"(tid));
    if (tid < 256) { const float* p = CG + ((size_t)u.pm * BM + tid) * 8; const f32x4 a = *(const f32x4*)p, b = *(const f32x4*)(p + 4);
        f32x4 ra, rb; ra[0] = b[3]; ra[1] = a[0] * __builtin_amdgcn_rcpf(a[1]); ra[2] = a[1] * __builtin_amdgcn_rcpf(a[2]); ra[3] = a[2] * __builtin_amdgcn_rcpf(a[3]);
        rb[0] = a[3] * __builtin_amdgcn_rcpf(b[0]); rb[1] = b[0] * __builtin_amdgcn_rcpf(b[1]); rb[2] = b[1] * __builtin_amdgcn_rcpf(b[2]); rb[3] = b[2] * __builtin_amdgcn_rcpf(b[3]);
        *(PG8_LAS f32x4*)(tbl + tid * 8) = ra; *(PG8_LAS f32x4*)(tbl + tid * 8 + 4) = rb; }
}
__device__ __forceinline__ void kscale_step(f32x4 (&acc)[2][2][4][2], const PG8_LAS float* tbl, int g, int, int) {
    int tz = threadIdx.x; asm volatile("" : "+v"(tz)); const int wr = tz >> 8, fr = tz & 15;
#pragma unroll
    for (int ai = 0; ai < 2; ++ai)
#pragma unroll
        for (int m = 0; m < 4; ++m) { const int r = ai * HALF + wr * 64 + m * 16 + fr; const float ratio = tbl[r * 8 + g];
#pragma unroll
            for (int bj = 0; bj < 2; ++bj)
#pragma unroll
                for (int n = 0; n < 2; ++n) acc[ai][bj][m][n] = acc[ai][bj][m][n] * ratio; }
}
struct EpiResid {
    static constexpr bool PERM = true, AFTER_DRAIN = false, KSCALE = false;
    bf16_t* H; float* SSQ; float* SLAB;
    __device__ __forceinline__ void operator()(const f32x4 (&acc)[2][2][4][2], const Unit& u, int wr, int wc, int fr, int fq) const {
        const int row0 = u.pm * BM + wr * 64 + fr, col0 = u.pn * BM + wc * 32 + 8 * fq;
        if (u.pm >= M_MAIN_PANELS) {
            float* sl = SLAB + (size_t)(u.kt0 / u.nkt) * (256 * 4096) + (size_t)(wr * 64 + fr) * 4096 + col0;
#pragma unroll
            for (int ai = 0; ai < 2; ++ai)
#pragma unroll
                for (int m = 0; m < 4; ++m)
#pragma unroll
                    for (int bj = 0; bj < 2; ++bj) { float* p = sl + (size_t)(ai * HALF + m * 16) * 4096 + bj * HALF; *(f32x4*)p = acc[ai][bj][m][0]; *(f32x4*)(p + 4) = acc[ai][bj][m][1]; }
            return;
        }
        const unsigned off0 = ((unsigned)row0 * 4096u + (unsigned)col0) * 2u;
        const char* hb = (const char*)H;
#pragma unroll
        for (int ai = 0; ai < 2; ++ai) {
            u32x4 old[4][2];
#pragma unroll
            for (int m = 0; m < 4; ++m)
#pragma unroll
                for (int bj = 0; bj < 2; ++bj) old[m][bj] = *(const u32x4*)(hb + (off0 + (unsigned)((ai * HALF + m * 16) * 4096 + bj * HALF) * 2u));
#pragma unroll
            for (int m = 0; m < 4; ++m) { const int row = row0 + ai * HALF + m * 16; float ss = 0.f;
#pragma unroll
                for (int bj = 0; bj < 2; ++bj) { const u32x4 o = old[m][bj];
                    f32x4 v0 = acc[ai][bj][m][0], v1 = acc[ai][bj][m][1];
                    v0[0] += __uint_as_float(o.x << 16); v0[1] += __uint_as_float(o.x & 0xffff0000u); v0[2] += __uint_as_float(o.y << 16); v0[3] += __uint_as_float(o.y & 0xffff0000u);
                    v1[0] += __uint_as_float(o.z << 16); v1[1] += __uint_as_float(o.z & 0xffff0000u); v1[2] += __uint_as_float(o.w << 16); v1[3] += __uint_as_float(o.w & 0xffff0000u);
                    ss += (v0[0] * v0[0] + v0[1] * v0[1]) + (v0[2] * v0[2] + v0[3] * v0[3]) + (v1[0] * v1[0] + v1[1] * v1[1]) + (v1[2] * v1[2] + v1[3] * v1[3]);
                    u32x4 w; w.x = cvt_pk_bf16(v0[0], v0[1]); w.y = cvt_pk_bf16(v0[2], v0[3]); w.z = cvt_pk_bf16(v1[0], v1[1]); w.w = cvt_pk_bf16(v1[2], v1[3]);
                    *(u32x4*)((char*)H + (off0 + (unsigned)((ai * HALF + m * 16) * 4096 + bj * HALF) * 2u)) = w; }
                ss += __shfl_xor(ss, 16); ss += __shfl_xor(ss, 32);
                if (fq == 0) SSQ[(size_t)row * 64 + u.pn * 4 + wc] = ss; }
        }
    }
};

struct EpiResidN {
    static constexpr bool PERM = true, AFTER_DRAIN = false, KSCALE = true;
    EpiResid R; const float* CG;
    __device__ __forceinline__ void prep(const Unit& u, PG8_LAS float* tbl) const { kscale_prep(CG, u, tbl); }
    __device__ __forceinline__ void operator()(f32x4 (&acc)[2][2][4][2], const Unit& u, int, int, int, int, const PG8_LAS float* tbl) const {
        int tz = threadIdx.x; asm volatile("" : "+v"(tz)); const int wid = tz >> 6, lane = tz & 63, wr = wid >> 2, wc = wid & 3, fr = lane & 15, fq = lane >> 4;
        const int g = (u.pm >= M_MAIN_PANELS) ? (u.kt0 >> 4) : 7;
#pragma unroll
        for (int ai = 0; ai < 2; ++ai)
#pragma unroll
            for (int m = 0; m < 4; ++m) { const PG8_LAS float* tr = tbl + (ai * HALF + wr * 64 + m * 16 + fr) * 8; float c = tr[0];
                for (int k = 7; k > g; --k) c *= tr[k];
#pragma unroll
                for (int bj = 0; bj < 2; ++bj)
#pragma unroll
                    for (int n = 0; n < 2; ++n) acc[ai][bj][m][n] = acc[ai][bj][m][n] * c; }
        R(acc, u, wr, wc, fr, fq);
    }
};

template <class Epi, class Sched, bool ALIGN_EPI = false, bool SP2 = false>
__device__ __forceinline__ void gemm_phase(PG8_LAS unsigned char* lds, const Gemm g, const Sched& S, const Epi& E) {
    const int tid = threadIdx.x, wid = __builtin_amdgcn_readfirstlane(tid >> 6), lane = tid & 63, wr = wid >> 2, wc = wid & 3, fr = lane & 15, fq = lane >> 4;
    const int K = g.K;
    unsigned voffA, voffB;
    { int R, C; stage_rc(tid * 16, R, C); const int Rb = Epi::PERM ? ((R & ~31) + perm32(R & 31)) : R; voffA = (unsigned)(R * K + C) * 2u; voffB = (unsigned)(Rb * K + C) * 2u; }
    const size_t rstep = (size_t)64 * K * 2;
    const size_t kstep = (size_t)(BK * 2);
    const size_t hstep = (size_t)HALF * K * 2;
    const size_t tstep = 2 * hstep;
    const unsigned ldsw = (unsigned)wid * 1024u;
    const int aoff = lds_byte(wr * 64 + fr, fq * 8), boff = lds_byte(wc * 32 + fr, fq * 8);
#define PG8_SA(b, h) (((b) * 2 + (h)) * HTB)
#define PG8_SB(b, h) ((4 + (b) * 2 + (h)) * HTB)
#define PG8_STAGE(bufoff, gbase, voff) do { _Pragma("unroll") for (int _i = 0; _i < 2; ++_i) \
        __builtin_amdgcn_global_load_lds((const unsigned*)((const char*)(gbase) + (size_t)_i * rstep + (voff)), (PG8_LAS unsigned*)(lds + (bufoff) + ldsw + _i * 8192), 16, 0, 0); } while (0)
#define PG8_LDA(dst, b, h) do { _Pragma("unroll") for (int m = 0; m < 4; ++m) _Pragma("unroll") for (int k = 0; k < 2; ++k) dst[m][k] = *(const PG8_LAS bf16x8*)(lds + PG8_SA(b, h) + aoff + m * 2048 + k * 1024); } while (0)
#define PG8_LDB(dst, b, h) do { _Pragma("unroll") for (int n = 0; n < 2; ++n) _Pragma("unroll") for (int k = 0; k < 2; ++k) dst[n][k] = *(const PG8_LAS bf16x8*)(lds + PG8_SB(b, h) + boff + n * 2048 + k * 1024); } while (0)
#define PG8_MMA(ai, bj, At, Bt) do { __builtin_amdgcn_s_setprio(1); _Pragma("unroll") for (int m = 0; m < 4; ++m) _Pragma("unroll") for (int n = 0; n < 2; ++n) _Pragma("unroll") for (int k = 0; k < 2; ++k) \
        acc[ai][bj][m][n] = __builtin_amdgcn_mfma_f32_16x16x32_bf16(Bt[n][k], At[m][k], acc[ai][bj][m][n], 0, 0, 0); __builtin_amdgcn_s_setprio(0); } while (0)
#define PG8_WAIT_V(n) asm volatile("s_waitcnt vmcnt(" #n ")" ::: "memory")
#define PG8_WAIT_L(n) asm volatile("s_waitcnt lgkmcnt(" #n ")" ::: "memory")
#define PG8_BAR __builtin_amdgcn_s_barrier()
#define PG8_SCHED __builtin_amdgcn_sched_barrier(0)
    Unit cur, nxt; int ui = 0;
    if (!S.next(0, cur)) return;
    PG8_LAS float* const ktbl = (PG8_LAS float*)(lds + STAGE_BYTES);
    f32x4 acc[2][2][4][2];
#pragma unroll
    for (int a = 0; a < 2; ++a)
#pragma unroll
        for (int b = 0; b < 2; ++b)
#pragma unroll
            for (int m = 0; m < 4; ++m)
#pragma unroll
                for (int n = 0; n < 2; ++n) acc[a][b][m][n] = (f32x4){0.f, 0.f, 0.f, 0.f};
    bf16x8 At[4][2], B0[2][2], B1[2][2];
    const char* cA = (const char*)g.A + (size_t)cur.pm * tstep + (size_t)cur.kt0 * kstep; const char* cB = (const char*)g.Bt + (size_t)cur.pn * tstep + (size_t)cur.kt0 * kstep;
    S.a_ready(cur);
    if constexpr (Epi::KSCALE) E.prep(cur, ktbl);
    if constexpr (SP2) {
        PG8_STAGE(PG8_SB(0, 0), cB, voffB); PG8_STAGE(PG8_SB(0, 1), cB + hstep, voffB); PG8_STAGE(PG8_SA(0, 0), cA, voffA); PG8_STAGE(PG8_SA(0, 1), cA + hstep, voffA);
        if (wr == 1) PG8_BAR;
        PG8_WAIT_V(2); PG8_BAR;
        PG8_STAGE(PG8_SB(1, 0), cB + kstep, voffB); PG8_STAGE(PG8_SA(1, 0), cA + kstep, voffA); PG8_STAGE(PG8_SB(1, 1), cB + hstep + kstep, voffB);
        PG8_WAIT_V(6); PG8_BAR;
    } else {
        PG8_STAGE(PG8_SB(0, 0), cB, voffB); PG8_STAGE(PG8_SA(0, 0), cA, voffA); PG8_STAGE(PG8_SB(0, 1), cB + hstep, voffB); PG8_STAGE(PG8_SA(0, 1), cA + hstep, voffA);
        if (wr == 1) PG8_BAR;
        PG8_WAIT_V(4); PG8_BAR;
        PG8_STAGE(PG8_SB(1, 0), cB + kstep, voffB); PG8_STAGE(PG8_SA(1, 0), cA + kstep, voffA); PG8_STAGE(PG8_SB(1, 1), cB + hstep + kstep, voffB);
        PG8_WAIT_V(6); PG8_BAR;
    }
    for (;;) {
        const unsigned kclaim = S.fetch(ui);
        bool has_next = false; const char* nA = cA; const char* nB = cB;
        const int nt = cur.nkt;
        for (int t = 0; t < nt; t += 2) {
            const bool last = (t == nt - 2);
            if (t == (nt > 4 ? 2 : 0)) S.commit(ui, kclaim);
            if (last) { has_next = S.resolve(ui + 1, nxt);
                if (has_next) { nA = (const char*)g.A + (size_t)nxt.pm * tstep + (size_t)nxt.kt0 * kstep; nB = (const char*)g.Bt + (size_t)nxt.pn * tstep + (size_t)nxt.kt0 * kstep; } }
            const char* a1 = cA + (size_t)(t + 1) * kstep;
            const char* a2 = last ? nA : cA + (size_t)(t + 2) * kstep; const char* b2 = last ? nB : cB + (size_t)(t + 2) * kstep;
            const char* a3 = a2 + kstep; const char* b3 = b2 + kstep;
            if (last && has_next) S.a_ready(nxt);
            if constexpr (Epi::KSCALE) { const int kt = cur.kt0 + t; if (t > 0 && (kt & 15) == 0) kscale_step(acc, ktbl + (ui & 1) * 2048, kt >> 4, wr, fr); }
            if constexpr (SP2) {
            PG8_LDB(B0, 0, 0); PG8_LDB(B1, 0, 1); PG8_SCHED; PG8_LDA(At, 0, 0); PG8_STAGE(PG8_SA(1, 1), a1 + hstep, voffA);
            PG8_WAIT_V(8); PG8_WAIT_L(0); PG8_BAR; PG8_MMA(0, 0, At, B0); PG8_MMA(0, 1, At, B1); PG8_BAR; PG8_SCHED;
            PG8_LDA(At, 0, 1); PG8_STAGE(PG8_SB(0, 0), b2, voffB); PG8_STAGE(PG8_SB(0, 1), b2 + hstep, voffB); PG8_STAGE(PG8_SA(0, 0), a2, voffA);
            PG8_WAIT_V(8); PG8_WAIT_L(0); PG8_BAR; PG8_MMA(1, 0, At, B0); PG8_MMA(1, 1, At, B1); PG8_BAR; PG8_SCHED;
            PG8_LDB(B0, 1, 0); PG8_LDB(B1, 1, 1); PG8_SCHED; PG8_LDA(At, 1, 0); PG8_STAGE(PG8_SA(0, 1), a2 + hstep, voffA);
            PG8_WAIT_V(8); PG8_WAIT_L(0); PG8_BAR; PG8_MMA(0, 0, At, B0); PG8_MMA(0, 1, At, B1); PG8_BAR; PG8_SCHED;
            PG8_LDA(At, 1, 1); PG8_STAGE(PG8_SB(1, 0), b3, voffB); PG8_STAGE(PG8_SB(1, 1), b3 + hstep, voffB); PG8_STAGE(PG8_SA(1, 0), a3, voffA);
            PG8_WAIT_V(8); PG8_WAIT_L(0); PG8_BAR; PG8_MMA(1, 0, At, B0); PG8_MMA(1, 1, At, B1); PG8_BAR; PG8_SCHED;
            } else {
            PG8_LDB(B0, 0, 0); PG8_SCHED; PG8_LDA(At, 0, 0); PG8_STAGE(PG8_SA(1, 1), a1 + hstep, voffA);
            PG8_WAIT_L(8); PG8_BAR; PG8_WAIT_L(0); PG8_MMA(0, 0, At, B0); PG8_BAR; PG8_SCHED;
            PG8_LDB(B1, 0, 1); PG8_STAGE(PG8_SB(0, 0), b2, voffB);
            PG8_BAR; PG8_WAIT_L(0); PG8_MMA(0, 1, At, B1); PG8_BAR;
            PG8_LDA(At, 0, 1); PG8_STAGE(PG8_SA(0, 0), a2, voffA);
            PG8_BAR; PG8_WAIT_L(0); PG8_MMA(1, 0, At, B0); PG8_BAR; PG8_SCHED;
            PG8_STAGE(PG8_SB(0, 1), b2 + hstep, voffB);
            PG8_WAIT_V(6); PG8_BAR; PG8_MMA(1, 1, At, B1); PG8_BAR;
            PG8_LDB(B0, 1, 0); PG8_SCHED; PG8_LDA(At, 1, 0); PG8_STAGE(PG8_SA(0, 1), a2 + hstep, voffA);
            PG8_WAIT_L(8); PG8_BAR; PG8_WAIT_L(0); PG8_MMA(0, 0, At, B0); PG8_BAR; PG8_SCHED;
            PG8_LDB(B1, 1, 1); PG8_STAGE(PG8_SB(1, 0), b3, voffB);
            PG8_BAR; PG8_WAIT_L(0); PG8_MMA(0, 1, At, B1); PG8_BAR;
            PG8_LDA(At, 1, 1); PG8_STAGE(PG8_SA(1, 0), a3, voffA);
            PG8_BAR; PG8_WAIT_L(0); PG8_MMA(1, 0, At, B0); PG8_BAR; PG8_SCHED;
            PG8_STAGE(PG8_SB(1, 1), b3 + hstep, voffB);
            PG8_WAIT_V(6); PG8_BAR; PG8_MMA(1, 1, At, B1); PG8_BAR;
            }
        }
        if constexpr (ALIGN_EPI) { if (wr == 0) PG8_BAR; }
        if constexpr (Epi::KSCALE) { E(acc, cur, wr, wc, fr, fq, ktbl + (ui & 1) * 2048); if (has_next) E.prep(nxt, ktbl + ((ui + 1) & 1) * 2048); }
        else E(acc, cur, wr, wc, fr, fq);
        S.done(cur);
        if (!has_next) break;
#pragma unroll
        for (int a = 0; a < 2; ++a)
#pragma unroll
            for (int b = 0; b < 2; ++b)
#pragma unroll
                for (int m = 0; m < 4; ++m)
#pragma unroll
                    for (int n = 0; n < 2; ++n) acc[a][b][m][n] = (f32x4){0.f, 0.f, 0.f, 0.f};
        cur = nxt; cA = nA; cB = nB; ++ui;
        if constexpr (ALIGN_EPI) { if (wr == 1) PG8_BAR; }
    }
    PG8_WAIT_V(0);
    if constexpr (!ALIGN_EPI) { if (wr == 0) PG8_BAR; }
    PG8_BAR;
#undef PG8_SA
#undef PG8_SB
#undef PG8_STAGE
#undef PG8_LDA
#undef PG8_LDB
#undef PG8_MMA
#undef PG8_WAIT_V
#undef PG8_WAIT_L
#undef PG8_BAR
#undef PG8_SCHED
}
}

constexpr int D = 4096, DI = 8192, NH = 128, HD = 64, NG = 8, DS = 128, CONVD = 10240;
constexpr int SSD_PROJ = 18560, SSD_PROJ_PAD = 18688, SC_PROJ = 16384;
constexpr int NB = 4, SEQ = 4096, NMETA = 16, NSB = 8, LS = 16;
constexpr int ROW_META = 16384, ROW_SAMPLE = 16448, M_REAL = 16576, M_PAD = 16640, M_MAIN = 16384;
constexpr int NSEG = 1036;
constexpr float EPS = 1e-5f;
constexpr int NWAVES = 8;

constexpr size_t MiB = 1u << 20;
constexpr size_t WS_CTL = 0, CTL_ZERO_BYTES = 1 * MiB;
constexpr size_t SZ_W_SSD_IN1 = (size_t)SSD_PROJ_PAD * D * 2, SZ_W_SSD_OUT1 = (size_t)D * DI * 2, SZ_W_SC_IN1 = (size_t)SC_PROJ * D * 2, SZ_W_SC_OUT1 = (size_t)D * D * 2;
constexpr size_t WS_W_SSD_IN = 1 * MiB;
constexpr size_t WS_W_SSD_OUT = WS_W_SSD_IN + 2 * SZ_W_SSD_IN1;
constexpr size_t WS_W_SC_IN = WS_W_SSD_OUT + 2 * SZ_W_SSD_OUT1;
constexpr size_t WS_W_SC_OUT = WS_W_SC_IN + 2 * SZ_W_SC_IN1;
constexpr size_t WS_H = WS_W_SC_OUT + 2 * SZ_W_SC_OUT1;
constexpr size_t WS_SSQ = WS_H + (size_t)M_PAD * D * 2;
constexpr size_t WS_PROJ = WS_SSQ + (size_t)M_PAD * 64 * 4;
constexpr size_t SZ_Z = (size_t)M_PAD * DI * 2, SZ_XBC = (size_t)M_PAD * CONVD * 2, SZ_DT = (size_t)M_PAD * NH * 4;
constexpr size_t WS_Z = WS_PROJ, WS_XBC = WS_Z + SZ_Z, WS_DTRAW = WS_XBC + SZ_XBC;
constexpr size_t WS_GC = WS_PROJ;
constexpr size_t WS_XACT = WS_DTRAW + SZ_DT;
constexpr size_t WS_YN = WS_XACT;
constexpr size_t WS_DT = WS_XACT + SZ_XBC;
constexpr size_t WS_Y = WS_DT + SZ_DT;
constexpr size_t WS_YSQ = WS_Y + SZ_Z;
constexpr size_t WS_RSTD = WS_YSQ + 4 * SZ_DT;
constexpr size_t WS_SLAB = WS_RSTD + (size_t)M_PAD * 4;
constexpr size_t WS_CG = WS_SLAB + (size_t)16 * 256 * 4096 * 4;
constexpr size_t WS_END = WS_CG + (size_t)M_PAD * 8 * 4;
static_assert((size_t)M_PAD * SC_PROJ * 2 <= SZ_Z + SZ_XBC + SZ_DT, "SC projection overlays the SSD projection region");
static_assert(WS_END % 256 == 0 && WS_XACT % 256 == 0 && WS_Y % 256 == 0, "alignment");
constexpr int CW_BAR = 4096;

constexpr size_t O_YP = 0, O_YS = O_YP + (size_t)NB * SEQ * D, O_SSM_P = O_YS + (size_t)NSB * LS * D, O_CONV_P = O_SSM_P + (size_t)2 * NB * NH * HD * DS,
                 O_SC_P = O_CONV_P + (size_t)2 * NB * 3 * CONVD, O_SSM_S = O_SC_P + (size_t)2 * NB * 2 * D, O_CONV_S = O_SSM_S + (size_t)2 * NSB * NH * HD * DS,
                 O_SC_S = O_CONV_S + (size_t)2 * NSB * 3 * CONVD, O_END = O_SC_S + (size_t)2 * NSB * 2 * D;

constexpr int RING_OFF = 0, RING_BYTES = 131072;
constexpr int LDS_BYTES = 163840;
constexpr int SMALL_OFF = 147456;
constexpr int LDSCTL_OFF = LDS_BYTES - 512, MISC_OFF = LDSCTL_OFF + 320;

#define GAS __attribute__((address_space(1)))
#define LAS __attribute__((address_space(3)))
typedef unsigned short bf16;
typedef unsigned v4u __attribute__((ext_vector_type(4)));
typedef unsigned v2u __attribute__((ext_vector_type(2)));
typedef float f32x4 __attribute__((ext_vector_type(4)));
typedef float f32x2 __attribute__((ext_vector_type(2)));
typedef GAS unsigned gu32;
#define RLX_AGENT __ATOMIC_RELAXED, __HIP_MEMORY_SCOPE_AGENT
#define LDS_WAIT() asm volatile("s_waitcnt lgkmcnt(0)" ::: "memory")
#define VM_WAIT() asm volatile("s_waitcnt vmcnt(0)" ::: "memory")
__device__ __forceinline__ unsigned pk2(float lo, float hi) { return pg8::cvt_pk_bf16(lo, hi); }
__device__ __forceinline__ float bflo(unsigned u) { return __uint_as_float(u << 16); }
__device__ __forceinline__ float bfhi(unsigned u) { return __uint_as_float(u & 0xffff0000u); }
__device__ __forceinline__ void unpack8(const v4u w, float (&f)[8]) { f[0] = bflo(w.x); f[1] = bfhi(w.x); f[2] = bflo(w.y); f[3] = bfhi(w.y); f[4] = bflo(w.z); f[5] = bfhi(w.z); f[6] = bflo(w.w); f[7] = bfhi(w.w); }
__device__ __forceinline__ v4u pack8(const float (&f)[8]) { v4u o; o.x = pk2(f[0], f[1]); o.y = pk2(f[2], f[3]); o.z = pk2(f[4], f[5]); o.w = pk2(f[6], f[7]); return o; }
__device__ __forceinline__ float silu_f(float x) { return x * __builtin_amdgcn_rcpf(1.f + __expf(-x)); }
__device__ __forceinline__ float softplus_f(float x) { return fmaxf(x, 0.f) + log1pf(__expf(-fabsf(x))); }

#define XB_TMO      128
#define XB_XCNT(j)  (256  + 64 * (j))
#define XB_XSUB(j)  (1280 + 64 * (j))
#define XB_XGEN(j)  (2304 + 64 * (j))
#define XB_TOP      3328
#define XB_TOPGEN   3392
#define XCD_BAR_WORDS 3456
#define XB_SPIN_CAP (1u << 18)
__device__ __forceinline__ unsigned xb_ld(unsigned* p)              { return __hip_atomic_load(p, __ATOMIC_RELAXED, __HIP_MEMORY_SCOPE_AGENT); }
__device__ __forceinline__ unsigned xb_add(unsigned* p, unsigned v) { return __hip_atomic_fetch_add(p, v, __ATOMIC_RELAXED, __HIP_MEMORY_SCOPE_AGENT); }
__device__ __forceinline__ unsigned xb_xcc_id() { return (unsigned)__builtin_amdgcn_s_getreg((3 << 11) | 20) & 0xFu; }
#define XB_SPIN(cond, bar) do { unsigned _sp = 0; while (cond) { __builtin_amdgcn_s_sleep(1); \
    if ((++_sp & 255u) == 0u) { if (xb_ld(&(bar)[XB_TMO])) break; if (_sp > XB_SPIN_CAP) { atomicAdd(&(bar)[XB_TMO], 1u); break; } } } } while (0)
struct XcdBarrier { unsigned* bar; unsigned x; volatile LAS unsigned* st; };
__device__ __forceinline__ XcdBarrier xcd_barrier_post(unsigned* bar, volatile LAS unsigned* st) {
    XcdBarrier b; b.bar = bar; b.x = xb_xcc_id(); b.st = st;
    if (threadIdx.x == 0) (void)xb_add(&bar[XB_XCNT(b.x)], 1u);
    return b;
}
__device__ __forceinline__ void xcd_barrier_complete(unsigned* bar, unsigned x, unsigned& nloc, unsigned& nx) {
    const unsigned G = gridDim.x * gridDim.y * gridDim.z;
    unsigned sum, cnt, mine, sp = 0u;
    for (;;) {
        sum = 0u; cnt = 0u; mine = 0u;
#pragma unroll
        for (unsigned j = 0; j < 16; ++j) { const unsigned c = xb_ld(&bar[XB_XCNT(j)]); sum += c; cnt += (c > 0u) ? 1u : 0u; mine = (j == x) ? c : mine; }
        if (sum == G) break;
        __builtin_amdgcn_s_sleep(1);
        if ((++sp & 255u) == 0u) { if (xb_ld(&bar[XB_TMO])) break; if (sp > XB_SPIN_CAP) { atomicAdd(&bar[XB_TMO], 1u); break; } }
    }
    nloc = mine > 0u ? mine : 1u; nx = cnt > 0u ? cnt : 1u;
}
__device__ __forceinline__ void xcd_barrier(const XcdBarrier& b) {
    asm volatile("s_waitcnt vmcnt(0)" ::: "memory");
    __syncthreads();
    if (threadIdx.x == 0) {
        unsigned* bar = b.bar;
        __builtin_amdgcn_s_waitcnt(0);
        unsigned nloc = b.st[0], nx = b.st[1];
        if (nloc == 0u) { xcd_barrier_complete(bar, b.x, nloc, nx); b.st[0] = nloc; b.st[1] = nx; }
        const unsigned old = xb_add(&bar[XB_XSUB(b.x)], 1u);
        const unsigned gen = old / nloc;
        if (old + 1u == (gen + 1u) * nloc) {
            __builtin_amdgcn_fence(__ATOMIC_RELEASE, "agent");
            asm volatile("s_waitcnt vmcnt(0)" ::: "memory");
            const unsigned og = xb_add(&bar[XB_TOP], 1u);
            const unsigned tg = og / nx;
            if (og + 1u == (tg + 1u) * nx) xb_add(&bar[XB_TOPGEN], 1u);
            else XB_SPIN(xb_ld(&bar[XB_TOPGEN]) == tg, bar);
            __builtin_amdgcn_fence(__ATOMIC_ACQUIRE, "agent");
            xb_add(&bar[XB_XGEN(b.x)], 1u);
            asm volatile("s_waitcnt vmcnt(0)" ::: "memory");
        } else {
            XB_SPIN(xb_ld(&bar[XB_XGEN(b.x)]) == gen, bar);
            __builtin_amdgcn_fence(__ATOMIC_ACQUIRE, "agent");
            asm volatile("s_waitcnt vmcnt(0)" ::: "memory");
        }
    }
    __syncthreads();
}

struct Args { const float* in[19]; float* out; unsigned char* ws; int ph_lo, ph_hi; };
struct Frame {
    LAS unsigned char* lds;
    int tid, lane, wave, vcu, G;
    GAS unsigned char* ws; GAS float* out;
};
template <class T> __device__ __forceinline__ GAS T* uni(T* p) { const unsigned long long v = (unsigned long long)p; const unsigned lo = __builtin_amdgcn_readfirstlane((unsigned)v), hi = __builtin_amdgcn_readfirstlane((unsigned)(v >> 32)); return (GAS T*)(((unsigned long long)hi << 32) | lo); }
__device__ __forceinline__ float wave_sum(float v) {
#pragma unroll
    for (int o = 1; o < 64; o <<= 1) v += __shfl_xor(v, o);
    return v;
}

__host__ __device__ __forceinline__ int sc_in_row(int wcol) { const int type = wcol >> 12, j = wcol & 4095, pn = j >> 6, jj = j & 63; return 256 * pn + 128 * (type >> 1) + 32 * (jj >> 4) + 8 * ((jj >> 2) & 3) + 4 * (type & 1) + (jj & 3); }
template <int SCPERM>
__device__ __forceinline__ void p0_transpose_item(const float* W, int K, int N, const float* ksc, bf16* WT, LAS float* scr, int item, int lane) {
    const int nblk = N / 32, kb = item / nblk, nb = item % nblk, k0 = 64 * kb, n0 = 32 * nb;
#pragma unroll 8
    for (int i = 0; i < 32; ++i) { const int kk = 2 * i + (lane >> 5); scr[kk * 33 + (lane & 31)] = __builtin_nontemporal_load(W + (size_t)(k0 + kk) * N + n0 + (lane & 31)) * ksc[k0 + kk]; }
    LDS_WAIT(); asm volatile("" ::: "memory");
    const int c = lane & 7;
#pragma unroll
    for (int j = 0; j < 4; ++j) { const int n = (lane >> 3) + 8 * j; const LAS float* s = scr + (8 * c) * 33 + n;
        v4u o; o.x = pk2(s[0 * 33], s[1 * 33]); o.y = pk2(s[2 * 33], s[3 * 33]); o.z = pk2(s[4 * 33], s[5 * 33]); o.w = pk2(s[6 * 33], s[7 * 33]);
        const int drow = SCPERM ? sc_in_row(n0 + n) : (n0 + n);
        __builtin_nontemporal_store(o, (v4u*)(WT + (size_t)drow * K + k0 + 8 * c)); }
    LDS_WAIT(); asm volatile("" ::: "memory");
}
constexpr int I_A = (D / 64) * (SSD_PROJ / 32), I_B = (DI / 64) * (D / 32), I_C = (D / 64) * (SC_PROJ / 32), I_D = (D / 64) * (D / 32), I_L = I_A + I_B + I_C + I_D;
constexpr int LATE0_BEGIN = I_L, LATE0_COUNT = 26000;
constexpr int LATE1_BEGIN = I_L + I_A, LATE1_COUNT = 26000;
static_assert(LATE0_COUNT <= I_A && LATE1_COUNT <= I_B + I_C, "late ranges");
__device__ __forceinline__ void p0_item(Frame& F, const Args& A, LAS float* scr, int it) {
    const int j = it / I_L; int r = it % I_L;
    if (r < I_A) { p0_transpose_item<0>(A.in[7] + (size_t)j * D * SSD_PROJ, D, SSD_PROJ, A.in[6] + (size_t)(2 * j) * D, (bf16*)(F.ws + WS_W_SSD_IN + j * SZ_W_SSD_IN1), scr, r, F.lane); return; } r -= I_A;
    if (r < I_B) { p0_transpose_item<0>(A.in[14] + (size_t)j * DI * D, DI, D, A.in[13] + (size_t)j * DI, (bf16*)(F.ws + WS_W_SSD_OUT + j * SZ_W_SSD_OUT1), scr, r, F.lane); return; } r -= I_B;
    if (r < I_C) { p0_transpose_item<1>(A.in[15] + (size_t)j * D * SC_PROJ, D, SC_PROJ, A.in[6] + (size_t)(2 * j + 1) * D, (bf16*)(F.ws + WS_W_SC_IN + j * SZ_W_SC_IN1), scr, r, F.lane); return; } r -= I_C;
    { const float* W = A.in[17] + (size_t)j * D * D; bf16* WT = (bf16*)(F.ws + WS_W_SC_OUT + j * SZ_W_SC_OUT1);
      const int nblk = D / 32, kb = r / nblk, nb = r % nblk, k0 = 64 * kb, n0 = 32 * nb; const int lane = F.lane;
#pragma unroll 8
      for (int i = 0; i < 32; ++i) { const int kk = 2 * i + (lane >> 5); scr[kk * 33 + (lane & 31)] = __builtin_nontemporal_load(W + (size_t)(k0 + kk) * D + n0 + (lane & 31)); }
      LDS_WAIT(); asm volatile("" ::: "memory");
      const int c = lane & 7;
#pragma unroll
      for (int jj = 0; jj < 4; ++jj) { const int n = (lane >> 3) + 8 * jj; const LAS float* s = scr + (8 * c) * 33 + n;
          v4u o; o.x = pk2(s[0 * 33], s[1 * 33]); o.y = pk2(s[2 * 33], s[3 * 33]); o.z = pk2(s[4 * 33], s[5 * 33]); o.w = pk2(s[6 * 33], s[7 * 33]);
          __builtin_nontemporal_store(o, (v4u*)(WT + (size_t)(n0 + n) * D + k0 + 8 * c)); }
      LDS_WAIT(); asm volatile("" ::: "memory"); }
}
__device__ __forceinline__ void late_convert(Frame& F, const Args& A, int begin, int count) {
    constexpr int NWG1 = (M_PAD / 256) * (SSD_PROJ_PAD / 256);
    const int rem = NWG1 % F.G, c = (int)blockIdx.x;
    LAS float* scr = (LAS float*)(F.lds + RING_OFF + F.wave * 16384);
    if (rem == 0) { const int gw = F.vcu * NWAVES + F.wave; for (int it = gw; it < count; it += F.G * NWAVES) p0_item(F, A, scr, begin + it); return; }
    if (c < rem) return;
    const int rank = (c - rem) * NWAVES + F.wave, nw = (F.G - rem) * NWAVES;
    for (int it = rank; it < count; it += nw) p0_item(F, A, scr, begin + it);
}
__device__ __forceinline__ void p0_prologue(Frame& F, const Args& A) {
    LAS float* scr = (LAS float*)(F.lds + RING_OFF + F.wave * 16384);
    const int gw = F.vcu * NWAVES + F.wave, NGW = F.G * NWAVES;
    constexpr int N_EARLY = 2 * I_L - LATE0_COUNT - LATE1_COUNT;
    for (int e = gw; e < N_EARLY; e += NGW) {
        int it = e; if (it >= LATE0_BEGIN) it += LATE0_COUNT; if (it >= LATE1_BEGIN) it += LATE1_COUNT;
        p0_item(F, A, scr, it);
    }
    { const size_t gt = (size_t)F.vcu * 512 + F.tid, GT = (size_t)F.G * 512;
      for (size_t i = gt; i < (size_t)2 * 128 * D / 8; i += GT) { const size_t j = i / (128 * D / 8), o = i % (128 * D / 8);
          *(v4u*)(F.ws + WS_W_SSD_IN + j * SZ_W_SSD_IN1 + (size_t)SSD_PROJ * D * 2 + o * 16) = (v4u){0u, 0u, 0u, 0u}; } }
    bf16* H = (bf16*)(F.ws + WS_H); float* SSQ = (float*)(F.ws + WS_SSQ);
    for (int m = gw; m < M_PAD; m += NGW) {
        const float* src = nullptr;
        if (m < ROW_META) src = A.in[0] + (size_t)m * D;
        else if (m < ROW_SAMPLE) src = A.in[5] + (size_t)((m - ROW_META) & 15) * D;
        else if (m < M_REAL) src = A.in[1] + (size_t)(m - ROW_SAMPLE) * D;
        float s = 0.f;
        f32x4 xa[8], xb[8];
#pragma unroll
        for (int jj = 0; jj < 8; ++jj) {
            if (src) { xa[jj] = __builtin_nontemporal_load((const f32x4*)(src + 8 * (64 * jj + F.lane))); xb[jj] = __builtin_nontemporal_load((const f32x4*)(src + 8 * (64 * jj + F.lane) + 4)); }
            else { xa[jj] = (f32x4){0.f, 0.f, 0.f, 0.f}; xb[jj] = xa[jj]; } }
#pragma unroll
        for (int jj = 0; jj < 8; ++jj) {
            const float f[8] = {xa[jj][0], xa[jj][1], xa[jj][2], xa[jj][3], xb[jj][0], xb[jj][1], xb[jj][2], xb[jj][3]};
#pragma unroll
            for (int e = 0; e < 8; ++e) s += f[e] * f[e];
            *(v4u*)(H + (size_t)m * D + 8 * (64 * jj + F.lane)) = pack8(f);
        }
        s = wave_sum(s);
        SSQ[(size_t)m * 64 + F.lane] = (F.lane == 0) ? s : 0.f;
        if (F.lane == 0) ((float*)(F.ws + WS_RSTD))[m] = rsqrtf(s * (1.f / D) + EPS);
    }
}

struct Seg { int row0, b, k, is_sample, is_last; };
__device__ __forceinline__ Seg seg_decode(int seg) {
    Seg s;
    if (seg < NB * 257) { s.b = seg / 257; s.k = seg % 257; s.is_sample = 0; s.is_last = (s.k == 256);
        s.row0 = (s.k == 0) ? ROW_META + 16 * s.b : s.b * SEQ + 16 * (s.k - 1); }
    else { s.b = seg - NB * 257; s.k = -1; s.is_sample = 1; s.is_last = 1; s.row0 = ROW_SAMPLE + 16 * s.b; }
    return s;
}
__device__ __forceinline__ int seg_halo(const Seg& s, int d) {
    if (s.is_sample || s.k == 0) return -1;
    if (s.k == 1) return ROW_META + 16 * s.b + 16 - d;
    return s.row0 - d;
}
__device__ __forceinline__ float row_rstd8(const float* SSQ, int row, int sub) {
    float s = 0.f;
    if (row >= 0) { const f32x4 a = *(const f32x4*)(SSQ + (size_t)row * 64 + sub * 8), b = *(const f32x4*)(SSQ + (size_t)row * 64 + sub * 8 + 4);
        s = (a[0] + a[1]) + (a[2] + a[3]) + (b[0] + b[1]) + (b[2] + b[3]); }
    s += __shfl_xor(s, 1); s += __shfl_xor(s, 2); s += __shfl_xor(s, 4);
    return row >= 0 ? rsqrtf(s * (1.f / D) + EPS) : 0.f;
}

__device__ __forceinline__ void ssd_conv_phase(Frame& F, const Args& A, int j) {
    const GAS unsigned char* XBCb = F.ws + WS_XBC; GAS unsigned char* XACTb = F.ws + WS_XACT;
    const float* DTRAW = (const float*)(F.ws + WS_DTRAW); float* DT = (float*)(F.ws + WS_DT); const float* RSTD = (const float*)(F.ws + WS_RSTD);
    const float* cw = A.in[8] + (size_t)j * 4 * CONVD; const float* cb = A.in[9] + (size_t)j * CONVD; const float* dtb = A.in[10] + (size_t)j * NH;
    const float* st_in = A.in[3] + (size_t)j * NSB * 3 * CONVD;
    const int NHW = 2 * F.G, hw = 2 * F.vcu + (F.wave >> 2), tl = F.tid & 255;
    const int hpart = hw % 5, rank = hw / 5, nranks = (NHW - hpart + 4) / 5;
    const int c0 = hpart * 2048 + tl * 8; const unsigned voff = (unsigned)c0 * 2u;
#define XBC_ROW(r) (__builtin_nontemporal_load((const GAS v4u*)(XBCb + (size_t)(r) * (CONVD * 2) + voff)))
    float w[4][8], bias[8];
#pragma unroll
    for (int k = 0; k < 4; ++k) { const f32x4 a = *(const f32x4*)(cw + (size_t)k * CONVD + c0), b = *(const f32x4*)(cw + (size_t)k * CONVD + c0 + 4);
        w[k][0] = a[0]; w[k][1] = a[1]; w[k][2] = a[2]; w[k][3] = a[3]; w[k][4] = b[0]; w[k][5] = b[1]; w[k][6] = b[2]; w[k][7] = b[3]; }
    { const f32x4 a = *(const f32x4*)(cb + c0), b = *(const f32x4*)(cb + c0 + 4); bias[0] = a[0]; bias[1] = a[1]; bias[2] = a[2]; bias[3] = a[3]; bias[4] = b[0]; bias[5] = b[1]; bias[6] = b[2]; bias[7] = b[3]; }
    for (int seg = rank; seg < NSEG; seg += nranks) {
        const Seg s = seg_decode(seg);
        float r3[8], r2[8], r1[8];
#pragma unroll
        for (int d = 3; d >= 1; --d) {
            float (&dst)[8] = (d == 3) ? r3 : (d == 2) ? r2 : r1;
            if (s.is_sample) { const float* p = st_in + ((size_t)s.b * 3 + (3 - d)) * CONVD + c0; const f32x4 a = *(const f32x4*)p, b = *(const f32x4*)(p + 4);
                dst[0] = a[0]; dst[1] = a[1]; dst[2] = a[2]; dst[3] = a[3]; dst[4] = b[0]; dst[5] = b[1]; dst[6] = b[2]; dst[7] = b[3]; }
            else { const int hr = seg_halo(s, d);
                if (hr >= 0) { unpack8(XBC_ROW(hr), dst); const float rs = RSTD[hr];
#pragma unroll
                    for (int e = 0; e < 8; ++e) dst[e] *= rs; }
                else {
#pragma unroll
                    for (int e = 0; e < 8; ++e) dst[e] = 0.f; } }
        }
        v4u rawv[16]; float rsv[16];
#pragma unroll
        for (int i = 0; i < 16; ++i) { rawv[i] = XBC_ROW(s.row0 + i); rsv[i] = RSTD[s.row0 + i]; }
#pragma unroll
        for (int i = 0; i < 16; ++i) {
            float cur[8], o[8]; unpack8(rawv[i], cur); const float rs = rsv[i];
#pragma unroll
            for (int e = 0; e < 8; ++e) { cur[e] *= rs; const float v = __builtin_fmaf(w[3][e], cur[e], __builtin_fmaf(w[2][e], r1[e], __builtin_fmaf(w[1][e], r2[e], __builtin_fmaf(w[0][e], r3[e], bias[e])))); o[e] = silu_f(v);
                r3[e] = r2[e]; r2[e] = r1[e]; r1[e] = cur[e]; }
            *(GAS v4u*)(XACTb + (size_t)(s.row0 + i) * (CONVD * 2) + voff) = pack8(o);
        }
        if (s.is_last) {
            GAS float* ob = F.out + (s.is_sample ? O_CONV_S + ((size_t)j * NSB + s.b) * 3 * CONVD : O_CONV_P + ((size_t)j * NB + s.b) * 3 * CONVD) + c0;
            *(GAS f32x4*)(ob) = (f32x4){r3[0], r3[1], r3[2], r3[3]}; *(GAS f32x4*)(ob + 4) = (f32x4){r3[4], r3[5], r3[6], r3[7]};
            *(GAS f32x4*)(ob + CONVD) = (f32x4){r2[0], r2[1], r2[2], r2[3]}; *(GAS f32x4*)(ob + CONVD + 4) = (f32x4){r2[4], r2[5], r2[6], r2[7]};
            *(GAS f32x4*)(ob + 2 * CONVD) = (f32x4){r1[0], r1[1], r1[2], r1[3]}; *(GAS f32x4*)(ob + 2 * CONVD + 4) = (f32x4){r1[4], r1[5], r1[6], r1[7]};
        }
    }
#undef XBC_ROW
    for (size_t i = (size_t)F.vcu * 512 + F.tid; i < (size_t)M_REAL * (NH / 8); i += (size_t)F.G * 512) { const size_t row = i >> 4; const int h0 = (int)(i & 15) * 8; const float rs = RSTD[row];
        const f32x4 a = *(const f32x4*)(DTRAW + row * NH + h0), b = *(const f32x4*)(DTRAW + row * NH + h0 + 4);
        const f32x4 ba = *(const f32x4*)(dtb + h0), bb = *(const f32x4*)(dtb + h0 + 4);
        f32x4 oa, ob;
#pragma unroll
        for (int e = 0; e < 4; ++e) { oa[e] = softplus_f(a[e] * rs + ba[e]); ob[e] = softplus_f(b[e] * rs + bb[e]); }
        *(f32x4*)(DT + row * NH + h0) = oa; *(f32x4*)(DT + row * NH + h0 + 4) = ob; }
}

typedef short s16x4 __attribute__((ext_vector_type(4)));
typedef short bf16x8 __attribute__((ext_vector_type(8)));
#define MFMA16(a, b, c) __builtin_amdgcn_mfma_f32_16x16x32_bf16((a), (b), (c), 0, 0, 0)
__device__ __forceinline__ bf16x8 frag_row(const LAS unsigned char* base, int stride, int row, int kbyte) { return *(const LAS bf16x8*)(base + row * stride + kbyte); }
__device__ __forceinline__ bf16x8 frag_tr(const LAS unsigned char* base, int stride, int k0, int c0, int lane) {
    const int g = lane >> 4, i16 = lane & 15, qq = i16 >> 2, pp = i16 & 3;
    const LAS unsigned char* p = base + (k0 + 8 * g + qq) * stride + (c0 + 4 * pp) * 2;
    const s16x4 lo = __builtin_amdgcn_ds_read_tr16_b64_v4i16((LAS s16x4*)p);
    const s16x4 hi = __builtin_amdgcn_ds_read_tr16_b64_v4i16((LAS s16x4*)(p + 4 * stride));
    return __builtin_shufflevector(lo, hi, 0, 1, 2, 3, 4, 5, 6, 7);
}
__device__ __forceinline__ void ssd_scan_phase(Frame& F, const Args& A, int j) {
    constexpr int S128 = 272, S64 = 144;
    constexpr int OFF_B = 0, OFF_C = 17408, OFF_XD = 34816, OFF_XE = 53248, OFF_L = 71680, OFF_H = 90112, OFF_XD2 = 124928;
    constexpr int SM_ACS = 0, SM_EA = 128, SM_DTD = 256, SM_DTE = 384, SM_ETOT = 512, SM_V = 520, SM_U = 648, SM_STRIDE = 1040;
#define LDS_BARRIER() do { asm volatile("s_waitcnt lgkmcnt(0)" ::: "memory"); __builtin_amdgcn_s_barrier(); asm volatile("" ::: "memory"); } while (0)
    LAS unsigned char* const L = F.lds;
    LAS float* const SM = (LAS float*)(F.lds + SMALL_OFF);
    const bf16* XACT = (const bf16*)(F.ws + WS_XACT); const float* DT = (const float*)(F.ws + WS_DT); bf16* Y = (bf16*)(F.ws + WS_Y);
    const bf16* Z = (const bf16*)(F.ws + WS_Z); float* YSQ = (float*)(F.ws + WS_YSQ);
    LAS float* const PS = SM + 2 * SM_STRIDE;
    const float* a_log = A.in[11] + (size_t)j * NH; const float* d_skip = A.in[12] + (size_t)j * NH;
    const int tid = F.tid, lane = F.lane, w = F.wave, hh = w >> 2, pt = w & 3, q = lane >> 4, l16 = lane & 15;
    for (int item = F.vcu; item < (NB + NSB) * 64; item += F.G) {
        const int is_sample = item >= NB * 64, idx = is_sample ? item - NB * 64 : item, b = idx >> 6, hp = idx & 63, nblocks = is_sample ? 1 : 65;
        const int head = 2 * hp + hh, g = hp >> 3;
        const float Dh = d_skip[head];
        const int sm_h = (w == 4) ? 1 : (w == 6) ? 0 : -1;
        const int head_s = 2 * hp + (sm_h > 0 ? 1 : 0); const float A_own = -__expf(a_log[head_s]);
        f32x4 hacc[8];
        if (is_sample) { const float* sp = A.in[2] + ((((size_t)j * NSB + b) * NH + head) * HD + 16 * pt + l16) * DS + 4 * q;
#pragma unroll
            for (int n8 = 0; n8 < 8; ++n8) hacc[n8] = *(const f32x4*)(sp + 16 * n8); }
        else {
#pragma unroll
            for (int n8 = 0; n8 < 8; ++n8) hacc[n8] = (f32x4){0.f, 0.f, 0.f, 0.f}; }
        v4u pbc[4], px[2];
        int row0 = is_sample ? ROW_SAMPLE + 16 * b : ROW_META + 16 * b, nt = 16;
#define SCAN_PREFETCH(r0_, nt_) do { \
            _Pragma("unroll") for (int k_ = 0; k_ < 4; ++k_) { const int i_ = tid + 512 * k_, mat_ = i_ >> 10, r_ = (i_ >> 4) & 63, c8_ = i_ & 15; \
                pbc[k_] = (r_ < (nt_)) ? *(const v4u*)(XACT + (size_t)((r0_) + r_) * CONVD + DI + mat_ * (NG * DS) + g * DS + c8_ * 8) : (v4u){0u, 0u, 0u, 0u}; } \
            _Pragma("unroll") for (int k_ = 0; k_ < 2; ++k_) { const int i_ = tid + 512 * k_, h2_ = i_ >> 9, r_ = (i_ >> 3) & 63, c8_ = i_ & 7; \
                px[k_] = (r_ < (nt_)) ? *(const v4u*)(XACT + (size_t)((r0_) + r_) * CONVD + (2 * hp + h2_) * HD + c8_ * 8) : (v4u){0u, 0u, 0u, 0u}; } } while (0)
#define SCAN_DTLOAD(r0_, nt_) ((sm_h >= 0 && lane < (nt_)) ? DT[(size_t)((r0_) + lane) * NH + head_s] : 0.f)
#define SCAN_SMALL(dtv_, par_) do { if (sm_h >= 0) { const int hh = sm_h; LAS float* sm_ = SM + (par_) * SM_STRIDE; \
            const float dt_ = (dtv_); float acs_ = dt_ * (A_own * 1.44269504f); \
            _Pragma("unroll") for (int o_ = 1; o_ < 64; o_ <<= 1) { const float v_ = __shfl_up(acs_, o_); if (lane >= o_) acs_ += v_; } \
            const float r0_ = __shfl(acs_, 15), r1_ = __shfl(acs_, 31), r2_ = __shfl(acs_, 47), atot_ = __shfl(acs_, 63); \
            const float myr_ = lane < 16 ? r0_ : lane < 32 ? r1_ : lane < 48 ? r2_ : atot_;              \
            sm_[SM_ACS + hh * 64 + lane] = acs_; sm_[SM_EA + hh * 64 + lane] = __builtin_amdgcn_exp2f(acs_); sm_[SM_DTD + hh * 64 + lane] = dt_; sm_[SM_DTE + hh * 64 + lane] = dt_ * __builtin_amdgcn_exp2f(atot_ - acs_); \
            sm_[SM_V + hh * 64 + lane] = dt_ * __builtin_amdgcn_exp2f(myr_ - acs_); \
            sm_[SM_U + hh * 192 + lane] = __builtin_amdgcn_exp2f(fminf(acs_ - r0_, 0.f)); sm_[SM_U + hh * 192 + 64 + lane] = __builtin_amdgcn_exp2f(fminf(acs_ - r1_, 0.f)); sm_[SM_U + hh * 192 + 128 + lane] = __builtin_amdgcn_exp2f(fminf(acs_ - r2_, 0.f)); \
            if (lane == 0) sm_[SM_ETOT + hh] = __builtin_amdgcn_exp2f(atot_); } } while (0)
#define SCAN_STAGE(par_) do { const LAS float* sm_ = SM + (par_) * SM_STRIDE; \
            _Pragma("unroll") for (int k_ = 0; k_ < 4; ++k_) { const int i_ = tid + 512 * k_, mat_ = i_ >> 10, r_ = (i_ >> 4) & 63, c8_ = i_ & 15; \
                *(LAS v4u*)(L + (mat_ ? OFF_C : OFF_B) + r_ * S128 + c8_ * 16) = pbc[k_]; } \
            _Pragma("unroll") for (int k_ = 0; k_ < 2; ++k_) { const int i_ = tid + 512 * k_, h2_ = i_ >> 9, r_ = (i_ >> 3) & 63, c8_ = i_ & 7; \
                float f_[8], e_[8]; unpack8(px[k_], f_); const float se_ = sm_[SM_DTE + h2_ * 64 + r_]; \
                _Pragma("unroll") for (int e2_ = 0; e2_ < 8; ++e2_) { e_[e2_] = f_[e2_] * se_; } \
                *(LAS v4u*)(L + ((par_) ? OFF_XD2 : OFF_XD) + h2_ * 64 * S64 + r_ * S64 + c8_ * 16) = px[k_]; *(LAS v4u*)(L + OFF_XE + h2_ * 64 * S64 + r_ * S64 + c8_ * 16) = pack8(e_); } } while (0)
#define SCAN_WRITE_HS() do { _Pragma("unroll") for (int n8 = 0; n8 < 8; ++n8) { v2u hw_; hw_.x = pk2(hacc[n8][0], hacc[n8][1]); hw_.y = pk2(hacc[n8][2], hacc[n8][3]); \
            *(LAS v2u*)(L + OFF_H + hh * 64 * S128 + (16 * pt + l16) * S128 + (16 * n8 + 4 * q) * 2) = hw_; } } while (0)
        LDS_BARRIER();
        { const float dt0 = SCAN_DTLOAD(row0, nt); SCAN_PREFETCH(row0, nt); SCAN_SMALL(dt0, 0); }
        float dtA = (nblocks > 1) ? SCAN_DTLOAD(b * SEQ, 64) : 0.f;
        LDS_BARRIER();
        SCAN_STAGE(0);
        SCAN_WRITE_HS();
        int row0p = row0, ntp = nt;
        for (int blk = 0; blk < nblocks; ++blk) {
            const int par = blk & 1; const LAS float* sm = SM + par * SM_STRIDE;
            const bool has_next = blk + 1 < nblocks; const int row0n = b * SEQ + 64 * blk, ntn = 64;
            LDS_BARRIER();
            if (has_next) { SCAN_PREFETCH(row0n, ntn); }
            const float dtB = (blk + 2 < nblocks) ? SCAN_DTLOAD(b * SEQ + 64 * (blk + 1), 64) : 0.f;
            if (blk > 0 && sm_h >= 0) { const float sq = (PS[(sm_h * 4 + 0) * 64 + lane] + PS[(sm_h * 4 + 1) * 64 + lane]) + (PS[(sm_h * 4 + 2) * 64 + lane] + PS[(sm_h * 4 + 3) * 64 + lane]);
                if (lane < ntp) YSQ[(size_t)(row0p + lane) * NH + head_s] = sq; }
            v2u ez[4];
#pragma unroll
            for (int jt = 0; jt < 4; ++jt) { const int t = 16 * jt + l16; const size_t row = (size_t)(row0 + (t < nt ? t : 0));
                ez[jt] = *(const v2u*)(Z + row * DI + head * HD + 16 * pt + 4 * q); }
            { const int it_ = w >> 1, jt0 = 2 * (w & 1);
              if (it_ <= jt0 + 1) {
                  f32x4 g0 = (f32x4){0.f, 0.f, 0.f, 0.f}, g1 = g0;
#pragma unroll
                  for (int ks = 0; ks < 4; ++ks) { const int kb = (32 * ks + 8 * q) * 2;
                      const bf16x8 a = frag_row(L + OFF_B, S128, 16 * it_ + l16, kb), b1 = frag_row(L + OFF_C, S128, 16 * (jt0 + 1) + l16, kb);
                      g1 = MFMA16(a, b1, g1);
                      if (it_ <= jt0) { const bf16x8 b0 = frag_row(L + OFF_C, S128, 16 * jt0 + l16, kb); g0 = MFMA16(a, b0, g0); } }
#pragma unroll
                  for (int h2 = 0; h2 < 2; ++h2) {
#pragma unroll
                      for (int x = 0; x < 2; ++x) { const int jt = jt0 + x, t = 16 * jt + l16; const f32x4 gg = x ? g1 : g0; float v[4];
                          if (it_ > jt) { v[0] = 0.f; v[1] = 0.f; v[2] = 0.f; v[3] = 0.f; }
                          else if (it_ == jt) { const f32x4 as = *(const LAS f32x4*)(sm + SM_ACS + h2 * 64 + 16 * it_ + 4 * q), ds = *(const LAS f32x4*)(sm + SM_DTD + h2 * 64 + 16 * it_ + 4 * q); const float at = sm[SM_ACS + h2 * 64 + t];
#pragma unroll
                              for (int r = 0; r < 4; ++r) { const int s_ = 16 * it_ + 4 * q + r; v[r] = (s_ <= t) ? gg[r] * (ds[r] * __builtin_amdgcn_exp2f(at - as[r])) : 0.f; } }
                          else { const f32x4 vs = *(const LAS f32x4*)(sm + SM_V + h2 * 64 + 16 * it_ + 4 * q); const float ut = sm[SM_U + h2 * 192 + it_ * 64 + t];
#pragma unroll
                              for (int r = 0; r < 4; ++r) v[r] = gg[r] * (ut * vs[r]); }
                          if (it_ <= jt || ((it_ & 1) && it_ == jt + 1)) { v2u lw; lw.x = pk2(v[0], v[1]); lw.y = pk2(v[2], v[3]);
                              *(LAS v2u*)(L + OFF_L + h2 * 64 * S64 + t * S64 + (16 * it_ + 4 * q) * 2) = lw; } } } } }
            f32x4 yacc[4];
#pragma unroll
            for (int jt = 0; jt < 4; ++jt) yacc[jt] = (f32x4){0.f, 0.f, 0.f, 0.f};
#pragma unroll
            for (int ks = 0; ks < 4; ++ks) { const int kb = (32 * ks + 8 * q) * 2; const bf16x8 a = frag_row(L + OFF_H + hh * 64 * S128, S128, 16 * pt + l16, kb);
#pragma unroll
                for (int jt = 0; jt < 4; ++jt) { const bf16x8 bb = frag_row(L + OFF_C, S128, 16 * jt + l16, kb); yacc[jt] = MFMA16(a, bb, yacc[jt]); } }
#pragma unroll
            for (int jt = 0; jt < 4; ++jt) { const float ea = sm[SM_EA + hh * 64 + 16 * jt + l16]; yacc[jt] = yacc[jt] * ea; }
            { const float etot = sm[SM_ETOT + hh];
#pragma unroll
              for (int n8 = 0; n8 < 8; ++n8) hacc[n8] = hacc[n8] * etot;
#pragma unroll
              for (int ks = 0; ks < 2; ++ks) { const bf16x8 bb = frag_tr(L + OFF_XE + hh * 64 * S64, S64, 32 * ks, 16 * pt, lane);
#pragma unroll
                  for (int n8 = 0; n8 < 8; ++n8) { const bf16x8 a = frag_tr(L + OFF_B, S128, 32 * ks, 16 * n8, lane); hacc[n8] = MFMA16(a, bb, hacc[n8]); } } }
            if (has_next) { SCAN_SMALL(dtA, par ^ 1); }
            dtA = dtB;
            LDS_BARRIER();
#pragma unroll
            for (int ks = 0; ks < 2; ++ks) { const bf16x8 a = frag_tr(L + (par ? OFF_XD2 : OFF_XD) + hh * 64 * S64, S64, 32 * ks, 16 * pt, lane); const int kb = (32 * ks + 8 * q) * 2;
#pragma unroll
                for (int jt = 0; jt < 4; ++jt) { if (ks == 1 && jt < 2) continue;
                    const bf16x8 bb = frag_row(L + OFF_L + hh * 64 * S64, S64, 16 * jt + l16, kb); yacc[jt] = MFMA16(a, bb, yacc[jt]); } }
            SCAN_WRITE_HS();
#pragma unroll
            for (int jt = 0; jt < 4; ++jt) { const int t = 16 * jt + l16;
                const v2u xv = *(const LAS v2u*)(L + (par ? OFF_XD2 : OFF_XD) + hh * 64 * S64 + t * S64 + (16 * pt + 4 * q) * 2);
                const float o0 = (yacc[jt][0] + Dh * bflo(xv.x)) * bflo(ez[jt].x), o1 = (yacc[jt][1] + Dh * bfhi(xv.x)) * bfhi(ez[jt].x);
                const float o2 = (yacc[jt][2] + Dh * bflo(xv.y)) * bflo(ez[jt].y), o3 = (yacc[jt][3] + Dh * bfhi(xv.y)) * bfhi(ez[jt].y);
                float ss = (o0 * o0 + o1 * o1) + (o2 * o2 + o3 * o3); ss += __shfl_xor(ss, 16); ss += __shfl_xor(ss, 32);
                if (q == 0) PS[(hh * 4 + pt) * 64 + t] = ss;
                if (t < nt) { v2u ow; ow.x = pk2(o0, o1); ow.y = pk2(o2, o3);
                    *(v2u*)(Y + (size_t)(row0 + t) * DI + head * HD + 16 * pt + 4 * q) = ow; } }
            if (has_next) { SCAN_STAGE(par ^ 1); }
            row0p = row0; ntp = nt; row0 = row0n; nt = ntn;
        }
        LDS_BARRIER();
        if (sm_h >= 0) { const float sq = (PS[(sm_h * 4 + 0) * 64 + lane] + PS[(sm_h * 4 + 1) * 64 + lane]) + (PS[(sm_h * 4 + 2) * 64 + lane] + PS[(sm_h * 4 + 3) * 64 + lane]);
            if (lane < ntp) YSQ[(size_t)(row0p + lane) * NH + head_s] = sq; }
        { GAS float* op = F.out + (is_sample ? O_SSM_S + ((((size_t)j * NSB + b) * NH + head) * HD + 16 * pt + l16) * DS : O_SSM_P + ((((size_t)j * NB + b) * NH + head) * HD + 16 * pt + l16) * DS) + 4 * q;
#pragma unroll
          for (int n8 = 0; n8 < 8; ++n8) *(GAS f32x4*)(op + 16 * n8) = hacc[n8]; }
#undef SCAN_PREFETCH
#undef SCAN_DTLOAD
#undef SCAN_SMALL
#undef SCAN_STAGE
#undef SCAN_WRITE_HS
    }
}

__device__ __forceinline__ void ssd_scale_phase(Frame& F) {
    const float* YSQ = (const float*)(F.ws + WS_YSQ); float* CG = (float*)(F.ws + WS_CG);
    const int gw = F.vcu * NWAVES + F.wave, NGW = F.G * NWAVES;
    for (int m = gw; m < M_PAD; m += NGW) {
        f32x2 v = *(const f32x2*)(YSQ + (size_t)m * NH + 2 * F.lane);
        float sq = (m < M_REAL) ? v[0] + v[1] : 0.f;
        sq += __shfl_xor(sq, 1); sq += __shfl_xor(sq, 2); sq += __shfl_xor(sq, 4);
        if ((F.lane & 7) == 0) CG[(size_t)m * 8 + (F.lane >> 3)] = rsqrtf(sq * (1.f / 1024.f) + EPS);
    }
}

__device__ __forceinline__ void sc_tail_sum(const float* SLAB, int r, int type, int c0, float (&f)[8]) {
#pragma unroll
    for (int e = 0; e < 8; ++e) f[e] = 0.f;
#pragma unroll
    for (int k = 0; k < 4; ++k) { const float* p = SLAB + (size_t)k * (256 * 16384) + (size_t)r * 16384 + type * 4096 + c0; const f32x4 a = *(const f32x4*)p, b = *(const f32x4*)(p + 4);
        f[0] += a[0]; f[1] += a[1]; f[2] += a[2]; f[3] += a[3]; f[4] += b[0]; f[5] += b[1]; f[6] += b[2]; f[7] += b[3]; }
}
__device__ __forceinline__ void sc_elem_phase(Frame& F, const Args& A, int j) {
    const bf16* GC = (const bf16*)(F.ws + WS_GC); const float* SLAB = (const float*)(F.ws + WS_SLAB);
    bf16* Y = (bf16*)(F.ws + WS_Y); const float* RSTD = (const float*)(F.ws + WS_RSTD);
    const float* cw = A.in[16] + (size_t)j * 3 * D; const float* st_in = A.in[4] + (size_t)j * NSB * 2 * D;
    const bool tail_wg = (F.G > 24) && (F.vcu < 12);
    const int c0 = tail_wg ? F.wave * 512 + F.lane * 8 : F.tid * 8;
    float w[3][8];
#pragma unroll
    for (int k = 0; k < 3; ++k) { const f32x4 a = *(const f32x4*)(cw + (size_t)k * D + c0), b = *(const f32x4*)(cw + (size_t)k * D + c0 + 4);
        w[k][0] = a[0]; w[k][1] = a[1]; w[k][2] = a[2]; w[k][3] = a[3]; w[k][4] = b[0]; w[k][5] = b[1]; w[k][6] = b[2]; w[k][7] = b[3]; }
    if (tail_wg || F.G <= 24) {
        for (int t = tail_wg ? F.vcu : 0; t < 12; t += tail_wg ? 12 : 1) {
          for (int sl = tail_wg ? 0 : 0; sl < (tail_wg ? 1 : 8); ++sl) {
            const int cc = tail_wg ? c0 : sl * 512 + F.lane * 8;
            if (!tail_wg && F.wave != 0) continue;
            if (!tail_wg && F.vcu != 0) continue;
            const int seg = (t < 4) ? t * 257 : NB * 257 + (t - 4);
            const Seg s = seg_decode(seg);
            float ww[3][8];
#pragma unroll
            for (int k = 0; k < 3; ++k) { const f32x4 a = *(const f32x4*)(cw + (size_t)k * D + cc), b = *(const f32x4*)(cw + (size_t)k * D + cc + 4);
                ww[k][0] = a[0]; ww[k][1] = a[1]; ww[k][2] = a[2]; ww[k][3] = a[3]; ww[k][4] = b[0]; ww[k][5] = b[1]; ww[k][6] = b[2]; ww[k][7] = b[3]; }
            float r2[8], r1[8];
            if (s.is_sample) {
#pragma unroll
                for (int d = 2; d >= 1; --d) { float (&dst)[8] = (d == 2) ? r2 : r1; const float* p = st_in + ((size_t)s.b * 2 + (2 - d)) * D + cc; const f32x4 a = *(const f32x4*)p, b = *(const f32x4*)(p + 4);
                    dst[0] = a[0]; dst[1] = a[1]; dst[2] = a[2]; dst[3] = a[3]; dst[4] = b[0]; dst[5] = b[1]; dst[6] = b[2]; dst[7] = b[3]; } }
            else {
#pragma unroll
                for (int e = 0; e < 8; ++e) { r2[e] = 0.f; r1[e] = 0.f; } }
            for (int i = 0; i < 16; ++i) { const int row = s.row0 + i; const float rs = RSTD[row], rs2 = rs * rs;
                float gf[8], bf[8], cf[8], vf[8], o[8];
                sc_tail_sum(SLAB, row - ROW_META, 0, cc, gf); sc_tail_sum(SLAB, row - ROW_META, 1, cc, bf); sc_tail_sum(SLAB, row - ROW_META, 2, cc, cf); sc_tail_sum(SLAB, row - ROW_META, 3, cc, vf);
#pragma unroll
                for (int e = 0; e < 8; ++e) { const float cv = cf[e] * vf[e] * rs2; const float conv = ww[0][e] * r2[e] + ww[1][e] * r1[e] + ww[2][e] * cv;
                    o[e] = silu_f(gf[e] * rs) * (bf[e] * rs) * conv; r2[e] = r1[e]; r1[e] = cv; }
                *(v4u*)(Y + (size_t)row * D + cc) = pack8(o); }
            if (s.is_last) {
                GAS float* ob = F.out + O_SC_S + ((size_t)j * NSB + s.b) * 2 * D + cc;
                *(GAS f32x4*)(ob) = (f32x4){r2[0], r2[1], r2[2], r2[3]}; *(GAS f32x4*)(ob + 4) = (f32x4){r2[4], r2[5], r2[6], r2[7]};
                *(GAS f32x4*)(ob + D) = (f32x4){r1[0], r1[1], r1[2], r1[3]}; *(GAS f32x4*)(ob + D + 4) = (f32x4){r1[4], r1[5], r1[6], r1[7]}; }
          }
        }
        if (tail_wg) return;
    }
    const int nwg = tail_wg ? 0 : (F.G > 24 ? F.G - 12 : F.G), rank = (F.G > 24) ? F.vcu - 12 : F.vcu;
    for (int n = rank; n < NB * 256; n += nwg) {
        const int b = n >> 8, k = (n & 255) + 1; const int row0 = b * SEQ + 16 * (k - 1);
        float r2[8], r1[8];
#pragma unroll
        for (int d = 2; d >= 1; --d) {
            float (&dst)[8] = (d == 2) ? r2 : r1;
            const int hr = (k == 1) ? ROW_META + 16 * b + 16 - d : row0 - d;
            if (hr >= ROW_META) { float cf[8], vf[8]; sc_tail_sum(SLAB, hr - ROW_META, 2, c0, cf); sc_tail_sum(SLAB, hr - ROW_META, 3, c0, vf); const float rs = RSTD[hr], rs2 = rs * rs;
#pragma unroll
                for (int e = 0; e < 8; ++e) dst[e] = cf[e] * vf[e] * rs2; }
            else { const v4u q0 = *(const v4u*)(GC + (size_t)hr * 8192 + 2 * c0), q1 = *(const v4u*)(GC + (size_t)hr * 8192 + 2 * c0 + 8);
                dst[0] = bflo(q0.z); dst[1] = bfhi(q0.z); dst[2] = bflo(q0.w); dst[3] = bfhi(q0.w); dst[4] = bflo(q1.z); dst[5] = bfhi(q1.z); dst[6] = bflo(q1.w); dst[7] = bfhi(q1.w); }
        }
        v4u q0v[16], q1v[16];
#pragma unroll
        for (int i = 0; i < 16; ++i) { const size_t off = (size_t)(row0 + i) * D + c0; q0v[i] = __builtin_nontemporal_load((const v4u*)(GC + 2 * off)); q1v[i] = __builtin_nontemporal_load((const v4u*)(GC + 2 * off + 8)); }
#pragma unroll
        for (int i = 0; i < 16; ++i) { const size_t off = (size_t)(row0 + i) * D + c0; const v4u q0 = q0v[i], q1 = q1v[i];
            const float gb[8] = {bflo(q0.x), bfhi(q0.x), bflo(q0.y), bfhi(q0.y), bflo(q1.x), bfhi(q1.x), bflo(q1.y), bfhi(q1.y)};
            const float cv[8] = {bflo(q0.z), bfhi(q0.z), bflo(q0.w), bfhi(q0.w), bflo(q1.z), bfhi(q1.z), bflo(q1.w), bfhi(q1.w)}; float o[8];
#pragma unroll
            for (int e = 0; e < 8; ++e) { o[e] = gb[e] * __builtin_fmaf(w[2][e], cv[e], __builtin_fmaf(w[1][e], r1[e], w[0][e] * r2[e])); r2[e] = r1[e]; r1[e] = cv[e]; }
            *(v4u*)(Y + off) = pack8(o); }
        if (k == 256) {
            GAS float* ob = F.out + O_SC_P + ((size_t)j * NB + b) * 2 * D + c0;
            *(GAS f32x4*)(ob) = (f32x4){r2[0], r2[1], r2[2], r2[3]}; *(GAS f32x4*)(ob + 4) = (f32x4){r2[4], r2[5], r2[6], r2[7]};
            *(GAS f32x4*)(ob + D) = (f32x4){r1[0], r1[1], r1[2], r1[3]}; *(GAS f32x4*)(ob + D + 4) = (f32x4){r1[4], r1[5], r1[6], r1[7]}; }
    }
}

__device__ __forceinline__ void final_phase(Frame& F, const Args& A) {
    const bf16* H = (const bf16*)(F.ws + WS_H); const float* RSTD = (const float*)(F.ws + WS_RSTD); const float* fw = A.in[18];
    const int gw = F.vcu * NWAVES + F.wave, NGW = F.G * NWAVES;
    for (int mm = gw; mm < NB * SEQ + NSB * LS; mm += NGW) {
        const int m = (mm < NB * SEQ) ? mm : mm + (ROW_SAMPLE - ROW_META);
        const float rs = RSTD[m];
        GAS float* orow = F.out + (size_t)mm * D;
        v4u hv[8];
#pragma unroll
        for (int jj = 0; jj < 8; ++jj) hv[jj] = __builtin_nontemporal_load((const v4u*)(H + (size_t)m * D + 8 * (64 * jj + F.lane)));
#pragma unroll
        for (int jj = 0; jj < 8; ++jj) { const int c = 8 * (64 * jj + F.lane); float f[8]; unpack8(hv[jj], f);
            const f32x4 wa = *(const f32x4*)(fw + c), wb = *(const f32x4*)(fw + c + 4);
            __builtin_nontemporal_store((f32x4){f[0] * rs * wa[0], f[1] * rs * wa[1], f[2] * rs * wa[2], f[3] * rs * wa[3]}, (GAS f32x4*)(orow + c));
            __builtin_nontemporal_store((f32x4){f[4] * rs * wb[0], f[5] * rs * wb[1], f[6] * rs * wb[2], f[7] * rs * wb[3]}, (GAS f32x4*)(orow + c + 4)); }
    }
}

__device__ __forceinline__ void tail_fixup_phase(Frame& F) {
    bf16* H = (bf16*)(F.ws + WS_H); float* SSQ = (float*)(F.ws + WS_SSQ); const float* SLAB = (const float*)(F.ws + WS_SLAB); float* RSTD = (float*)(F.ws + WS_RSTD);
    LAS float* red = (LAS float*)(F.lds + SMALL_OFF);
    for (int r = F.vcu; r < 256; r += F.G) {
        const int row = ROW_META + r; const int c = F.tid * 8;
        float f[8]; unpack8(*(const v4u*)(H + (size_t)row * D + c), f);
#pragma unroll
        for (int k = 0; k < 16; ++k) { const float* p = SLAB + (size_t)k * (256 * 4096) + (size_t)r * 4096 + c; const f32x4 a = *(const f32x4*)p, b = *(const f32x4*)(p + 4);
            f[0] += a[0]; f[1] += a[1]; f[2] += a[2]; f[3] += a[3]; f[4] += b[0]; f[5] += b[1]; f[6] += b[2]; f[7] += b[3]; }
        float ss = 0.f;
#pragma unroll
        for (int e = 0; e < 8; ++e) ss += f[e] * f[e];
        *(v4u*)(H + (size_t)row * D + c) = pack8(f);
        ss = wave_sum(ss);
        __syncthreads();
        if (F.lane == 0) red[F.wave] = ss;
        __syncthreads();
        if (F.tid < 64) { float t = 0.f;
#pragma unroll
            for (int k = 0; k < NWAVES; ++k) t += red[k];
            SSQ[(size_t)row * 64 + F.tid] = (F.tid == 0) ? t : 0.f; if (F.tid == 0) RSTD[row] = rsqrtf(t * (1.f / D) + EPS); }
    }
    { const int gw = F.vcu * NWAVES + F.wave, NGW = F.G * NWAVES;
      for (int m = gw; m < M_MAIN; m += NGW) { const float t = wave_sum(SSQ[(size_t)m * 64 + F.lane]); if (F.lane == 0) RSTD[m] = rsqrtf(t * (1.f / D) + EPS); } }
}

enum { T_PRO = 0, T_G1 = 1, T_CONV = 2, T_SCAN = 3, T_NORM = 4, T_G2 = 5, T_FIX2 = 6, T_G3 = 7, T_SCE = 8, T_G4 = 9, T_FIX4 = 10, T_FIN = 11 };
constexpr int N_PHASES = 22;
#ifndef PROBE_TYPES
#define PROBE_TYPES 0
#endif
#define REPS(T) (((PROBE_TYPES >> (T)) & 1) ? 2 : 1)

__global__ void __launch_bounds__(NWAVES * 64, 2) trunk_fwd(Args args) {
    extern __shared__ __attribute__((aligned(16))) unsigned char lds[];
    Frame F;
    F.lds = (LAS unsigned char*)lds;
    F.tid = threadIdx.x; F.lane = F.tid & 63; F.wave = __builtin_amdgcn_readfirstlane(F.tid >> 6);
    F.G = gridDim.x; { const int bx = blockIdx.x; F.vcu = (F.G % 8 == 0) ? (bx % 8) * (F.G / 8) + bx / 8 : bx; }
    const Args& A = args;
    F.ws = uni(args.ws); F.out = uni(args.out);
    for (int u = F.tid; u < (LDS_BYTES - LDSCTL_OFF) / 4; u += NWAVES * 64) ((LAS unsigned*)(F.lds + LDSCTL_OFF))[u] = 0u;
    __syncthreads();
    XcdBarrier bar; bar.bar = (unsigned*)(F.ws + WS_CTL) + CW_BAR; bar.x = 0; bar.st = nullptr;
    const int lo = args.ph_lo, hi = args.ph_hi;
    if (hi - lo > 1) bar = xcd_barrier_post((unsigned*)(F.ws + WS_CTL) + CW_BAR, (volatile LAS unsigned*)(F.lds + MISC_OFF) + 8);
#ifndef PH_OFF
#define PH_OFF(k) 0
#endif
#define IN(k) (!PH_OFF(k) && lo <= (k) && (k) < hi)
#define SEAM(k) do { if (IN(k) && IN((k) + 1)) xcd_barrier(bar); } while (0)

    if (IN(0)) { for (int rep = 0; rep < REPS(T_PRO); ++rep) p0_prologue(F, A); } SEAM(0);

#define LAYER_PAIR(lp) do {\
        const int pb = 1 + 10 * lp;\
        if (IN(pb + 0)) {\
            pg8::Gemm g{(const pg8::bf16_t*)(F.ws + WS_H), (const pg8::bf16_t*)(F.ws + WS_W_SSD_IN + lp * SZ_W_SSD_IN1), M_PAD, SSD_PROJ_PAD, D};\
            pg8::StaticOrder S; S.init(M_PAD, SSD_PROJ_PAD, D, F.G, (int)blockIdx.x);\
            pg8::EpiSsdIn E{(pg8::bf16_t*)(F.ws + WS_Z), (pg8::bf16_t*)(F.ws + WS_XBC), (float*)(F.ws + WS_DTRAW), (const float*)(F.ws + WS_RSTD)};\
            pg8::gemm_phase<pg8::EpiSsdIn, pg8::StaticOrder, true, true>(F.lds + RING_OFF, g, S, E);\
            if (REPS(T_G1) > 1) { pg8::EpiNone E0; pg8::gemm_phase<pg8::EpiNone, pg8::StaticOrder, true, true>(F.lds + RING_OFF, g, S, E0); }\
            late_convert(F, A, lp == 0 ? LATE0_BEGIN : LATE1_BEGIN, lp == 0 ? LATE0_COUNT : LATE1_COUNT);\
        } SEAM(pb + 0);\
        if (IN(pb + 1)) { for (int rep = 0; rep < REPS(T_CONV); ++rep) ssd_conv_phase(F, A, lp); } SEAM(pb + 1);\
        if (IN(pb + 2)) { for (int rep = 0; rep < REPS(T_SCAN); ++rep) ssd_scan_phase(F, A, lp); } SEAM(pb + 2);\
        if (IN(pb + 3)) { ssd_scale_phase(F); } SEAM(pb + 3);\
        if (IN(pb + 4)) {\
            pg8::Gemm g{(const pg8::bf16_t*)(F.ws + WS_Y), (const pg8::bf16_t*)(F.ws + WS_W_SSD_OUT + lp * SZ_W_SSD_OUT1), M_MAIN, D, DI};\
            pg8::TailSplitOrder S; S.init(M_MAIN, D, DI, F.G, (int)blockIdx.x); S.KS = 16;\
            pg8::EpiResidN E{pg8::EpiResid{(pg8::bf16_t*)(F.ws + WS_H), (float*)(F.ws + WS_SSQ), (float*)(F.ws + WS_SLAB)}, (const float*)(F.ws + WS_CG)};\
            pg8::gemm_phase<pg8::EpiResidN, pg8::TailSplitOrder, true, true>(F.lds + RING_OFF, g, S, E);\
        } SEAM(pb + 4);\
        if (IN(pb + 5)) { tail_fixup_phase(F); } SEAM(pb + 5);\
        if (IN(pb + 6)) {\
            pg8::Gemm g{(const pg8::bf16_t*)(F.ws + WS_H), (const pg8::bf16_t*)(F.ws + WS_W_SC_IN + lp * SZ_W_SC_IN1), M_MAIN, SC_PROJ, D};\
            pg8::TailSplitOrder S; S.init(M_MAIN, SC_PROJ, D, F.G, (int)blockIdx.x); S.KS = 4;\
            pg8::EpiScIn E{(pg8::bf16_t*)(F.ws + WS_GC), (const float*)(F.ws + WS_RSTD), (float*)(F.ws + WS_SLAB)};\
            if (REPS(T_G3) > 1) { pg8::EpiNone E0; pg8::gemm_phase<pg8::EpiNone, pg8::TailSplitOrder, true, true>(F.lds + RING_OFF, g, S, E0); }\
            pg8::gemm_phase<pg8::EpiScIn, pg8::TailSplitOrder, true, true>(F.lds + RING_OFF, g, S, E);\
        } SEAM(pb + 6);\
        if (IN(pb + 7)) { for (int rep = 0; rep < REPS(T_SCE); ++rep) sc_elem_phase(F, A, lp); } SEAM(pb + 7);\
        if (IN(pb + 8)) {\
            pg8::Gemm g{(const pg8::bf16_t*)(F.ws + WS_Y), (const pg8::bf16_t*)(F.ws + WS_W_SC_OUT + lp * SZ_W_SC_OUT1), M_MAIN, D, D};\
            pg8::TailSplitOrder S; S.init(M_MAIN, D, D, F.G, (int)blockIdx.x); S.KS = 16;\
            pg8::EpiResid E{(pg8::bf16_t*)(F.ws + WS_H), (float*)(F.ws + WS_SSQ), (float*)(F.ws + WS_SLAB)};\
            if (REPS(T_G4) > 1) { pg8::EpiNone E0; pg8::gemm_phase<pg8::EpiNone, pg8::TailSplitOrder, true, true>(F.lds + RING_OFF, g, S, E0); }\
            pg8::gemm_phase<pg8::EpiResid, pg8::TailSplitOrder, true, true>(F.lds + RING_OFF, g, S, E);\
        } SEAM(pb + 8);\
        if (IN(pb + 9)) { tail_fixup_phase(F); } SEAM(pb + 9);\
    } while (0)
    LAYER_PAIR(0);
    LAYER_PAIR(1);
#undef LAYER_PAIR
    if (IN(21)) { for (int rep = 0; rep < REPS(T_FIN); ++rep) final_phase(F, A); }
#undef IN
#undef SEAM
}

extern "C" void kernel_launch(void* const* d_in, const int* in_sizes, int n_in, void* d_out, int out_size, void* d_ws, size_t ws_size, hipStream_t stream) {
    static int grid = 0;
    if (grid == 0) {
        if (n_in != 19 || (size_t)out_size != O_END || ws_size < WS_END) { fprintf(stderr, "kernel_launch: unexpected shapes: n_in %d out %d ws %zu (need %zu)\n", n_in, out_size, ws_size, (size_t)WS_END); grid = -1; return; }
        int dev = 0, cus = 0, per_cu = 0;
        if (hipGetDevice(&dev) != hipSuccess || hipDeviceGetAttribute(&cus, hipDeviceAttributeMultiprocessorCount, dev) != hipSuccess) { grid = -1; return; }
        if (hipFuncSetAttribute((const void*)trunk_fwd, hipFuncAttributeMaxDynamicSharedMemorySize, LDS_BYTES) != hipSuccess) { fprintf(stderr, "kernel_launch: hipFuncSetAttribute failed\n"); grid = -1; return; }
        if (hipOccupancyMaxActiveBlocksPerMultiprocessor(&per_cu, (const void*)trunk_fwd, NWAVES * 64, LDS_BYTES) != hipSuccess || per_cu < 1)
            fprintf(stderr, "kernel_launch: occupancy query reports %d workgroups per CU\n", per_cu);
        (void)hipGetLastError();
        grid = cus;
    }
    if (grid < 0) return;
    if (hipMemsetAsync((char*)d_ws + WS_CTL, 0, CTL_ZERO_BYTES, stream) != hipSuccess) return;
    Args a{};
    for (int i = 0; i < 19; ++i) a.in[i] = (const float*)d_in[i];
    a.out = (float*)d_out; a.ws = (unsigned char*)d_ws;
#if MK_N_LAUNCHES == 1
    a.ph_lo = 0; a.ph_hi = N_PHASES;
    hipLaunchKernelGGL(trunk_fwd, dim3(grid), dim3(NWAVES * 64), LDS_BYTES, stream, a);
#else
    for (int ph = 0; ph < N_PHASES; ++ph) { a.ph_lo = ph; a.ph_hi = ph + 1; hipLaunchKernelGGL(trunk_fwd, dim3(grid), dim3(NWAVES * 64), LDS_BYTES, stream, a); }
#endif
}
```

```cpp
#include <hip/hip_runtime.h>
#include <cstdio>
#include <cstdint>

#ifndef MK_N_LAUNCHES
#define MK_N_LAUNCHES 1
#endif

namespace pg8 {
#define PG8_LAS __attribute__((address_space(3)))
typedef unsigned short bf16_t;
typedef short bf16x8 __attribute__((ext_vector_type(8)));
typedef float f32x4 __attribute__((ext_vector_type(4)));
typedef unsigned u32x4 __attribute__((ext_vector_type(4)));
constexpr int M_MAIN_PANELS = 64;
constexpr int BM = 256, BK = 64, HALF = 128, HTB = HALF * BK * 2  , STAGE_BYTES = 8 * HTB, NXCD = 8, WGM = 8;

__host__ __device__ __forceinline__ int lds_byte(int r, int c) { const int st = (r >> 4) * 2 + (c >> 5), rr = r & 15, cc = c & 31, ob = rr * 64 + cc * 2; return st * 1024 + (ob ^ (((ob >> 9) & 1) << 5)); }
__host__ __device__ __forceinline__ void stage_rc(int b, int& R, int& C) { const int st = b / 1024, sb = b % 1024, swz = sb ^ (((sb >> 9) & 1) << 5); R = (st >> 1) * 16 + swz / 64; C = (st & 1) * 32 + (swz % 64) / 2; }
__host__ __device__ __forceinline__ int perm32(int rho) { const int n = rho >> 4, i = rho & 15; return 8 * (i >> 2) + 4 * n + (i & 3); }

struct Unit { int pm, pn, kt0, nkt; };
struct Gemm { const bf16_t* A; const bf16_t* Bt; int M, N, K; };

struct StaticOrder {
    int nM, nN, nwg, G, c, nktf, wgm;
    __host__ __device__ void init(int M, int N, int K, int G_, int c_) { nM = M / BM; nN = N / BM; nwg = nM * nN; G = G_; c = c_; nktf = K / BK; wgm = WGM; }
    __host__ __device__ __forceinline__ void main_unit(int L, Unit& u) const {
        int wgid = L; { const int q = nwg / NXCD, r = nwg % NXCD, xcd = wgid % NXCD, off = wgid / NXCD; wgid = (xcd < r ? xcd * (q + 1) : r * (q + 1) + (xcd - r) * q) + off; }
        const int nig = wgm * nN, ngrp = (nM / wgm) > 0 ? (nM / wgm) : 1; int gid = wgid / nig; gid = gid < ngrp ? gid : ngrp - 1;
        const int fm = gid * wgm, gsz = (gid == ngrp - 1) ? (nM - fm) : wgm, w = wgid - gid * nig;
        u.pm = fm + (w % gsz); u.pn = w / gsz; u.kt0 = 0; u.nkt = nktf;
    }
    __host__ __device__ __forceinline__ bool next(int i, Unit& u) const {
        const long L = (long)i * G + c; if (L >= nwg) return false;
        main_unit((int)L, u); return true;
    }
    __device__ __forceinline__ void a_ready(const Unit&) const {}
    __device__ __forceinline__ void done(const Unit&) const {}
    __device__ __forceinline__ unsigned fetch(int) const { return 0u; }
    __device__ __forceinline__ void commit(int, unsigned) const {}
    __device__ __forceinline__ bool resolve(int i, Unit& u) const { return next(i, u); }
};
struct TailSplitOrder : StaticOrder {
    int KS;
    __host__ __device__ __forceinline__ bool next(int i, Unit& u) const {
        const long L = (long)i * G + c; const bool is_main = L < nwg; const long mi = L - nwg;
        if (!is_main && mi >= (long)nN * KS) return false;
        Unit a; main_unit(is_main ? (int)L : 0, a);
        const int mn = nktf / KS, mpn = (int)(mi / KS), mks = (int)(mi % KS);
        u.pm = is_main ? a.pm : nM; u.pn = is_main ? a.pn : mpn; u.kt0 = is_main ? 0 : mks * mn; u.nkt = is_main ? nktf : mn;
        return true;
    }
    __device__ __forceinline__ bool resolve(int i, Unit& u) const { return next(i, u); }
};

struct DynOrder : TailSplitOrder {
    unsigned* ctr; PG8_LAS unsigned* slot; bool dyn;
    __device__ __forceinline__ void setup(unsigned* ctr_, PG8_LAS unsigned* slot_) { ctr = ctr_; slot = slot_; dyn = (G % 8 == 0) && G >= 8; }
    __device__ __forceinline__ bool entry(int k, Unit& u) const {
        const int x = c & 7; const int nmain = (nwg - x + 7) / 8; const bool is_main = k < nmain; const long mi = (long)(k - nmain) * 8 + x;
        if (!is_main && (KS == 0 || mi >= (long)nN * KS)) return false;
        Unit a; main_unit(is_main ? k * 8 + x : 0, a);
        const int ks_ = KS ? KS : 1, mn = nktf / ks_, mpn = (int)(mi / ks_), mks = (int)(mi % ks_);
        u.pm = is_main ? a.pm : nM; u.pn = is_main ? a.pn : mpn; u.kt0 = is_main ? 0 : mks * mn; u.nkt = is_main ? nktf : mn;
        return true;
    }
    __device__ __forceinline__ bool next(int i, Unit& u) const { return dyn ? entry(c >> 3, u) : TailSplitOrder::next(i, u); }
    __device__ __forceinline__ unsigned fetch(int) const { unsigned k = 0u; if (dyn && threadIdx.x == 0) k = (unsigned)(G >> 3) + __hip_atomic_fetch_add(ctr + 64 * (c & 7), 1u, __ATOMIC_RELAXED, __HIP_MEMORY_SCOPE_AGENT); return k; }
    __device__ __forceinline__ void commit(int ui, unsigned k) const { if (dyn && threadIdx.x == 0) slot[(ui + 1) & 1] = k; }
    __device__ __forceinline__ bool resolve(int i, Unit& u) const { if (!dyn) return TailSplitOrder::next(i, u); const int k = __builtin_amdgcn_readfirstlane((int)slot[i & 1]); return entry(k, u); }
};

__device__ __forceinline__ unsigned cvt_pk_bf16(float lo, float hi) { unsigned r; asm volatile("v_cvt_pk_bf16_f32 %0, %1, %2" : "=v"(r) : "v"(lo), "v"(hi)); return r; }

struct EpiSsdIn {
    static constexpr bool PERM = true, AFTER_DRAIN = false, KSCALE = false;
    bf16_t* Z; bf16_t* XBC; float* DTRAW; const float* RSTD;
    __device__ __forceinline__ void operator()(const f32x4 (&acc)[2][2][4][2], const Unit& u, int wr, int wc, int fr, int fq) const {
        const int row0 = u.pm * BM + wr * 64 + fr;
        if (u.pn < 32) {
            const int col0 = u.pn * BM + wc * 32 + 8 * fq;
            float rsv[2][4];
#pragma unroll
            for (int ai = 0; ai < 2; ++ai)
#pragma unroll
                for (int m = 0; m < 4; ++m) rsv[ai][m] = RSTD[row0 + ai * HALF + m * 16];
#pragma unroll
            for (int ai = 0; ai < 2; ++ai)
#pragma unroll
                for (int m = 0; m < 4; ++m) { bf16_t* rowp = Z + (size_t)(row0 + ai * HALF + m * 16) * 8192 + col0; const float rs = rsv[ai][m];
#pragma unroll
                    for (int bj = 0; bj < 2; ++bj) { float g[8];
#pragma unroll
                        for (int e = 0; e < 8; ++e) { const float x = acc[ai][bj][m][e >> 2][e & 3] * rs; g[e] = x * __builtin_amdgcn_rcpf(1.f + __builtin_amdgcn_exp2f(-1.44269504f * x)); }
                        u32x4 w; w.x = cvt_pk_bf16(g[0], g[1]); w.y = cvt_pk_bf16(g[2], g[3]); w.z = cvt_pk_bf16(g[4], g[5]); w.w = cvt_pk_bf16(g[6], g[7]);
                        *(u32x4*)(rowp + bj * HALF) = w; } }
        } else if (u.pn < 72) {
            const int col0 = (u.pn - 32) * BM + wc * 32 + 8 * fq;
#pragma unroll
            for (int ai = 0; ai < 2; ++ai)
#pragma unroll
                for (int m = 0; m < 4; ++m) { bf16_t* rowp = XBC + (size_t)(row0 + ai * HALF + m * 16) * 10240 + col0;
#pragma unroll
                    for (int bj = 0; bj < 2; ++bj) { const f32x4 v0 = acc[ai][bj][m][0], v1 = acc[ai][bj][m][1];
                        u32x4 w; w.x = cvt_pk_bf16(v0[0], v0[1]); w.y = cvt_pk_bf16(v0[2], v0[3]); w.z = cvt_pk_bf16(v1[0], v1[1]); w.w = cvt_pk_bf16(v1[2], v1[3]);
                        *(u32x4*)(rowp + bj * HALF) = w; } }
        } else {
            const int col0 = wc * 32 + 8 * fq;
#pragma unroll
            for (int ai = 0; ai < 2; ++ai)
#pragma unroll
                for (int m = 0; m < 4; ++m) { float* rowp = DTRAW + (size_t)(row0 + ai * HALF + m * 16) * 128 + col0;
                    *(f32x4*)(rowp) = acc[ai][0][m][0]; *(f32x4*)(rowp + 4) = acc[ai][0][m][1]; }
        }
    }
};
struct EpiBf16Plain {
    static constexpr bool PERM = true, AFTER_DRAIN = false, KSCALE = false;
    bf16_t* O; int ldc;
    __device__ __forceinline__ void operator()(const f32x4 (&acc)[2][2][4][2], const Unit& u, int wr, int wc, int fr, int fq) const {
        const int row0 = u.pm * BM + wr * 64 + fr, col0 = u.pn * BM + wc * 32 + 8 * fq;
#pragma unroll
        for (int ai = 0; ai < 2; ++ai)
#pragma unroll
            for (int m = 0; m < 4; ++m) { bf16_t* rowp = O + (size_t)(row0 + ai * HALF + m * 16) * ldc + col0;
#pragma unroll
                for (int bj = 0; bj < 2; ++bj) { const f32x4 v0 = acc[ai][bj][m][0], v1 = acc[ai][bj][m][1];
                    u32x4 w; w.x = cvt_pk_bf16(v0[0], v0[1]); w.y = cvt_pk_bf16(v0[2], v0[3]); w.z = cvt_pk_bf16(v1[0], v1[1]); w.w = cvt_pk_bf16(v1[2], v1[3]);
                    *(u32x4*)(rowp + bj * HALF) = w; } }
    }
};
struct EpiScIn {
    static constexpr bool PERM = true, AFTER_DRAIN = false, KSCALE = false;
    bf16_t* GC; const float* RSTD; float* SLAB;
    __device__ __forceinline__ void operator()(const f32x4 (&acc)[2][2][4][2], const Unit& u, int wr, int wc, int fr, int fq) const {
        const int j0 = u.pn * 64 + wc * 16 + fq * 4;
        if (u.pm >= M_MAIN_PANELS) {
            float* sl = SLAB + (size_t)(u.kt0 / u.nkt) * (256 * 16384) + (size_t)(wr * 64 + fr) * 16384 + j0;
#pragma unroll
            for (int ai = 0; ai < 2; ++ai)
#pragma unroll
                for (int m = 0; m < 4; ++m) { float* p = sl + (size_t)(ai * HALF + m * 16) * 16384;
                    *(f32x4*)(p) = acc[ai][0][m][0]; *(f32x4*)(p + 4096) = acc[ai][0][m][1]; *(f32x4*)(p + 8192) = acc[ai][1][m][0]; *(f32x4*)(p + 12288) = acc[ai][1][m][1]; }
            return;
        }
        const int row0 = u.pm * BM + wr * 64 + fr;
        float rsv[2][4];
#pragma unroll
        for (int ai = 0; ai < 2; ++ai)
#pragma unroll
            for (int m = 0; m < 4; ++m) rsv[ai][m] = RSTD[row0 + ai * HALF + m * 16];
#pragma unroll
        for (int ai = 0; ai < 2; ++ai)
#pragma unroll
            for (int m = 0; m < 4; ++m) { const int row = row0 + ai * HALF + m * 16; const float rs = rsv[ai][m], rs2 = rs * rs;
                const f32x4 g = acc[ai][0][m][0], b = acc[ai][0][m][1], c = acc[ai][1][m][0], v = acc[ai][1][m][1]; float gb[4], cv[4];
#pragma unroll
                for (int e = 0; e < 4; ++e) { const float x = g[e] * rs; gb[e] = x * __builtin_amdgcn_rcpf(1.f + __builtin_amdgcn_exp2f(-1.44269504f * x)) * (b[e] * rs); cv[e] = c[e] * v[e] * rs2; }
                u32x4 w; w.x = cvt_pk_bf16(gb[0], gb[1]); w.y = cvt_pk_bf16(gb[2], gb[3]); w.z = cvt_pk_bf16(cv[0], cv[1]); w.w = cvt_pk_bf16(cv[2], cv[3]);
                *(u32x4*)(GC + (size_t)row * 8192 + 2 * j0) = w; }
    }
};
struct EpiNone {
    static constexpr bool PERM = true, AFTER_DRAIN = false, KSCALE = false;
    __device__ __forceinline__ void operator()(const f32x4 (&acc)[2][2][4][2], const Unit&, int, int, int, int) const {
#pragma unroll
        for (int ai = 0; ai < 2; ++ai)
#pragma unroll
            for (int bj = 0; bj < 2; ++bj)
#pragma unroll
                for (int m = 0; m < 4; ++m) { asm volatile("" :: "v"(acc[ai][bj][m][0]), "v"(acc[ai][bj][m][1])); }
    }
};
__device__ __forceinline__ void kscale_prep(const float* CG, const Unit& u, PG8_LAS float* tbl) {
    int tid = threadIdx.x; asm volatile("" : "+v"(tid));
    if (tid < 256) { const float* p = CG + ((size_t)u.pm * BM + tid) * 8; const f32x4 a = *(const f32x4*)p, b = *(const f32x4*)(p + 4);
        f32x4 ra, rb; ra[0] = b[3]; ra[1] = a[0] * __builtin_amdgcn_rcpf(a[1]); ra[2] = a[1] * __builtin_amdgcn_rcpf(a[2]); ra[3] = a[2] * __builtin_amdgcn_rcpf(a[3]);
        rb[0] = a[3] * __builtin_amdgcn_rcpf(b[0]); rb[1] = b[0] * __builtin_amdgcn_rcpf(b[1]); rb[2] = b[1] * __builtin_amdgcn_rcpf(b[2]); rb[3] = b[2] * __builtin_amdgcn_rcpf(b[3]);
        *(PG8_LAS f32x4*)(tbl + tid * 8) = ra; *(PG8_LAS f32x4*)(tbl + tid * 8 + 4) = rb; }
}
__device__ __forceinline__ void kscale_step(f32x4 (&acc)[2][2][4][2], const PG8_LAS float* tbl, int g, int, int) {
    int tz = threadIdx.x; asm volatile("" : "+v"(tz)); const int wr = tz >> 8, fr = tz & 15;
#pragma unroll
    for (int ai = 0; ai < 2; ++ai)
#pragma unroll
        for (int m = 0; m < 4; ++m) { const int r = ai * HALF + wr * 64 + m * 16 + fr; const float ratio = tbl[r * 8 + g];
#pragma unroll
            for (int bj = 0; bj < 2; ++bj)
#pragma unroll
                for (int n = 0; n < 2; ++n) acc[ai][bj][m][n] = acc[ai][bj][m][n] * ratio; }
}
struct EpiResid {
    static constexpr bool PERM = true, AFTER_DRAIN = false, KSCALE = false;
    bf16_t* H; float* SSQ; float* SLAB;
    __device__ __forceinline__ void operator()(const f32x4 (&acc)[2][2][4][2], const Unit& u, int wr, int wc, int fr, int fq) const {
        const int row0 = u.pm * BM + wr * 64 + fr, col0 = u.pn * BM + wc * 32 + 8 * fq;
        if (u.pm >= M_MAIN_PANELS) {
            float* sl = SLAB + (size_t)(u.kt0 / u.nkt) * (256 * 4096) + (size_t)(wr * 64 + fr) * 4096 + col0;
#pragma unroll
            for (int ai = 0; ai < 2; ++ai)
#pragma unroll
                for (int m = 0; m < 4; ++m)
#pragma unroll
                    for (int bj = 0; bj < 2; ++bj) { float* p = sl + (size_t)(ai * HALF + m * 16) * 4096 + bj * HALF; *(f32x4*)p = acc[ai][bj][m][0]; *(f32x4*)(p + 4) = acc[ai][bj][m][1]; }
            return;
        }
        const unsigned off0 = ((unsigned)row0 * 4096u + (unsigned)col0) * 2u;
        const char* hb = (const char*)H;
#pragma unroll
        for (int ai = 0; ai < 2; ++ai) {
            u32x4 old[4][2];
#pragma unroll
            for (int m = 0; m < 4; ++m)
#pragma unroll
                for (int bj = 0; bj < 2; ++bj) old[m][bj] = *(const u32x4*)(hb + (off0 + (unsigned)((ai * HALF + m * 16) * 4096 + bj * HALF) * 2u));
#pragma unroll
            for (int m = 0; m < 4; ++m) { const int row = row0 + ai * HALF + m * 16; float ss = 0.f;
#pragma unroll
                for (int bj = 0; bj < 2; ++bj) { const u32x4 o = old[m][bj];
                    f32x4 v0 = acc[ai][bj][m][0], v1 = acc[ai][bj][m][1];
                    v0[0] += __uint_as_float(o.x << 16); v0[1] += __uint_as_float(o.x & 0xffff0000u); v0[2] += __uint_as_float(o.y << 16); v0[3] += __uint_as_float(o.y & 0xffff0000u);
                    v1[0] += __uint_as_float(o.z << 16); v1[1] += __uint_as_float(o.z & 0xffff0000u); v1[2] += __uint_as_float(o.w << 16); v1[3] += __uint_as_float(o.w & 0xffff0000u);
                    ss += (v0[0] * v0[0] + v0[1] * v0[1]) + (v0[2] * v0[2] + v0[3] * v0[3]) + (v1[0] * v1[0] + v1[1] * v1[1]) + (v1[2] * v1[2] + v1[3] * v1[3]);
                    u32x4 w; w.x = cvt_pk_bf16(v0[0], v0[1]); w.y = cvt_pk_bf16(v0[2], v0[3]); w.z = cvt_pk_bf16(v1[0], v1[1]); w.w = cvt_pk_bf16(v1[2], v1[3]);
                    *(u32x4*)((char*)H + (off0 + (unsigned)((ai * HALF + m * 16) * 4096 + bj * HALF) * 2u)) = w; }
                ss += __shfl_xor(ss, 16); ss += __shfl_xor(ss, 32);
                if (fq == 0) SSQ[(size_t)row * 64 + u.pn * 4 + wc] = ss; }
        }
    }
};

struct EpiResidN {
    static constexpr bool PERM = true, AFTER_DRAIN = false, KSCALE = true;
    EpiResid R; const float* CG;
    __device__ __forceinline__ void prep(const Unit& u, PG8_LAS float* tbl) const { kscale_prep(CG, u, tbl); }
    __device__ __forceinline__ void operator()(f32x4 (&acc)[2][2][4][2], const Unit& u, int, int, int, int, const PG8_LAS float* tbl) const {
        int tz = threadIdx.x; asm volatile("" : "+v"(tz)); const int wid = tz >> 6, lane = tz & 63, wr = wid >> 2, wc = wid & 3, fr = lane & 15, fq = lane >> 4;
        const int g = (u.pm >= M_MAIN_PANELS) ? (u.kt0 >> 4) : 7;
#pragma unroll
        for (int ai = 0; ai < 2; ++ai)
#pragma unroll
            for (int m = 0; m < 4; ++m) { const PG8_LAS float* tr = tbl + (ai * HALF + wr * 64 + m * 16 + fr) * 8; float c = tr[0];
                for (int k = 7; k > g; --k) c *= tr[k];
#pragma unroll
                for (int bj = 0; bj < 2; ++bj)
#pragma unroll
                    for (int n = 0; n < 2; ++n) acc[ai][bj][m][n] = acc[ai][bj][m][n] * c; }
        R(acc, u, wr, wc, fr, fq);
    }
};

template <class Epi, class Sched, bool ALIGN_EPI = false, bool SP2 = false>
__device__ __forceinline__ void gemm_phase(PG8_LAS unsigned char* lds, const Gemm g, const Sched& S, const Epi& E) {
    const int tid = threadIdx.x, wid = __builtin_amdgcn_readfirstlane(tid >> 6), lane = tid & 63, wr = wid >> 2, wc = wid & 3, fr = lane & 15, fq = lane >> 4;
    const int K = g.K;
    unsigned voffA, voffB;
    { int R, C; stage_rc(tid * 16, R, C); const int Rb = Epi::PERM ? ((R & ~31) + perm32(R & 31)) : R; voffA = (unsigned)(R * K + C) * 2u; voffB = (unsigned)(Rb * K + C) * 2u; }
    const size_t rstep = (size_t)64 * K * 2;
    const size_t kstep = (size_t)(BK * 2);
    const size_t hstep = (size_t)HALF * K * 2;
    const size_t tstep = 2 * hstep;
    const unsigned ldsw = (unsigned)wid * 1024u;
    const int aoff = lds_byte(wr * 64 + fr, fq * 8), boff = lds_byte(wc * 32 + fr, fq * 8);
#define PG8_SA(b, h) (((b) * 2 + (h)) * HTB)
#define PG8_SB(b, h) ((4 + (b) * 2 + (h)) * HTB)
#define PG8_STAGE(bufoff, gbase, voff) do { _Pragma("unroll") for (int _i = 0; _i < 2; ++_i) \
        __builtin_amdgcn_global_load_lds((const unsigned*)((const char*)(gbase) + (size_t)_i * rstep + (voff)), (PG8_LAS unsigned*)(lds + (bufoff) + ldsw + _i * 8192), 16, 0, 0); } while (0)
#define PG8_LDA(dst, b, h) do { _Pragma("unroll") for (int m = 0; m < 4; ++m) _Pragma("unroll") for (int k = 0; k < 2; ++k) dst[m][k] = *(const PG8_LAS bf16x8*)(lds + PG8_SA(b, h) + aoff + m * 2048 + k * 1024); } while (0)
#define PG8_LDB(dst, b, h) do { _Pragma("unroll") for (int n = 0; n < 2; ++n) _Pragma("unroll") for (int k = 0; k < 2; ++k) dst[n][k] = *(const PG8_LAS bf16x8*)(lds + PG8_SB(b, h) + boff + n * 2048 + k * 1024); } while (0)
#define PG8_MMA(ai, bj, At, Bt) do { __builtin_amdgcn_s_setprio(1); _Pragma("unroll") for (int m = 0; m < 4; ++m) _Pragma("unroll") for (int n = 0; n < 2; ++n) _Pragma("unroll") for (int k = 0; k < 2; ++k) \
        acc[ai][bj][m][n] = __builtin_amdgcn_mfma_f32_16x16x32_bf16(Bt[n][k], At[m][k], acc[ai][bj][m][n], 0, 0, 0); __builtin_amdgcn_s_setprio(0); } while (0)
#define PG8_WAIT_V(n) asm volatile("s_waitcnt vmcnt(" #n ")" ::: "memory")
#define PG8_WAIT_L(n) asm volatile("s_waitcnt lgkmcnt(" #n ")" ::: "memory")
#define PG8_BAR __builtin_amdgcn_s_barrier()
#define PG8_SCHED __builtin_amdgcn_sched_barrier(0)
    Unit cur, nxt; int ui = 0;
    if (!S.next(0, cur)) return;
    PG8_LAS float* const ktbl = (PG8_LAS float*)(lds + STAGE_BYTES);
    f32x4 acc[2][2][4][2];
#pragma unroll
    for (int a = 0; a < 2; ++a)
#pragma unroll
        for (int b = 0; b < 2; ++b)
#pragma unroll
            for (int m = 0; m < 4; ++m)
#pragma unroll
                for (int n = 0; n < 2; ++n) acc[a][b][m][n] = (f32x4){0.f, 0.f, 0.f, 0.f};
    bf16x8 At[4][2], B0[2][2], B1[2][2];
    const char* cA = (const char*)g.A + (size_t)cur.pm * tstep + (size_t)cur.kt0 * kstep; const char* cB = (const char*)g.Bt + (size_t)cur.pn * tstep + (size_t)cur.kt0 * kstep;
    S.a_ready(cur);
    if constexpr (Epi::KSCALE) E.prep(cur, ktbl);
    if constexpr (SP2) {
        PG8_STAGE(PG8_SB(0, 0), cB, voffB); PG8_STAGE(PG8_SB(0, 1), cB + hstep, voffB); PG8_STAGE(PG8_SA(0, 0), cA, voffA); PG8_STAGE(PG8_SA(0, 1), cA + hstep, voffA);
        if (wr == 1) PG8_BAR;
        PG8_WAIT_V(2); PG8_BAR;
        PG8_STAGE(PG8_SB(1, 0), cB + kstep, voffB); PG8_STAGE(PG8_SA(1, 0), cA + kstep, voffA); PG8_STAGE(PG8_SB(1, 1), cB + hstep + kstep, voffB);
        PG8_WAIT_V(6); PG8_BAR;
    } else {
        PG8_STAGE(PG8_SB(0, 0), cB, voffB); PG8_STAGE(PG8_SA(0, 0), cA, voffA); PG8_STAGE(PG8_SB(0, 1), cB + hstep, voffB); PG8_STAGE(PG8_SA(0, 1), cA + hstep, voffA);
        if (wr == 1) PG8_BAR;
        PG8_WAIT_V(4); PG8_BAR;
        PG8_STAGE(PG8_SB(1, 0), cB + kstep, voffB); PG8_STAGE(PG8_SA(1, 0), cA + kstep, voffA); PG8_STAGE(PG8_SB(1, 1), cB + hstep + kstep, voffB);
        PG8_WAIT_V(6); PG8_BAR;
    }
    for (;;) {
        const unsigned kclaim = S.fetch(ui);
        bool has_next = false; const char* nA = cA; const char* nB = cB;
        const int nt = cur.nkt;
        for (int t = 0; t < nt; t += 2) {
            const bool last = (t == nt - 2);
            if (t == (nt > 4 ? 2 : 0)) S.commit(ui, kclaim);
            if (last) { has_next = S.resolve(ui + 1, nxt);
                if (has_next) { nA = (const char*)g.A + (size_t)nxt.pm * tstep + (size_t)nxt.kt0 * kstep; nB = (const char*)g.Bt + (size_t)nxt.pn * tstep + (size_t)nxt.kt0 * kstep; } }
            const char* a1 = cA + (size_t)(t + 1) * kstep;
            const char* a2 = last ? nA : cA + (size_t)(t + 2) * kstep; const char* b2 = last ? nB : cB + (size_t)(t + 2) * kstep;
            const char* a3 = a2 + kstep; const char* b3 = b2 + kstep;
            if (last && has_next) S.a_ready(nxt);
            if constexpr (Epi::KSCALE) { const int kt = cur.kt0 + t; if (t > 0 && (kt & 15) == 0) kscale_step(acc, ktbl + (ui & 1) * 2048, kt >> 4, wr, fr); }
            if constexpr (SP2) {
            PG8_LDB(B0, 0, 0); PG8_LDB(B1, 0, 1); PG8_SCHED; PG8_LDA(At, 0, 0); PG8_STAGE(PG8_SA(1, 1), a1 + hstep, voffA);
            PG8_WAIT_V(8); PG8_WAIT_L(0); PG8_BAR; PG8_MMA(0, 0, At, B0); PG8_MMA(0, 1, At, B1); PG8_BAR; PG8_SCHED;
            PG8_LDA(At, 0, 1); PG8_STAGE(PG8_SB(0, 0), b2, voffB); PG8_STAGE(PG8_SB(0, 1), b2 + hstep, voffB); PG8_STAGE(PG8_SA(0, 0), a2, voffA);
            PG8_WAIT_V(8); PG8_WAIT_L(0); PG8_BAR; PG8_MMA(1, 0, At, B0); PG8_MMA(1, 1, At, B1); PG8_BAR; PG8_SCHED;
            PG8_LDB(B0, 1, 0); PG8_LDB(B1, 1, 1); PG8_SCHED; PG8_LDA(At, 1, 0); PG8_STAGE(PG8_SA(0, 1), a2 + hstep, voffA);
            PG8_WAIT_V(8); PG8_WAIT_L(0); PG8_BAR; PG8_MMA(0, 0, At, B0); PG8_MMA(0, 1, At, B1); PG8_BAR; PG8_SCHED;
            PG8_LDA(At, 1, 1); PG8_STAGE(PG8_SB(1, 0), b3, voffB); PG8_STAGE(PG8_SB(1, 1), b3 + hstep, voffB); PG8_STAGE(PG8_SA(1, 0), a3, voffA);
            PG8_WAIT_V(8); PG8_WAIT_L(0); PG8_BAR; PG8_MMA(1, 0, At, B0); PG8_MMA(1, 1, At, B1); PG8_BAR; PG8_SCHED;
            } else {
            PG8_LDB(B0, 0, 0); PG8_SCHED; PG8_LDA(At, 0, 0); PG8_STAGE(PG8_SA(1, 1), a1 + hstep, voffA);
            PG8_WAIT_L(8); PG8_BAR; PG8_WAIT_L(0); PG8_MMA(0, 0, At, B0); PG8_BAR; PG8_SCHED;
            PG8_LDB(B1, 0, 1); PG8_STAGE(PG8_SB(0, 0), b2, voffB);
            PG8_BAR; PG8_WAIT_L(0); PG8_MMA(0, 1, At, B1); PG8_BAR;
            PG8_LDA(At, 0, 1); PG8_STAGE(PG8_SA(0, 0), a2, voffA);
            PG8_BAR; PG8_WAIT_L(0); PG8_MMA(1, 0, At, B0); PG8_BAR; PG8_SCHED;
            PG8_STAGE(PG8_SB(0, 1), b2 + hstep, voffB);
            PG8_WAIT_V(6); PG8_BAR; PG8_MMA(1, 1, At, B1); PG8_BAR;
            PG8_LDB(B0, 1, 0); PG8_SCHED; PG8_LDA(At, 1, 0); PG8_STAGE(PG8_SA(0, 1), a2 + hstep, voffA);
            PG8_WAIT_L(8); PG8_BAR; PG8_WAIT_L(0); PG8_MMA(0, 0, At, B0); PG8_BAR; PG8_SCHED;
            PG8_LDB(B1, 1, 1); PG8_STAGE(PG8_SB(1, 0), b3, voffB);
            PG8_BAR; PG8_WAIT_L(0); PG8_MMA(0, 1, At, B1); PG8_BAR;
            PG8_LDA(At, 1, 1); PG8_STAGE(PG8_SA(1, 0), a3, voffA);
            PG8_BAR; PG8_WAIT_L(0); PG8_MMA(1, 0, At, B0); PG8_BAR; PG8_SCHED;
            PG8_STAGE(PG8_SB(1, 1), b3 + hstep, voffB);
            PG8_WAIT_V(6); PG8_BAR; PG8_MMA(1, 1, At, B1); PG8_BAR;
            }
        }
        if constexpr (ALIGN_EPI) { if (wr == 0) PG8_BAR; }
        if constexpr (Epi::KSCALE) { E(acc, cur, wr, wc, fr, fq, ktbl + (ui & 1) * 2048); if (has_next) E.prep(nxt, ktbl + ((ui + 1) & 1) * 2048); }
        else E(acc, cur, wr, wc, fr, fq);
        S.done(cur);
        if (!has_next) break;
#pragma unroll
        for (int a = 0; a < 2; ++a)
#pragma unroll
            for (int b = 0; b < 2; ++b)
#pragma unroll
                for (int m = 0; m < 4; ++m)
#pragma unroll
                    for (int n = 0; n < 2; ++n) acc[a][b][m][n] = (f32x4){0.f, 0.f, 0.f, 0.f};
        cur = nxt; cA = nA; cB = nB; ++ui;
        if constexpr (ALIGN_EPI) { if (wr == 1) PG8_BAR; }
    }
    PG8_WAIT_V(0);
    if constexpr (!ALIGN_EPI) { if (wr == 0) PG8_BAR; }
    PG8_BAR;
#undef PG8_SA
#undef PG8_SB
#undef PG8_STAGE
#undef PG8_LDA
#undef PG8_LDB
#undef PG8_MMA
#undef PG8_WAIT_V
#undef PG8_WAIT_L
#undef PG8_BAR
#undef PG8_SCHED
}
}

constexpr int D = 4096, DI = 8192, NH = 128, HD = 64, NG = 8, DS = 128, CONVD = 10240;
constexpr int SSD_PROJ = 18560, SSD_PROJ_PAD = 18688, SC_PROJ = 16384;
constexpr int NB = 4, SEQ = 4096, NMETA = 16, NSB = 8, LS = 16;
constexpr int ROW_META = 16384, ROW_SAMPLE = 16448, M_REAL = 16576, M_PAD = 16640, M_MAIN = 16384;
#ifndef G2_WGM
#define G2_WGM 2
#endif
constexpr int NSEG = 1036;
constexpr float EPS = 1e-5f;
constexpr int NWAVES = 8;

constexpr size_t MiB = 1u << 20;
constexpr size_t WS_CTL = 0, CTL_ZERO_BYTES = 1 * MiB;
constexpr size_t SZ_W_SSD_IN1 = (size_t)SSD_PROJ_PAD * D * 2, SZ_W_SSD_OUT1 = (size_t)D * DI * 2, SZ_W_SC_IN1 = (size_t)SC_PROJ * D * 2, SZ_W_SC_OUT1 = (size_t)D * D * 2;
constexpr size_t WS_W_SSD_IN = 1 * MiB;
constexpr size_t WS_W_SSD_OUT = WS_W_SSD_IN + 2 * SZ_W_SSD_IN1;
constexpr size_t WS_W_SC_IN = WS_W_SSD_OUT + 2 * SZ_W_SSD_OUT1;
constexpr size_t WS_W_SC_OUT = WS_W_SC_IN + 2 * SZ_W_SC_IN1;
constexpr size_t WS_H = WS_W_SC_OUT + 2 * SZ_W_SC_OUT1;
constexpr size_t WS_SSQ = WS_H + (size_t)M_PAD * D * 2;
constexpr size_t WS_PROJ = WS_SSQ + (size_t)M_PAD * 64 * 4;
constexpr size_t SZ_Z = (size_t)M_PAD * DI * 2, SZ_XBC = (size_t)M_PAD * CONVD * 2, SZ_DT = (size_t)M_PAD * NH * 4;
constexpr size_t WS_Z = WS_PROJ, WS_XBC = WS_Z + SZ_Z, WS_DTRAW = WS_XBC + SZ_XBC;
constexpr size_t WS_GC = WS_PROJ;
constexpr size_t WS_XACT = WS_DTRAW + SZ_DT;
constexpr size_t WS_YN = WS_XACT;
constexpr size_t WS_DT = WS_XACT + SZ_XBC;
constexpr size_t WS_Y = WS_DT + SZ_DT;
constexpr size_t WS_YSQ = WS_Y + SZ_Z;
constexpr size_t WS_RSTD = WS_YSQ + 4 * SZ_DT;
constexpr size_t WS_SLAB = WS_RSTD + (size_t)M_PAD * 4;
constexpr size_t WS_CG = WS_SLAB + (size_t)16 * 256 * 4096 * 4;
constexpr size_t WS_END = WS_CG + (size_t)M_PAD * 8 * 4;
static_assert((size_t)M_PAD * SC_PROJ * 2 <= SZ_Z + SZ_XBC + SZ_DT, "SC projection overlays the SSD projection region");
static_assert(WS_END % 256 == 0 && WS_XACT % 256 == 0 && WS_Y % 256 == 0, "alignment");
constexpr int CW_BAR = 4096;

constexpr size_t O_YP = 0, O_YS = O_YP + (size_t)NB * SEQ * D, O_SSM_P = O_YS + (size_t)NSB * LS * D, O_CONV_P = O_SSM_P + (size_t)2 * NB * NH * HD * DS,
                 O_SC_P = O_CONV_P + (size_t)2 * NB * 3 * CONVD, O_SSM_S = O_SC_P + (size_t)2 * NB * 2 * D, O_CONV_S = O_SSM_S + (size_t)2 * NSB * NH * HD * DS,
                 O_SC_S = O_CONV_S + (size_t)2 * NSB * 3 * CONVD, O_END = O_SC_S + (size_t)2 * NSB * 2 * D;

constexpr int RING_OFF = 0, RING_BYTES = 131072;
constexpr int LDS_BYTES = 163840;
constexpr int SMALL_OFF = 147456;
constexpr int LDSCTL_OFF = LDS_BYTES - 512, MISC_OFF = LDSCTL_OFF + 320;

#define GAS __attribute__((address_space(1)))
#define LAS __attribute__((address_space(3)))
typedef unsigned short bf16;
typedef unsigned v4u __attribute__((ext_vector_type(4)));
typedef unsigned v2u __attribute__((ext_vector_type(2)));
typedef float f32x4 __attribute__((ext_vector_type(4)));
typedef float f32x2 __attribute__((ext_vector_type(2)));
typedef GAS unsigned gu32;
#define RLX_AGENT __ATOMIC_RELAXED, __HIP_MEMORY_SCOPE_AGENT
#define LDS_WAIT() asm volatile("s_waitcnt lgkmcnt(0)" ::: "memory")
#define VM_WAIT() asm volatile("s_waitcnt vmcnt(0)" ::: "memory")
__device__ __forceinline__ unsigned pk2(float lo, float hi) { return pg8::cvt_pk_bf16(lo, hi); }
__device__ __forceinline__ float bflo(unsigned u) { return __uint_as_float(u << 16); }
__device__ __forceinline__ float bfhi(unsigned u) { return __uint_as_float(u & 0xffff0000u); }
__device__ __forceinline__ void unpack8(const v4u w, float (&f)[8]) { f[0] = bflo(w.x); f[1] = bfhi(w.x); f[2] = bflo(w.y); f[3] = bfhi(w.y); f[4] = bflo(w.z); f[5] = bfhi(w.z); f[6] = bflo(w.w); f[7] = bfhi(w.w); }
__device__ __forceinline__ v4u pack8(const float (&f)[8]) { v4u o; o.x = pk2(f[0], f[1]); o.y = pk2(f[2], f[3]); o.z = pk2(f[4], f[5]); o.w = pk2(f[6], f[7]); return o; }
__device__ __forceinline__ float silu_f(float x) { return x * __builtin_amdgcn_rcpf(1.f + __expf(-x)); }
__device__ __forceinline__ float softplus_f(float x) { return fmaxf(x, 0.f) + log1pf(__expf(-fabsf(x))); }

#define XB_TMO      128
#define XB_XCNT(j)  (256  + 64 * (j))
#define XB_XSUB(j)  (1280 + 64 * (j))
#define XB_XGEN(j)  (2304 + 64 * (j))
#define XB_TOP      3328
#define XB_TOPGEN   3392
#define XCD_BAR_WORDS 3456
#define XB_SPIN_CAP (1u << 18)
__device__ __forceinline__ unsigned xb_ld(unsigned* p)              { return __hip_atomic_load(p, __ATOMIC_RELAXED, __HIP_MEMORY_SCOPE_AGENT); }
__device__ __forceinline__ unsigned xb_add(unsigned* p, unsigned v) { return __hip_atomic_fetch_add(p, v, __ATOMIC_RELAXED, __HIP_MEMORY_SCOPE_AGENT); }
__device__ __forceinline__ unsigned xb_xcc_id() { return (unsigned)__builtin_amdgcn_s_getreg((3 << 11) | 20) & 0xFu; }
#define XB_SPIN(cond, bar) do { unsigned _sp = 0; while (cond) { __builtin_amdgcn_s_sleep(1); \
    if ((++_sp & 255u) == 0u) { if (xb_ld(&(bar)[XB_TMO])) break; if (_sp > XB_SPIN_CAP) { atomicAdd(&(bar)[XB_TMO], 1u); break; } } } } while (0)
struct XcdBarrier { unsigned* bar; unsigned x; volatile LAS unsigned* st; };
__device__ __forceinline__ XcdBarrier xcd_barrier_post(unsigned* bar, volatile LAS unsigned* st) {
    XcdBarrier b; b.bar = bar; b.x = xb_xcc_id(); b.st = st;
    if (threadIdx.x == 0) (void)xb_add(&bar[XB_XCNT(b.x)], 1u);
    return b;
}
__device__ __forceinline__ void xcd_barrier_complete(unsigned* bar, unsigned x, unsigned& nloc, unsigned& nx) {
    const unsigned G = gridDim.x * gridDim.y * gridDim.z;
    unsigned sum, cnt, mine, sp = 0u;
    for (;;) {
        sum = 0u; cnt = 0u; mine = 0u;
#pragma unroll
        for (unsigned j = 0; j < 16; ++j) { const unsigned c = xb_ld(&bar[XB_XCNT(j)]); sum += c; cnt += (c > 0u) ? 1u : 0u; mine = (j == x) ? c : mine; }
        if (sum == G) break;
        __builtin_amdgcn_s_sleep(1);
        if ((++sp & 255u) == 0u) { if (xb_ld(&bar[XB_TMO])) break; if (sp > XB_SPIN_CAP) { atomicAdd(&bar[XB_TMO], 1u); break; } }
    }
    nloc = mine > 0u ? mine : 1u; nx = cnt > 0u ? cnt : 1u;
}
__device__ __forceinline__ void xcd_barrier(const XcdBarrier& b) {
    asm volatile("s_waitcnt vmcnt(0)" ::: "memory");
    __syncthreads();
    if (threadIdx.x == 0) {
        unsigned* bar = b.bar;
        __builtin_amdgcn_s_waitcnt(0);
        unsigned nloc = b.st[0], nx = b.st[1];
        if (nloc == 0u) { xcd_barrier_complete(bar, b.x, nloc, nx); b.st[0] = nloc; b.st[1] = nx; }
        const unsigned old = xb_add(&bar[XB_XSUB(b.x)], 1u);
        const unsigned gen = old / nloc;
        if (old + 1u == (gen + 1u) * nloc) {
            __builtin_amdgcn_fence(__ATOMIC_RELEASE, "agent");
            asm volatile("s_waitcnt vmcnt(0)" ::: "memory");
            const unsigned og = xb_add(&bar[XB_TOP], 1u);
            const unsigned tg = og / nx;
            if (og + 1u == (tg + 1u) * nx) xb_add(&bar[XB_TOPGEN], 1u);
            else XB_SPIN(xb_ld(&bar[XB_TOPGEN]) == tg, bar);
            __builtin_amdgcn_fence(__ATOMIC_ACQUIRE, "agent");
            xb_add(&bar[XB_XGEN(b.x)], 1u);
            asm volatile("s_waitcnt vmcnt(0)" ::: "memory");
        } else {
            XB_SPIN(xb_ld(&bar[XB_XGEN(b.x)]) == gen, bar);
            __builtin_amdgcn_fence(__ATOMIC_ACQUIRE, "agent");
            asm volatile("s_waitcnt vmcnt(0)" ::: "memory");
        }
    }
    __syncthreads();
}

struct Args { const float* in[19]; float* out; unsigned char* ws; int ph_lo, ph_hi; };
struct Frame {
    LAS unsigned char* lds;
    int tid, lane, wave, vcu, G;
    GAS unsigned char* ws; GAS float* out;
};
template <class T> __device__ __forceinline__ GAS T* uni(T* p) { const unsigned long long v = (unsigned long long)p; const unsigned lo = __builtin_amdgcn_readfirstlane((unsigned)v), hi = __builtin_amdgcn_readfirstlane((unsigned)(v >> 32)); return (GAS T*)(((unsigned long long)hi << 32) | lo); }
__device__ __forceinline__ float wave_sum(float v) {
#pragma unroll
    for (int o = 1; o < 64; o <<= 1) v += __shfl_xor(v, o);
    return v;
}

__host__ __device__ __forceinline__ int sc_in_row(int wcol) { const int type = wcol >> 12, j = wcol & 4095, pn = j >> 6, jj = j & 63; return 256 * pn + 128 * (type >> 1) + 32 * (jj >> 4) + 8 * ((jj >> 2) & 3) + 4 * (type & 1) + (jj & 3); }
template <int SCPERM>
__device__ __forceinline__ void p0_transpose_item(const float* W, int K, int N, const float* ksc, bf16* WT, LAS float* scr, int item, int lane) {
    const int nblk = N / 32, kb = item / nblk, nb = item % nblk, k0 = 64 * kb, n0 = 32 * nb;
#pragma unroll 8
    for (int i = 0; i < 32; ++i) { const int kk = 2 * i + (lane >> 5); scr[kk * 33 + (lane & 31)] = __builtin_nontemporal_load(W + (size_t)(k0 + kk) * N + n0 + (lane & 31)) * ksc[k0 + kk]; }
    LDS_WAIT(); asm volatile("" ::: "memory");
    const int c = lane & 7;
#pragma unroll
    for (int j = 0; j < 4; ++j) { const int n = (lane >> 3) + 8 * j; const LAS float* s = scr + (8 * c) * 33 + n;
        v4u o; o.x = pk2(s[0 * 33], s[1 * 33]); o.y = pk2(s[2 * 33], s[3 * 33]); o.z = pk2(s[4 * 33], s[5 * 33]); o.w = pk2(s[6 * 33], s[7 * 33]);
        const int drow = SCPERM ? sc_in_row(n0 + n) : (n0 + n);
        __builtin_nontemporal_store(o, (v4u*)(WT + (size_t)drow * K + k0 + 8 * c)); }
    LDS_WAIT(); asm volatile("" ::: "memory");
}
constexpr int I_A = (D / 64) * (SSD_PROJ / 32), I_B = (DI / 64) * (D / 32), I_C = (D / 64) * (SC_PROJ / 32), I_D = (D / 64) * (D / 32), I_L = I_A + I_B + I_C + I_D;
constexpr int LATE0_BEGIN = I_L, LATE0_COUNT = 26000;
constexpr int LATE1_BEGIN = I_L + I_A, LATE1_COUNT = 26000;
static_assert(LATE0_COUNT <= I_A && LATE1_COUNT <= I_B + I_C, "late ranges");
__device__ __forceinline__ void p0_item(Frame& F, const Args& A, LAS float* scr, int it) {
    const int j = it / I_L; int r = it % I_L;
    if (r < I_A) { p0_transpose_item<0>(A.in[7] + (size_t)j * D * SSD_PROJ, D, SSD_PROJ, A.in[6] + (size_t)(2 * j) * D, (bf16*)(F.ws + WS_W_SSD_IN + j * SZ_W_SSD_IN1), scr, r, F.lane); return; } r -= I_A;
    if (r < I_B) { p0_transpose_item<0>(A.in[14] + (size_t)j * DI * D, DI, D, A.in[13] + (size_t)j * DI, (bf16*)(F.ws + WS_W_SSD_OUT + j * SZ_W_SSD_OUT1), scr, r, F.lane); return; } r -= I_B;
    if (r < I_C) { p0_transpose_item<1>(A.in[15] + (size_t)j * D * SC_PROJ, D, SC_PROJ, A.in[6] + (size_t)(2 * j + 1) * D, (bf16*)(F.ws + WS_W_SC_IN + j * SZ_W_SC_IN1), scr, r, F.lane); return; } r -= I_C;
    { const float* W = A.in[17] + (size_t)j * D * D; bf16* WT = (bf16*)(F.ws + WS_W_SC_OUT + j * SZ_W_SC_OUT1);
      const int nblk = D / 32, kb = r / nblk, nb = r % nblk, k0 = 64 * kb, n0 = 32 * nb; const int lane = F.lane;
#pragma unroll 8
      for (int i = 0; i < 32; ++i) { const int kk = 2 * i + (lane >> 5); scr[kk * 33 + (lane & 31)] = __builtin_nontemporal_load(W + (size_t)(k0 + kk) * D + n0 + (lane & 31)); }
      LDS_WAIT(); asm volatile("" ::: "memory");
      const int c = lane & 7;
#pragma unroll
      for (int jj = 0; jj < 4; ++jj) { const int n = (lane >> 3) + 8 * jj; const LAS float* s = scr + (8 * c) * 33 + n;
          v4u o; o.x = pk2(s[0 * 33], s[1 * 33]); o.y = pk2(s[2 * 33], s[3 * 33]); o.z = pk2(s[4 * 33], s[5 * 33]); o.w = pk2(s[6 * 33], s[7 * 33]);
          __builtin_nontemporal_store(o, (v4u*)(WT + (size_t)(n0 + n) * D + k0 + 8 * c)); }
      LDS_WAIT(); asm volatile("" ::: "memory"); }
}
__device__ __forceinline__ void late_convert(Frame& F, const Args& A, int begin, int count) {
    constexpr int NWG1 = (M_PAD / 256) * (SSD_PROJ_PAD / 256);
    const int rem = NWG1 % F.G, c = (int)blockIdx.x;
    LAS float* scr = (LAS float*)(F.lds + RING_OFF + F.wave * 16384);
    if (rem == 0) { const int gw = F.vcu * NWAVES + F.wave; for (int it = gw; it < count; it += F.G * NWAVES) p0_item(F, A, scr, begin + it); return; }
    if (c < rem) return;
    const int rank = (c - rem) * NWAVES + F.wave, nw = (F.G - rem) * NWAVES;
    for (int it = rank; it < count; it += nw) p0_item(F, A, scr, begin + it);
}
__device__ __forceinline__ void p0_prologue(Frame& F, const Args& A) {
    LAS float* scr = (LAS float*)(F.lds + RING_OFF + F.wave * 16384);
    const int gw = F.vcu * NWAVES + F.wave, NGW = F.G * NWAVES;
    constexpr int N_EARLY = 2 * I_L - LATE0_COUNT - LATE1_COUNT;
    for (int e = gw; e < N_EARLY; e += NGW) {
        int it = e; if (it >= LATE0_BEGIN) it += LATE0_COUNT; if (it >= LATE1_BEGIN) it += LATE1_COUNT;
        p0_item(F, A, scr, it);
    }
    { const size_t gt = (size_t)F.vcu * 512 + F.tid, GT = (size_t)F.G * 512;
      for (size_t i = gt; i < (size_t)2 * 128 * D / 8; i += GT) { const size_t j = i / (128 * D / 8), o = i % (128 * D / 8);
          *(v4u*)(F.ws + WS_W_SSD_IN + j * SZ_W_SSD_IN1 + (size_t)SSD_PROJ * D * 2 + o * 16) = (v4u){0u, 0u, 0u, 0u}; } }
    bf16* H = (bf16*)(F.ws + WS_H); float* SSQ = (float*)(F.ws + WS_SSQ);
    for (int m = gw; m < M_PAD; m += NGW) {
        const float* src = nullptr;
        if (m < ROW_META) src = A.in[0] + (size_t)m * D;
        else if (m < ROW_SAMPLE) src = A.in[5] + (size_t)((m - ROW_META) & 15) * D;
        else if (m < M_REAL) src = A.in[1] + (size_t)(m - ROW_SAMPLE) * D;
        float s = 0.f;
        f32x4 xa[8], xb[8];
#pragma unroll
        for (int jj = 0; jj < 8; ++jj) {
            if (src) { xa[jj] = __builtin_nontemporal_load((const f32x4*)(src + 8 * (64 * jj + F.lane))); xb[jj] = __builtin_nontemporal_load((const f32x4*)(src + 8 * (64 * jj + F.lane) + 4)); }
            else { xa[jj] = (f32x4){0.f, 0.f, 0.f, 0.f}; xb[jj] = xa[jj]; } }
#pragma unroll
        for (int jj = 0; jj < 8; ++jj) {
            const float f[8] = {xa[jj][0], xa[jj][1], xa[jj][2], xa[jj][3], xb[jj][0], xb[jj][1], xb[jj][2], xb[jj][3]};
#pragma unroll
            for (int e = 0; e < 8; ++e) s += f[e] * f[e];
            *(v4u*)(H + (size_t)m * D + 8 * (64 * jj + F.lane)) = pack8(f);
        }
        s = wave_sum(s);
        SSQ[(size_t)m * 64 + F.lane] = (F.lane == 0) ? s : 0.f;
        if (F.lane == 0) ((float*)(F.ws + WS_RSTD))[m] = rsqrtf(s * (1.f / D) + EPS);
    }
}

struct Seg { int row0, b, k, is_sample, is_last; };
__device__ __forceinline__ Seg seg_decode(int seg) {
    Seg s;
    if (seg < NB * 257) { s.b = seg / 257; s.k = seg % 257; s.is_sample = 0; s.is_last = (s.k == 256);
        s.row0 = (s.k == 0) ? ROW_META + 16 * s.b : s.b * SEQ + 16 * (s.k - 1); }
    else { s.b = seg - NB * 257; s.k = -1; s.is_sample = 1; s.is_last = 1; s.row0 = ROW_SAMPLE + 16 * s.b; }
    return s;
}
__device__ __forceinline__ int seg_halo(const Seg& s, int d) {
    if (s.is_sample || s.k == 0) return -1;
    if (s.k == 1) return ROW_META + 16 * s.b + 16 - d;
    return s.row0 - d;
}
__device__ __forceinline__ float row_rstd8(const float* SSQ, int row, int sub) {
    float s = 0.f;
    if (row >= 0) { const f32x4 a = *(const f32x4*)(SSQ + (size_t)row * 64 + sub * 8), b = *(const f32x4*)(SSQ + (size_t)row * 64 + sub * 8 + 4);
        s = (a[0] + a[1]) + (a[2] + a[3]) + (b[0] + b[1]) + (b[2] + b[3]); }
    s += __shfl_xor(s, 1); s += __shfl_xor(s, 2); s += __shfl_xor(s, 4);
    return row >= 0 ? rsqrtf(s * (1.f / D) + EPS) : 0.f;
}

__device__ __forceinline__ void ssd_conv_phase(Frame& F, const Args& A, int j) {
    const GAS unsigned char* XBCb = F.ws + WS_XBC; GAS unsigned char* XACTb = F.ws + WS_XACT;
    const float* DTRAW = (const float*)(F.ws + WS_DTRAW); float* DT = (float*)(F.ws + WS_DT); const float* RSTD = (const float*)(F.ws + WS_RSTD);
    const float* cw = A.in[8] + (size_t)j * 4 * CONVD; const float* cb = A.in[9] + (size_t)j * CONVD; const float* dtb = A.in[10] + (size_t)j * NH;
    const float* st_in = A.in[3] + (size_t)j * NSB * 3 * CONVD;
    const int NHW = 2 * F.G, hw = 2 * F.vcu + (F.wave >> 2), tl = F.tid & 255;
    const int hpart = hw % 5, rank = hw / 5, nranks = (NHW - hpart + 4) / 5;
    const int c0 = hpart * 2048 + tl * 8; const unsigned voff = (unsigned)c0 * 2u;
#define XBC_ROW(r) (__builtin_nontemporal_load((const GAS v4u*)(XBCb + (size_t)(r) * (CONVD * 2) + voff)))
    float w[4][8], bias[8];
#pragma unroll
    for (int k = 0; k < 4; ++k) { const f32x4 a = *(const f32x4*)(cw + (size_t)k * CONVD + c0), b = *(const f32x4*)(cw + (size_t)k * CONVD + c0 + 4);
        w[k][0] = a[0]; w[k][1] = a[1]; w[k][2] = a[2]; w[k][3] = a[3]; w[k][4] = b[0]; w[k][5] = b[1]; w[k][6] = b[2]; w[k][7] = b[3]; }
    { const f32x4 a = *(const f32x4*)(cb + c0), b = *(const f32x4*)(cb + c0 + 4); bias[0] = a[0]; bias[1] = a[1]; bias[2] = a[2]; bias[3] = a[3]; bias[4] = b[0]; bias[5] = b[1]; bias[6] = b[2]; bias[7] = b[3]; }
    for (int seg = rank; seg < NSEG; seg += nranks) {
        const Seg s = seg_decode(seg);
        float r3[8], r2[8], r1[8];
#pragma unroll
        for (int d = 3; d >= 1; --d) {
            float (&dst)[8] = (d == 3) ? r3 : (d == 2) ? r2 : r1;
            if (s.is_sample) { const float* p = st_in + ((size_t)s.b * 3 + (3 - d)) * CONVD + c0; const f32x4 a = *(const f32x4*)p, b = *(const f32x4*)(p + 4);
                dst[0] = a[0]; dst[1] = a[1]; dst[2] = a[2]; dst[3] = a[3]; dst[4] = b[0]; dst[5] = b[1]; dst[6] = b[2]; dst[7] = b[3]; }
            else { const int hr = seg_halo(s, d);
                if (hr >= 0) { unpack8(XBC_ROW(hr), dst); const float rs = RSTD[hr];
#pragma unroll
                    for (int e = 0; e < 8; ++e) dst[e] *= rs; }
                else {
#pragma unroll
                    for (int e = 0; e < 8; ++e) dst[e] = 0.f; } }
        }
        v4u rawv[16]; float rsv[16];
#pragma unroll
        for (int i = 0; i < 16; ++i) { rawv[i] = XBC_ROW(s.row0 + i); rsv[i] = RSTD[s.row0 + i]; }
#pragma unroll
        for (int i = 0; i < 16; ++i) {
            float cur[8], o[8]; unpack8(rawv[i], cur); const float rs = rsv[i];
#pragma unroll
            for (int e = 0; e < 8; ++e) { cur[e] *= rs; const float v = __builtin_fmaf(w[3][e], cur[e], __builtin_fmaf(w[2][e], r1[e], __builtin_fmaf(w[1][e], r2[e], __builtin_fmaf(w[0][e], r3[e], bias[e])))); o[e] = silu_f(v);
                r3[e] = r2[e]; r2[e] = r1[e]; r1[e] = cur[e]; }
            *(GAS v4u*)(XACTb + (size_t)(s.row0 + i) * (CONVD * 2) + voff) = pack8(o);
        }
        if (s.is_last) {
            GAS float* ob = F.out + (s.is_sample ? O_CONV_S + ((size_t)j * NSB + s.b) * 3 * CONVD : O_CONV_P + ((size_t)j * NB + s.b) * 3 * CONVD) + c0;
            *(GAS f32x4*)(ob) = (f32x4){r3[0], r3[1], r3[2], r3[3]}; *(GAS f32x4*)(ob + 4) = (f32x4){r3[4], r3[5], r3[6], r3[7]};
            *(GAS f32x4*)(ob + CONVD) = (f32x4){r2[0], r2[1], r2[2], r2[3]}; *(GAS f32x4*)(ob + CONVD + 4) = (f32x4){r2[4], r2[5], r2[6], r2[7]};
            *(GAS f32x4*)(ob + 2 * CONVD) = (f32x4){r1[0], r1[1], r1[2], r1[3]}; *(GAS f32x4*)(ob + 2 * CONVD + 4) = (f32x4){r1[4], r1[5], r1[6], r1[7]};
        }
    }
#undef XBC_ROW
    for (size_t i = (size_t)F.vcu * 512 + F.tid; i < (size_t)M_REAL * (NH / 8); i += (size_t)F.G * 512) { const size_t row = i >> 4; const int h0 = (int)(i & 15) * 8; const float rs = RSTD[row];
        const f32x4 a = *(const f32x4*)(DTRAW + row * NH + h0), b = *(const f32x4*)(DTRAW + row * NH + h0 + 4);
        const f32x4 ba = *(const f32x4*)(dtb + h0), bb = *(const f32x4*)(dtb + h0 + 4);
        f32x4 oa, ob;
#pragma unroll
        for (int e = 0; e < 4; ++e) { oa[e] = softplus_f(a[e] * rs + ba[e]); ob[e] = softplus_f(b[e] * rs + bb[e]); }
        *(f32x4*)(DT + row * NH + h0) = oa; *(f32x4*)(DT + row * NH + h0 + 4) = ob; }
}

typedef short s16x4 __attribute__((ext_vector_type(4)));
typedef short bf16x8 __attribute__((ext_vector_type(8)));
#define MFMA16(a, b, c) __builtin_amdgcn_mfma_f32_16x16x32_bf16((a), (b), (c), 0, 0, 0)
__device__ __forceinline__ bf16x8 frag_row(const LAS unsigned char* base, int stride, int row, int kbyte) { return *(const LAS bf16x8*)(base + row * stride + kbyte); }
__device__ __forceinline__ bf16x8 frag_tr(const LAS unsigned char* base, int stride, int k0, int c0, int lane) {
    const int g = lane >> 4, i16 = lane & 15, qq = i16 >> 2, pp = i16 & 3;
    const LAS unsigned char* p = base + (k0 + 8 * g + qq) * stride + (c0 + 4 * pp) * 2;
    const s16x4 lo = __builtin_amdgcn_ds_read_tr16_b64_v4i16((LAS s16x4*)p);
    const s16x4 hi = __builtin_amdgcn_ds_read_tr16_b64_v4i16((LAS s16x4*)(p + 4 * stride));
    return __builtin_shufflevector(lo, hi, 0, 1, 2, 3, 4, 5, 6, 7);
}
__device__ __forceinline__ void ssd_scan_phase(Frame& F, const Args& A, int j) {
    constexpr int S128 = 272, S64 = 144;
    constexpr int OFF_B = 0, OFF_C = 17408, OFF_XD = 34816, OFF_XE = 53248, OFF_L = 71680, OFF_H = 90112, OFF_XD2 = 124928;
    constexpr int SM_ACS = 0, SM_EA = 128, SM_DTD = 256, SM_DTE = 384, SM_ETOT = 512, SM_V = 520, SM_U = 648, SM_STRIDE = 1040;
#define LDS_BARRIER() do { asm volatile("s_waitcnt lgkmcnt(0)" ::: "memory"); __builtin_amdgcn_s_barrier(); asm volatile("" ::: "memory"); } while (0)
    LAS unsigned char* const L = F.lds;
    LAS float* const SM = (LAS float*)(F.lds + SMALL_OFF);
    const bf16* XACT = (const bf16*)(F.ws + WS_XACT); const float* DT = (const float*)(F.ws + WS_DT); bf16* Y = (bf16*)(F.ws + WS_Y);
    const bf16* Z = (const bf16*)(F.ws + WS_Z); float* YSQ = (float*)(F.ws + WS_YSQ);
    LAS float* const PS = SM + 2 * SM_STRIDE;
    const float* a_log = A.in[11] + (size_t)j * NH; const float* d_skip = A.in[12] + (size_t)j * NH;
    const int tid = F.tid, lane = F.lane, w = F.wave, hh = w >> 2, pt = w & 3, q = lane >> 4, l16 = lane & 15;
    for (int item = F.vcu; item < (NB + NSB) * 64; item += F.G) {
        const int is_sample = item >= NB * 64, idx = is_sample ? item - NB * 64 : item, b = idx >> 6, hp = idx & 63, nblocks = is_sample ? 1 : 65;
        const int head = 2 * hp + hh, g = hp >> 3;
        const float Dh = d_skip[head];
        const int sm_h = (w == 4) ? 1 : (w == 6) ? 0 : -1;
        const int head_s = 2 * hp + (sm_h > 0 ? 1 : 0); const float A_own = -__expf(a_log[head_s]);
        f32x4 hacc[8];
        if (is_sample) { const float* sp = A.in[2] + ((((size_t)j * NSB + b) * NH + head) * HD + 16 * pt + l16) * DS + 4 * q;
#pragma unroll
            for (int n8 = 0; n8 < 8; ++n8) hacc[n8] = *(const f32x4*)(sp + 16 * n8); }
        else {
#pragma unroll
            for (int n8 = 0; n8 < 8; ++n8) hacc[n8] = (f32x4){0.f, 0.f, 0.f, 0.f}; }
        v4u pbc[4], px[2];
        int row0 = is_sample ? ROW_SAMPLE + 16 * b : ROW_META + 16 * b, nt = 16;
#define SCAN_PREFETCH(r0_, nt_) do { \
            _Pragma("unroll") for (int k_ = 0; k_ < 4; ++k_) { const int i_ = tid + 512 * k_, mat_ = i_ >> 10, r_ = (i_ >> 4) & 63, c8_ = i_ & 15; \
                pbc[k_] = (r_ < (nt_)) ? *(const v4u*)(XACT + (size_t)((r0_) + r_) * CONVD + DI + mat_ * (NG * DS) + g * DS + c8_ * 8) : (v4u){0u, 0u, 0u, 0u}; } \
            _Pragma("unroll") for (int k_ = 0; k_ < 2; ++k_) { const int i_ = tid + 512 * k_, h2_ = i_ >> 9, r_ = (i_ >> 3) & 63, c8_ = i_ & 7; \
                px[k_] = (r_ < (nt_)) ? *(const v4u*)(XACT + (size_t)((r0_) + r_) * CONVD + (2 * hp + h2_) * HD + c8_ * 8) : (v4u){0u, 0u, 0u, 0u}; } } while (0)
#define SCAN_DTLOAD(r0_, nt_) ((sm_h >= 0 && lane < (nt_)) ? DT[(size_t)((r0_) + lane) * NH + head_s] : 0.f)
#define SCAN_SMALL(dtv_, par_) do { if (sm_h >= 0) { const int hh = sm_h; LAS float* sm_ = SM + (par_) * SM_STRIDE; \
            const float dt_ = (dtv_); float acs_ = dt_ * (A_own * 1.44269504f); \
            _Pragma("unroll") for (int o_ = 1; o_ < 64; o_ <<= 1) { const float v_ = __shfl_up(acs_, o_); if (lane >= o_) acs_ += v_; } \
            const float r0_ = __shfl(acs_, 15), r1_ = __shfl(acs_, 31), r2_ = __shfl(acs_, 47), atot_ = __shfl(acs_, 63); \
            const float myr_ = lane < 16 ? r0_ : lane < 32 ? r1_ : lane < 48 ? r2_ : atot_;              \
            sm_[SM_ACS + hh * 64 + lane] = acs_; sm_[SM_EA + hh * 64 + lane] = __builtin_amdgcn_exp2f(acs_); sm_[SM_DTD + hh * 64 + lane] = dt_; sm_[SM_DTE + hh * 64 + lane] = dt_ * __builtin_amdgcn_exp2f(atot_ - acs_); \
            sm_[SM_V + hh * 64 + lane] = dt_ * __builtin_amdgcn_exp2f(myr_ - acs_); \
            sm_[SM_U + hh * 192 + lane] = __builtin_amdgcn_exp2f(fminf(acs_ - r0_, 0.f)); sm_[SM_U + hh * 192 + 64 + lane] = __builtin_amdgcn_exp2f(fminf(acs_ - r1_, 0.f)); sm_[SM_U + hh * 192 + 128 + lane] = __builtin_amdgcn_exp2f(fminf(acs_ - r2_, 0.f)); \
            if (lane == 0) sm_[SM_ETOT + hh] = __builtin_amdgcn_exp2f(atot_); } } while (0)
#define SCAN_STAGE(par_) do { const LAS float* sm_ = SM + (par_) * SM_STRIDE; \
            _Pragma("unroll") for (int k_ = 0; k_ < 4; ++k_) { const int i_ = tid + 512 * k_, mat_ = i_ >> 10, r_ = (i_ >> 4) & 63, c8_ = i_ & 15; \
                *(LAS v4u*)(L + (mat_ ? OFF_C : OFF_B) + r_ * S128 + c8_ * 16) = pbc[k_]; } \
            _Pragma("unroll") for (int k_ = 0; k_ < 2; ++k_) { const int i_ = tid + 512 * k_, h2_ = i_ >> 9, r_ = (i_ >> 3) & 63, c8_ = i_ & 7; \
                float f_[8], e_[8]; unpack8(px[k_], f_); const float se_ = sm_[SM_DTE + h2_ * 64 + r_]; \
                _Pragma("unroll") for (int e2_ = 0; e2_ < 8; ++e2_) { e_[e2_] = f_[e2_] * se_; } \
                *(LAS v4u*)(L + ((par_) ? OFF_XD2 : OFF_XD) + h2_ * 64 * S64 + r_ * S64 + c8_ * 16) = px[k_]; *(LAS v4u*)(L + OFF_XE + h2_ * 64 * S64 + r_ * S64 + c8_ * 16) = pack8(e_); } } while (0)
#define SCAN_WRITE_HS() do { _Pragma("unroll") for (int n8 = 0; n8 < 8; ++n8) { v2u hw_; hw_.x = pk2(hacc[n8][0], hacc[n8][1]); hw_.y = pk2(hacc[n8][2], hacc[n8][3]); \
            *(LAS v2u*)(L + OFF_H + hh * 64 * S128 + (16 * pt + l16) * S128 + (16 * n8 + 4 * q) * 2) = hw_; } } while (0)
        LDS_BARRIER();
        { const float dt0 = SCAN_DTLOAD(row0, nt); SCAN_PREFETCH(row0, nt); SCAN_SMALL(dt0, 0); }
        float dtA = (nblocks > 1) ? SCAN_DTLOAD(b * SEQ, 64) : 0.f;
        LDS_BARRIER();
        SCAN_STAGE(0);
        SCAN_WRITE_HS();
        int row0p = row0, ntp = nt;
        for (int blk = 0; blk < nblocks; ++blk) {
            const int par = blk & 1; const LAS float* sm = SM + par * SM_STRIDE;
            const bool has_next = blk + 1 < nblocks; const int row0n = b * SEQ + 64 * blk, ntn = 64;
            LDS_BARRIER();
            if (has_next) { SCAN_PREFETCH(row0n, ntn); }
            const float dtB = (blk + 2 < nblocks) ? SCAN_DTLOAD(b * SEQ + 64 * (blk + 1), 64) : 0.f;
            if (blk > 0 && sm_h >= 0) { const float sq = (PS[(sm_h * 4 + 0) * 64 + lane] + PS[(sm_h * 4 + 1) * 64 + lane]) + (PS[(sm_h * 4 + 2) * 64 + lane] + PS[(sm_h * 4 + 3) * 64 + lane]);
                if (lane < ntp) YSQ[(size_t)(row0p + lane) * NH + head_s] = sq; }
            v2u ez[4];
#pragma unroll
            for (int jt = 0; jt < 4; ++jt) { const int t = 16 * jt + l16; const size_t row = (size_t)(row0 + (t < nt ? t : 0));
                ez[jt] = *(const v2u*)(Z + row * DI + head * HD + 16 * pt + 4 * q); }
            { const int it_ = w >> 1, jt0 = 2 * (w & 1);
              if (it_ <= jt0 + 1) {
                  f32x4 g0 = (f32x4){0.f, 0.f, 0.f, 0.f}, g1 = g0;
#pragma unroll
                  for (int ks = 0; ks < 4; ++ks) { const int kb = (32 * ks + 8 * q) * 2;
                      const bf16x8 a = frag_row(L + OFF_B, S128, 16 * it_ + l16, kb), b1 = frag_row(L + OFF_C, S128, 16 * (jt0 + 1) + l16, kb);
                      g1 = MFMA16(a, b1, g1);
                      if (it_ <= jt0) { const bf16x8 b0 = frag_row(L + OFF_C, S128, 16 * jt0 + l16, kb); g0 = MFMA16(a, b0, g0); } }
#pragma unroll
                  for (int h2 = 0; h2 < 2; ++h2) {
#pragma unroll
                      for (int x = 0; x < 2; ++x) { const int jt = jt0 + x, t = 16 * jt + l16; const f32x4 gg = x ? g1 : g0; float v[4];
                          if (it_ > jt) { v[0] = 0.f; v[1] = 0.f; v[2] = 0.f; v[3] = 0.f; }
                          else if (it_ == jt) { const f32x4 as = *(const LAS f32x4*)(sm + SM_ACS + h2 * 64 + 16 * it_ + 4 * q), ds = *(const LAS f32x4*)(sm + SM_DTD + h2 * 64 + 16 * it_ + 4 * q); const float at = sm[SM_ACS + h2 * 64 + t];
#pragma unroll
                              for (int r = 0; r < 4; ++r) { const int s_ = 16 * it_ + 4 * q + r; v[r] = (s_ <= t) ? gg[r] * (ds[r] * __builtin_amdgcn_exp2f(at - as[r])) : 0.f; } }
                          else { const f32x4 vs = *(const LAS f32x4*)(sm + SM_V + h2 * 64 + 16 * it_ + 4 * q); const float ut = sm[SM_U + h2 * 192 + it_ * 64 + t];
#pragma unroll
                              for (int r = 0; r < 4; ++r) v[r] = gg[r] * (ut * vs[r]); }
                          if (it_ <= jt || ((it_ & 1) && it_ == jt + 1)) { v2u lw; lw.x = pk2(v[0], v[1]); lw.y = pk2(v[2], v[3]);
                              *(LAS v2u*)(L + OFF_L + h2 * 64 * S64 + t * S64 + (16 * it_ + 4 * q) * 2) = lw; } } } } }
            f32x4 yacc[4];
#pragma unroll
            for (int jt = 0; jt < 4; ++jt) yacc[jt] = (f32x4){0.f, 0.f, 0.f, 0.f};
#pragma unroll
            for (int ks = 0; ks < 4; ++ks) { const int kb = (32 * ks + 8 * q) * 2; const bf16x8 a = frag_row(L + OFF_H + hh * 64 * S128, S128, 16 * pt + l16, kb);
#pragma unroll
                for (int jt = 0; jt < 4; ++jt) { const bf16x8 bb = frag_row(L + OFF_C, S128, 16 * jt + l16, kb); yacc[jt] = MFMA16(a, bb, yacc[jt]); } }
#pragma unroll
            for (int jt = 0; jt < 4; ++jt) { const float ea = sm[SM_EA + hh * 64 + 16 * jt + l16]; yacc[jt] = yacc[jt] * ea; }
            { const float etot = sm[SM_ETOT + hh];
#pragma unroll
              for (int n8 = 0; n8 < 8; ++n8) hacc[n8] = hacc[n8] * etot;
#pragma unroll
              for (int ks = 0; ks < 2; ++ks) { const bf16x8 bb = frag_tr(L + OFF_XE + hh * 64 * S64, S64, 32 * ks, 16 * pt, lane);
#pragma unroll
                  for (int n8 = 0; n8 < 8; ++n8) { const bf16x8 a = frag_tr(L + OFF_B, S128, 32 * ks, 16 * n8, lane); hacc[n8] = MFMA16(a, bb, hacc[n8]); } } }
            if (has_next) { SCAN_SMALL(dtA, par ^ 1); }
            dtA = dtB;
            LDS_BARRIER();
#pragma unroll
            for (int ks = 0; ks < 2; ++ks) { const bf16x8 a = frag_tr(L + (par ? OFF_XD2 : OFF_XD) + hh * 64 * S64, S64, 32 * ks, 16 * pt, lane); const int kb = (32 * ks + 8 * q) * 2;
#pragma unroll
                for (int jt = 0; jt < 4; ++jt) { if (ks == 1 && jt < 2) continue;
                    const bf16x8 bb = frag_row(L + OFF_L + hh * 64 * S64, S64, 16 * jt + l16, kb); yacc[jt] = MFMA16(a, bb, yacc[jt]); } }
            SCAN_WRITE_HS();
#pragma unroll
            for (int jt = 0; jt < 4; ++jt) { const int t = 16 * jt + l16;
                const v2u xv = *(const LAS v2u*)(L + (par ? OFF_XD2 : OFF_XD) + hh * 64 * S64 + t * S64 + (16 * pt + 4 * q) * 2);
                const float o0 = (yacc[jt][0] + Dh * bflo(xv.x)) * bflo(ez[jt].x), o1 = (yacc[jt][1] + Dh * bfhi(xv.x)) * bfhi(ez[jt].x);
                const float o2 = (yacc[jt][2] + Dh * bflo(xv.y)) * bflo(ez[jt].y), o3 = (yacc[jt][3] + Dh * bfhi(xv.y)) * bfhi(ez[jt].y);
                float ss = (o0 * o0 + o1 * o1) + (o2 * o2 + o3 * o3); ss += __shfl_xor(ss, 16); ss += __shfl_xor(ss, 32);
                if (q == 0) PS[(hh * 4 + pt) * 64 + t] = ss;
                if (t < nt) { v2u ow; ow.x = pk2(o0, o1); ow.y = pk2(o2, o3);
                    *(v2u*)(Y + (size_t)(row0 + t) * DI + head * HD + 16 * pt + 4 * q) = ow; } }
            if (has_next) { SCAN_STAGE(par ^ 1); }
            row0p = row0; ntp = nt; row0 = row0n; nt = ntn;
        }
        LDS_BARRIER();
        if (sm_h >= 0) { const float sq = (PS[(sm_h * 4 + 0) * 64 + lane] + PS[(sm_h * 4 + 1) * 64 + lane]) + (PS[(sm_h * 4 + 2) * 64 + lane] + PS[(sm_h * 4 + 3) * 64 + lane]);
            if (lane < ntp) YSQ[(size_t)(row0p + lane) * NH + head_s] = sq; }
        { GAS float* op = F.out + (is_sample ? O_SSM_S + ((((size_t)j * NSB + b) * NH + head) * HD + 16 * pt + l16) * DS : O_SSM_P + ((((size_t)j * NB + b) * NH + head) * HD + 16 * pt + l16) * DS) + 4 * q;
#pragma unroll
          for (int n8 = 0; n8 < 8; ++n8) *(GAS f32x4*)(op + 16 * n8) = hacc[n8]; }
#undef SCAN_PREFETCH
#undef SCAN_DTLOAD
#undef SCAN_SMALL
#undef SCAN_STAGE
#undef SCAN_WRITE_HS
    }
}

__device__ __forceinline__ void ssd_scale_phase(Frame& F) {
    const float* YSQ = (const float*)(F.ws + WS_YSQ); float* CG = (float*)(F.ws + WS_CG);
    const int gw = F.vcu * NWAVES + F.wave, NGW = F.G * NWAVES;
    for (int m = gw; m < M_PAD; m += NGW) {
        f32x2 v = *(const f32x2*)(YSQ + (size_t)m * NH + 2 * F.lane);
        float sq = (m < M_REAL) ? v[0] + v[1] : 0.f;
        sq += __shfl_xor(sq, 1); sq += __shfl_xor(sq, 2); sq += __shfl_xor(sq, 4);
        if ((F.lane & 7) == 0) CG[(size_t)m * 8 + (F.lane >> 3)] = rsqrtf(sq * (1.f / 1024.f) + EPS);
    }
}

__device__ __forceinline__ void sc_tail_sum(const float* SLAB, int r, int type, int c0, float (&f)[8]) {
#pragma unroll
    for (int e = 0; e < 8; ++e) f[e] = 0.f;
#pragma unroll
    for (int k = 0; k < 4; ++k) { const float* p = SLAB + (size_t)k * (256 * 16384) + (size_t)r * 16384 + type * 4096 + c0; const f32x4 a = *(const f32x4*)p, b = *(const f32x4*)(p + 4);
        f[0] += a[0]; f[1] += a[1]; f[2] += a[2]; f[3] += a[3]; f[4] += b[0]; f[5] += b[1]; f[6] += b[2]; f[7] += b[3]; }
}
__device__ __forceinline__ void sc_elem_phase(Frame& F, const Args& A, int j) {
    const bf16* GC = (const bf16*)(F.ws + WS_GC); const float* SLAB = (const float*)(F.ws + WS_SLAB);
    bf16* Y = (bf16*)(F.ws + WS_Y); const float* RSTD = (const float*)(F.ws + WS_RSTD);
    const float* cw = A.in[16] + (size_t)j * 3 * D; const float* st_in = A.in[4] + (size_t)j * NSB * 2 * D;
    const bool tail_wg = (F.G > 24) && (F.vcu < 12);
    const int c0 = tail_wg ? F.wave * 512 + F.lane * 8 : F.tid * 8;
    float w[3][8];
#pragma unroll
    for (int k = 0; k < 3; ++k) { const f32x4 a = *(const f32x4*)(cw + (size_t)k * D + c0), b = *(const f32x4*)(cw + (size_t)k * D + c0 + 4);
        w[k][0] = a[0]; w[k][1] = a[1]; w[k][2] = a[2]; w[k][3] = a[3]; w[k][4] = b[0]; w[k][5] = b[1]; w[k][6] = b[2]; w[k][7] = b[3]; }
    if (tail_wg || F.G <= 24) {
        for (int t = tail_wg ? F.vcu : 0; t < 12; t += tail_wg ? 12 : 1) {
          for (int sl = tail_wg ? 0 : 0; sl < (tail_wg ? 1 : 8); ++sl) {
            const int cc = tail_wg ? c0 : sl * 512 + F.lane * 8;
            if (!tail_wg && F.wave != 0) continue;
            if (!tail_wg && F.vcu != 0) continue;
            const int seg = (t < 4) ? t * 257 : NB * 257 + (t - 4);
            const Seg s = seg_decode(seg);
            float ww[3][8];
#pragma unroll
            for (int k = 0; k < 3; ++k) { const f32x4 a = *(const f32x4*)(cw + (size_t)k * D + cc), b = *(const f32x4*)(cw + (size_t)k * D + cc + 4);
                ww[k][0] = a[0]; ww[k][1] = a[1]; ww[k][2] = a[2]; ww[k][3] = a[3]; ww[k][4] = b[0]; ww[k][5] = b[1]; ww[k][6] = b[2]; ww[k][7] = b[3]; }
            float r2[8], r1[8];
            if (s.is_sample) {
#pragma unroll
                for (int d = 2; d >= 1; --d) { float (&dst)[8] = (d == 2) ? r2 : r1; const float* p = st_in + ((size_t)s.b * 2 + (2 - d)) * D + cc; const f32x4 a = *(const f32x4*)p, b = *(const f32x4*)(p + 4);
                    dst[0] = a[0]; dst[1] = a[1]; dst[2] = a[2]; dst[3] = a[3]; dst[4] = b[0]; dst[5] = b[1]; dst[6] = b[2]; dst[7] = b[3]; } }
            else {
#pragma unroll
                for (int e = 0; e < 8; ++e) { r2[e] = 0.f; r1[e] = 0.f; } }
            for (int i = 0; i < 16; ++i) { const int row = s.row0 + i; const float rs = RSTD[row], rs2 = rs * rs;
                float gf[8], bf[8], cf[8], vf[8], o[8];
                sc_tail_sum(SLAB, row - ROW_META, 0, cc, gf); sc_tail_sum(SLAB, row - ROW_META, 1, cc, bf); sc_tail_sum(SLAB, row - ROW_META, 2, cc, cf); sc_tail_sum(SLAB, row - ROW_META, 3, cc, vf);
#pragma unroll
                for (int e = 0; e < 8; ++e) { const float cv = cf[e] * vf[e] * rs2; const float conv = ww[0][e] * r2[e] + ww[1][e] * r1[e] + ww[2][e] * cv;
                    o[e] = silu_f(gf[e] * rs) * (bf[e] * rs) * conv; r2[e] = r1[e]; r1[e] = cv; }
                *(v4u*)(Y + (size_t)row * D + cc) = pack8(o); }
            if (s.is_last) {
                GAS float* ob = F.out + O_SC_S + ((size_t)j * NSB + s.b) * 2 * D + cc;
                *(GAS f32x4*)(ob) = (f32x4){r2[0], r2[1], r2[2], r2[3]}; *(GAS f32x4*)(ob + 4) = (f32x4){r2[4], r2[5], r2[6], r2[7]};
                *(GAS f32x4*)(ob + D) = (f32x4){r1[0], r1[1], r1[2], r1[3]}; *(GAS f32x4*)(ob + D + 4) = (f32x4){r1[4], r1[5], r1[6], r1[7]}; }
          }
        }
        if (tail_wg) return;
    }
    const int nwg = tail_wg ? 0 : (F.G > 24 ? F.G - 12 : F.G), rank = (F.G > 24) ? F.vcu - 12 : F.vcu;
    for (int n = rank; n < NB * 256; n += nwg) {
        const int b = n >> 8, k = (n & 255) + 1; const int row0 = b * SEQ + 16 * (k - 1);
        float r2[8], r1[8];
#pragma unroll
        for (int d = 2; d >= 1; --d) {
            float (&dst)[8] = (d == 2) ? r2 : r1;
            const int hr = (k == 1) ? ROW_META + 16 * b + 16 - d : row0 - d;
            if (hr >= ROW_META) { float cf[8], vf[8]; sc_tail_sum(SLAB, hr - ROW_META, 2, c0, cf); sc_tail_sum(SLAB, hr - ROW_META, 3, c0, vf); const float rs = RSTD[hr], rs2 = rs * rs;
#pragma unroll
                for (int e = 0; e < 8; ++e) dst[e] = cf[e] * vf[e] * rs2; }
            else { const v4u q0 = *(const v4u*)(GC + (size_t)hr * 8192 + 2 * c0), q1 = *(const v4u*)(GC + (size_t)hr * 8192 + 2 * c0 + 8);
                dst[0] = bflo(q0.z); dst[1] = bfhi(q0.z); dst[2] = bflo(q0.w); dst[3] = bfhi(q0.w); dst[4] = bflo(q1.z); dst[5] = bfhi(q1.z); dst[6] = bflo(q1.w); dst[7] = bfhi(q1.w); }
        }
        v4u q0v[16], q1v[16];
#pragma unroll
        for (int i = 0; i < 16; ++i) { const size_t off = (size_t)(row0 + i) * D + c0; q0v[i] = __builtin_nontemporal_load((const v4u*)(GC + 2 * off)); q1v[i] = __builtin_nontemporal_load((const v4u*)(GC + 2 * off + 8)); }
#pragma unroll
        for (int i = 0; i < 16; ++i) { const size_t off = (size_t)(row0 + i) * D + c0; const v4u q0 = q0v[i], q1 = q1v[i];
            const float gb[8] = {bflo(q0.x), bfhi(q0.x), bflo(q0.y), bfhi(q0.y), bflo(q1.x), bfhi(q1.x), bflo(q1.y), bfhi(q1.y)};
            const float cv[8] = {bflo(q0.z), bfhi(q0.z), bflo(q0.w), bfhi(q0.w), bflo(q1.z), bfhi(q1.z), bflo(q1.w), bfhi(q1.w)}; float o[8];
#pragma unroll
            for (int e = 0; e < 8; ++e) { o[e] = gb[e] * __builtin_fmaf(w[2][e], cv[e], __builtin_fmaf(w[1][e], r1[e], w[0][e] * r2[e])); r2[e] = r1[e]; r1[e] = cv[e]; }
            *(v4u*)(Y + off) = pack8(o); }
        if (k == 256) {
            GAS float* ob = F.out + O_SC_P + ((size_t)j * NB + b) * 2 * D + c0;
            *(GAS f32x4*)(ob) = (f32x4){r2[0], r2[1], r2[2], r2[3]}; *(GAS f32x4*)(ob + 4) = (f32x4){r2[4], r2[5], r2[6], r2[7]};
            *(GAS f32x4*)(ob + D) = (f32x4){r1[0], r1[1], r1[2], r1[3]}; *(GAS f32x4*)(ob + D + 4) = (f32x4){r1[4], r1[5], r1[6], r1[7]}; }
    }
}

__device__ __forceinline__ void final_phase(Frame& F, const Args& A) {
    const bf16* H = (const bf16*)(F.ws + WS_H); const float* RSTD = (const float*)(F.ws + WS_RSTD); const float* fw = A.in[18];
    const int gw = F.vcu * NWAVES + F.wave, NGW = F.G * NWAVES;
    for (int mm = gw; mm < NB * SEQ + NSB * LS; mm += NGW) {
        const int m = (mm < NB * SEQ) ? mm : mm + (ROW_SAMPLE - ROW_META);
        const float rs = RSTD[m];
        GAS float* orow = F.out + (size_t)mm * D;
        v4u hv[8];
#pragma unroll
        for (int jj = 0; jj < 8; ++jj) hv[jj] = __builtin_nontemporal_load((const v4u*)(H + (size_t)m * D + 8 * (64 * jj + F.lane)));
#pragma unroll
        for (int jj = 0; jj < 8; ++jj) { const int c = 8 * (64 * jj + F.lane); float f[8]; unpack8(hv[jj], f);
            const f32x4 wa = *(const f32x4*)(fw + c), wb = *(const f32x4*)(fw + c + 4);
            __builtin_nontemporal_store((f32x4){f[0] * rs * wa[0], f[1] * rs * wa[1], f[2] * rs * wa[2], f[3] * rs * wa[3]}, (GAS f32x4*)(orow + c));
            __builtin_nontemporal_store((f32x4){f[4] * rs * wb[0], f[5] * rs * wb[1], f[6] * rs * wb[2], f[7] * rs * wb[3]}, (GAS f32x4*)(orow + c + 4)); }
    }
}

__device__ __forceinline__ void tail_fixup_phase(Frame& F) {
    bf16* H = (bf16*)(F.ws + WS_H); float* SSQ = (float*)(F.ws + WS_SSQ); const float* SLAB = (const float*)(F.ws + WS_SLAB); float* RSTD = (float*)(F.ws + WS_RSTD);
    LAS float* red = (LAS float*)(F.lds + SMALL_OFF);
    for (int r = F.vcu; r < 256; r += F.G) {
        const int row = ROW_META + r; const int c = F.tid * 8;
        float f[8]; unpack8(*(const v4u*)(H + (size_t)row * D + c), f);
#pragma unroll
        for (int k = 0; k < 16; ++k) { const float* p = SLAB + (size_t)k * (256 * 4096) + (size_t)r * 4096 + c; const f32x4 a = *(const f32x4*)p, b = *(const f32x4*)(p + 4);
            f[0] += a[0]; f[1] += a[1]; f[2] += a[2]; f[3] += a[3]; f[4] += b[0]; f[5] += b[1]; f[6] += b[2]; f[7] += b[3]; }
        float ss = 0.f;
#pragma unroll
        for (int e = 0; e < 8; ++e) ss += f[e] * f[e];
        *(v4u*)(H + (size_t)row * D + c) = pack8(f);
        ss = wave_sum(ss);
        __syncthreads();
        if (F.lane == 0) red[F.wave] = ss;
        __syncthreads();
        if (F.tid < 64) { float t = 0.f;
#pragma unroll
            for (int k = 0; k < NWAVES; ++k) t += red[k];
            SSQ[(size_t)row * 64 + F.tid] = (F.tid == 0) ? t : 0.f; if (F.tid == 0) RSTD[row] = rsqrtf(t * (1.f / D) + EPS); }
    }
    { const int gw = F.vcu * NWAVES + F.wave, NGW = F.G * NWAVES;
      for (int m = gw; m < M_MAIN; m += NGW) { const float t = wave_sum(SSQ[(size_t)m * 64 + F.lane]); if (F.lane == 0) RSTD[m] = rsqrtf(t * (1.f / D) + EPS); } }
}

enum { T_PRO = 0, T_G1 = 1, T_CONV = 2, T_SCAN = 3, T_NORM = 4, T_G2 = 5, T_FIX2 = 6, T_G3 = 7, T_SCE = 8, T_G4 = 9, T_FIX4 = 10, T_FIN = 11 };
constexpr int N_PHASES = 22;
#ifndef PROBE_TYPES
#define PROBE_TYPES 0
#endif
#define REPS(T) (((PROBE_TYPES >> (T)) & 1) ? 2 : 1)

__global__ void __launch_bounds__(NWAVES * 64, 2) trunk_fwd(Args args) {
    extern __shared__ __attribute__((aligned(16))) unsigned char lds[];
    Frame F;
    F.lds = (LAS unsigned char*)lds;
    F.tid = threadIdx.x; F.lane = F.tid & 63; F.wave = __builtin_amdgcn_readfirstlane(F.tid >> 6);
    F.G = gridDim.x; { const int bx = blockIdx.x; F.vcu = (F.G % 8 == 0) ? (bx % 8) * (F.G / 8) + bx / 8 : bx; }
    const Args& A = args;
    F.ws = uni(args.ws); F.out = uni(args.out);
    for (int u = F.tid; u < (LDS_BYTES - LDSCTL_OFF) / 4; u += NWAVES * 64) ((LAS unsigned*)(F.lds + LDSCTL_OFF))[u] = 0u;
    __syncthreads();
    XcdBarrier bar; bar.bar = (unsigned*)(F.ws + WS_CTL) + CW_BAR; bar.x = 0; bar.st = nullptr;
    const int lo = args.ph_lo, hi = args.ph_hi;
    if (hi - lo > 1) bar = xcd_barrier_post((unsigned*)(F.ws + WS_CTL) + CW_BAR, (volatile LAS unsigned*)(F.lds + MISC_OFF) + 8);
#ifndef PH_OFF
#define PH_OFF(k) 0
#endif
#define IN(k) (!PH_OFF(k) && lo <= (k) && (k) < hi)
#define SEAM(k) do { if (IN(k) && IN((k) + 1)) xcd_barrier(bar); } while (0)

    if (IN(0)) { for (int rep = 0; rep < REPS(T_PRO); ++rep) p0_prologue(F, A); } SEAM(0);

#define LAYER_PAIR(lp) do {\
        const int pb = 1 + 10 * lp;\
        if (IN(pb + 0)) {\
            pg8::Gemm g{(const pg8::bf16_t*)(F.ws + WS_H), (const pg8::bf16_t*)(F.ws + WS_W_SSD_IN + lp * SZ_W_SSD_IN1), M_PAD, SSD_PROJ_PAD, D};\
            pg8::StaticOrder S; S.init(M_PAD, SSD_PROJ_PAD, D, F.G, (int)blockIdx.x);\
            pg8::EpiSsdIn E{(pg8::bf16_t*)(F.ws + WS_Z), (pg8::bf16_t*)(F.ws + WS_XBC), (float*)(F.ws + WS_DTRAW), (const float*)(F.ws + WS_RSTD)};\
            pg8::gemm_phase<pg8::EpiSsdIn, pg8::StaticOrder, true, true>(F.lds + RING_OFF, g, S, E);\
            if (REPS(T_G1) > 1) { pg8::EpiNone E0; pg8::gemm_phase<pg8::EpiNone, pg8::StaticOrder, true, true>(F.lds + RING_OFF, g, S, E0); }\
            late_convert(F, A, lp == 0 ? LATE0_BEGIN : LATE1_BEGIN, lp == 0 ? LATE0_COUNT : LATE1_COUNT);\
        } SEAM(pb + 0);\
        if (IN(pb + 1)) { for (int rep = 0; rep < REPS(T_CONV); ++rep) ssd_conv_phase(F, A, lp); } SEAM(pb + 1);\
        if (IN(pb + 2)) { for (int rep = 0; rep < REPS(T_SCAN); ++rep) ssd_scan_phase(F, A, lp); } SEAM(pb + 2);\
        if (IN(pb + 3)) { ssd_scale_phase(F); } SEAM(pb + 3);\
        if (IN(pb + 4)) {\
            pg8::Gemm g{(const pg8::bf16_t*)(F.ws + WS_Y), (const pg8::bf16_t*)(F.ws + WS_W_SSD_OUT + lp * SZ_W_SSD_OUT1), M_MAIN, D, DI};\
            pg8::TailSplitOrder S; S.init(M_MAIN, D, DI, F.G, (int)blockIdx.x); S.KS = 16; S.wgm = G2_WGM;\
            pg8::EpiResidN E{pg8::EpiResid{(pg8::bf16_t*)(F.ws + WS_H), (float*)(F.ws + WS_SSQ), (float*)(F.ws + WS_SLAB)}, (const float*)(F.ws + WS_CG)};\
            pg8::gemm_phase<pg8::EpiResidN, pg8::TailSplitOrder, true, true>(F.lds + RING_OFF, g, S, E);\
        } SEAM(pb + 4);\
        if (IN(pb + 5)) { tail_fixup_phase(F); } SEAM(pb + 5);\
        if (IN(pb + 6)) {\
            pg8::Gemm g{(const pg8::bf16_t*)(F.ws + WS_H), (const pg8::bf16_t*)(F.ws + WS_W_SC_IN + lp * SZ_W_SC_IN1), M_MAIN, SC_PROJ, D};\
            pg8::TailSplitOrder S; S.init(M_MAIN, SC_PROJ, D, F.G, (int)blockIdx.x); S.KS = 4;\
            pg8::EpiScIn E{(pg8::bf16_t*)(F.ws + WS_GC), (const float*)(F.ws + WS_RSTD), (float*)(F.ws + WS_SLAB)};\
            if (REPS(T_G3) > 1) { pg8::EpiNone E0; pg8::gemm_phase<pg8::EpiNone, pg8::TailSplitOrder, true, true>(F.lds + RING_OFF, g, S, E0); }\
            pg8::gemm_phase<pg8::EpiScIn, pg8::TailSplitOrder, true, true>(F.lds + RING_OFF, g, S, E);\
        } SEAM(pb + 6);\
        if (IN(pb + 7)) { for (int rep = 0; rep < REPS(T_SCE); ++rep) sc_elem_phase(F, A, lp); } SEAM(pb + 7);\
        if (IN(pb + 8)) {\
            pg8::Gemm g{(const pg8::bf16_t*)(F.ws + WS_Y), (const pg8::bf16_t*)(F.ws + WS_W_SC_OUT + lp * SZ_W_SC_OUT1), M_MAIN, D, D};\
            pg8::TailSplitOrder S; S.init(M_MAIN, D, D, F.G, (int)blockIdx.x); S.KS = 16;\
            pg8::EpiResid E{(pg8::bf16_t*)(F.ws + WS_H), (float*)(F.ws + WS_SSQ), (float*)(F.ws + WS_SLAB)};\
            if (REPS(T_G4) > 1) { pg8::EpiNone E0; pg8::gemm_phase<pg8::EpiNone, pg8::TailSplitOrder, true, true>(F.lds + RING_OFF, g, S, E0); }\
            pg8::gemm_phase<pg8::EpiResid, pg8::TailSplitOrder, true, true>(F.lds + RING_OFF, g, S, E);\
        } SEAM(pb + 8);\
        if (IN(pb + 9)) { tail_fixup_phase(F); } SEAM(pb + 9);\
    } while (0)
    LAYER_PAIR(0);
    LAYER_PAIR(1);
#undef LAYER_PAIR
    if (IN(21)) { for (int rep = 0; rep < REPS(T_FIN); ++rep) final_phase(F, A); }
#undef IN
#undef SEAM
}

extern "C" void kernel_launch(void* const* d_in, const int* in_sizes, int n_in, void* d_out, int out_size, void* d_ws, size_t ws_size, hipStream_t stream) {
    static int grid = 0;
    if (grid == 0) {
        if (n_in != 19 || (size_t)out_size != O_END || ws_size < WS_END) { fprintf(stderr, "kernel_launch: unexpected shapes: n_in %d out %d ws %zu (need %zu)\n", n_in, out_size, ws_size, (size_t)WS_END); grid = -1; return; }
        int dev = 0, cus = 0, per_cu = 0;
        if (hipGetDevice(&dev) != hipSuccess || hipDeviceGetAttribute(&cus, hipDeviceAttributeMultiprocessorCount, dev) != hipSuccess) { grid = -1; return; }
        if (hipFuncSetAttribute((const void*)trunk_fwd, hipFuncAttributeMaxDynamicSharedMemorySize, LDS_BYTES) != hipSuccess) { fprintf(stderr, "kernel_launch: hipFuncSetAttribute failed\n"); grid = -1; return; }
        if (hipOccupancyMaxActiveBlocksPerMultiprocessor(&per_cu, (const void*)trunk_fwd, NWAVES * 64, LDS_BYTES) != hipSuccess || per_cu < 1)
            fprintf(stderr, "kernel_launch: occupancy query reports %d workgroups per CU\n", per_cu);
        (void)hipGetLastError();
        grid = cus;
    }
    if (grid < 0) return;
    if (hipMemsetAsync((char*)d_ws + WS_CTL, 0, CTL_ZERO_BYTES, stream) != hipSuccess) return;
    Args a{};
    for (int i = 0; i < 19; ++i) a.in[i] = (const float*)d_in[i];
    a.out = (float*)d_out; a.ws = (unsigned char*)d_ws;
#if MK_N_LAUNCHES == 1
    a.ph_lo = 0; a.ph_hi = N_PHASES;
    hipLaunchKernelGGL(trunk_fwd, dim3(grid), dim3(NWAVES * 64), LDS_BYTES, stream, a);
#else
    for (int ph = 0; ph < N_PHASES; ++ph) { a.ph_lo = ph; a.ph_hi = ph + 1; hipLaunchKernelGGL(trunk_fwd, dim3(grid), dim3(NWAVES * 64), LDS_BYTES, stream, a); }
#endif
}
```

```cpp
#include <hip/hip_runtime.h>
#include <cstdio>
#include <cstdint>

#ifndef MK_N_LAUNCHES
#define MK_N_LAUNCHES 1
#endif

namespace pg8 {
#define PG8_LAS __attribute__((address_space(3)))
typedef unsigned short bf16_t;
typedef short bf16x8 __attribute__((ext_vector_type(8)));
typedef float f32x4 __attribute__((ext_vector_type(4)));
typedef unsigned u32x4 __attribute__((ext_vector_type(4)));
constexpr int M_MAIN_PANELS = 64;
constexpr int BM = 256, BK = 64, HALF = 128, HTB = HALF * BK * 2  , STAGE_BYTES = 8 * HTB, NXCD = 8, WGM = 8;

__host__ __device__ __forceinline__ int lds_byte(int r, int c) { const int st = (r >> 4) * 2 + (c >> 5), rr = r & 15, cc = c & 31, ob = rr * 64 + cc * 2; return st * 1024 + (ob ^ (((ob >> 9) & 1) << 5)); }
__host__ __device__ __forceinline__ void stage_rc(int b, int& R, int& C) { const int st = b / 1024, sb = b % 1024, swz = sb ^ (((sb >> 9) & 1) << 5); R = (st >> 1) * 16 + swz / 64; C = (st & 1) * 32 + (swz % 64) / 2; }
__host__ __device__ __forceinline__ int perm32(int rho) { const int n = rho >> 4, i = rho & 15; return 8 * (i >> 2) + 4 * n + (i & 3); }

struct Unit { int pm, pn, kt0, nkt; };
struct Gemm { const bf16_t* A; const bf16_t* Bt; int M, N, K; };

struct StaticOrder {
    int nM, nN, nwg, G, c, nktf, wgm;
    __host__ __device__ void init(int M, int N, int K, int G_, int c_) { nM = M / BM; nN = N / BM; nwg = nM * nN; G = G_; c = c_; nktf = K / BK; wgm = WGM; }
    __host__ __device__ __forceinline__ void main_unit(int L, Unit& u) const {
        int wgid = L; { const int q = nwg / NXCD, r = nwg % NXCD, xcd = wgid % NXCD, off = wgid / NXCD; wgid = (xcd < r ? xcd * (q + 1) : r * (q + 1) + (xcd - r) * q) + off; }
        const int nig = wgm * nN, ngrp = (nM / wgm) > 0 ? (nM / wgm) : 1; int gid = wgid / nig; gid = gid < ngrp ? gid : ngrp - 1;
        const int fm = gid * wgm, gsz = (gid == ngrp - 1) ? (nM - fm) : wgm, w = wgid - gid * nig;
        u.pm = fm + (w % gsz); u.pn = w / gsz; u.kt0 = 0; u.nkt = nktf;
    }
    __host__ __device__ __forceinline__ bool next(int i, Unit& u) const {
        const long L = (long)i * G + c; if (L >= nwg) return false;
        main_unit((int)L, u); return true;
    }
    __device__ __forceinline__ void a_ready(const Unit&) const {}
    __device__ __forceinline__ void done(const Unit&) const {}
    __device__ __forceinline__ unsigned fetch(int) const { return 0u; }
    __device__ __forceinline__ void commit(int, unsigned) const {}
    __device__ __forceinline__ bool resolve(int i, Unit& u) const { return next(i, u); }
};
struct TailSplitOrder : StaticOrder {
    int KS;
    __host__ __device__ __forceinline__ bool next(int i, Unit& u) const {
        const long L = (long)i * G + c; const bool is_main = L < nwg; const long mi = L - nwg;
        if (!is_main && mi >= (long)nN * KS) return false;
        Unit a; main_unit(is_main ? (int)L : 0, a);
        const int mn = nktf / KS, mpn = (int)(mi / KS), mks = (int)(mi % KS);
        u.pm = is_main ? a.pm : nM; u.pn = is_main ? a.pn : mpn; u.kt0 = is_main ? 0 : mks * mn; u.nkt = is_main ? nktf : mn;
        return true;
    }
    __device__ __forceinline__ bool resolve(int i, Unit& u) const { return next(i, u); }
};

struct DynOrder : TailSplitOrder {
    unsigned* ctr; PG8_LAS unsigned* slot; bool dyn;
    __device__ __forceinline__ void setup(unsigned* ctr_, PG8_LAS unsigned* slot_) { ctr = ctr_; slot = slot_; dyn = (G % 8 == 0) && G >= 8; }
    __device__ __forceinline__ bool entry(int k, Unit& u) const {
        const int x = c & 7; const int nmain = (nwg - x + 7) / 8; const bool is_main = k < nmain; const long mi = (long)(k - nmain) * 8 + x;
        if (!is_main && (KS == 0 || mi >= (long)nN * KS)) return false;
        Unit a; main_unit(is_main ? k * 8 + x : 0, a);
        const int ks_ = KS ? KS : 1, mn = nktf / ks_, mpn = (int)(mi / ks_), mks = (int)(mi % ks_);
        u.pm = is_main ? a.pm : nM; u.pn = is_main ? a.pn : mpn; u.kt0 = is_main ? 0 : mks * mn; u.nkt = is_main ? nktf : mn;
        return true;
    }
    __device__ __forceinline__ bool next(int i, Unit& u) const { return dyn ? entry(c >> 3, u) : TailSplitOrder::next(i, u); }
    __device__ __forceinline__ unsigned fetch(int) const { unsigned k = 0u; if (dyn && threadIdx.x == 0) k = (unsigned)(G >> 3) + __hip_atomic_fetch_add(ctr + 64 * (c & 7), 1u, __ATOMIC_RELAXED, __HIP_MEMORY_SCOPE_AGENT); return k; }
    __device__ __forceinline__ void commit(int ui, unsigned k) const { if (dyn && threadIdx.x == 0) slot[(ui + 1) & 1] = k; }
    __device__ __forceinline__ bool resolve(int i, Unit& u) const { if (!dyn) return TailSplitOrder::next(i, u); const int k = __builtin_amdgcn_readfirstlane((int)slot[i & 1]); return entry(k, u); }
};

__device__ __forceinline__ unsigned cvt_pk_bf16(float lo, float hi) { unsigned r; asm volatile("v_cvt_pk_bf16_f32 %0, %1, %2" : "=v"(r) : "v"(lo), "v"(hi)); return r; }

struct EpiSsdIn {
    static constexpr bool PERM = true, AFTER_DRAIN = false, KSCALE = false;
    bf16_t* Z; bf16_t* XBC; float* DTRAW; const float* RSTD;
    __device__ __forceinline__ void operator()(const f32x4 (&acc)[2][2][4][2], const Unit& u, int wr, int wc, int fr, int fq) const {
        const int row0 = u.pm * BM + wr * 64 + fr;
        if (u.pn < 32) {
            const int col0 = u.pn * BM + wc * 32 + 8 * fq;
            float rsv[2][4];
#pragma unroll
            for (int ai = 0; ai < 2; ++ai)
#pragma unroll
                for (int m = 0; m < 4; ++m) rsv[ai][m] = RSTD[row0 + ai * HALF + m * 16];
#pragma unroll
            for (int ai = 0; ai < 2; ++ai)
#pragma unroll
                for (int m = 0; m < 4; ++m) { bf16_t* rowp = Z + (size_t)(row0 + ai * HALF + m * 16) * 8192 + col0; const float rs = rsv[ai][m];
#pragma unroll
                    for (int bj = 0; bj < 2; ++bj) { float g[8];
#pragma unroll
                        for (int e = 0; e < 8; ++e) { const float x = acc[ai][bj][m][e >> 2][e & 3] * rs; g[e] = x * __builtin_amdgcn_rcpf(1.f + __builtin_amdgcn_exp2f(-1.44269504f * x)); }
                        u32x4 w; w.x = cvt_pk_bf16(g[0], g[1]); w.y = cvt_pk_bf16(g[2], g[3]); w.z = cvt_pk_bf16(g[4], g[5]); w.w = cvt_pk_bf16(g[6], g[7]);
                        *(u32x4*)(rowp + bj * HALF) = w; } }
        } else if (u.pn < 72) {
            const int col0 = (u.pn - 32) * BM + wc * 32 + 8 * fq;
#pragma unroll
            for (int ai = 0; ai < 2; ++ai)
#pragma unroll
                for (int m = 0; m < 4; ++m) { bf16_t* rowp = XBC + (size_t)(row0 + ai * HALF + m * 16) * 10240 + col0;
#pragma unroll
                    for (int bj = 0; bj < 2; ++bj) { const f32x4 v0 = acc[ai][bj][m][0], v1 = acc[ai][bj][m][1];
                        u32x4 w; w.x = cvt_pk_bf16(v0[0], v0[1]); w.y = cvt_pk_bf16(v0[2], v0[3]); w.z = cvt_pk_bf16(v1[0], v1[1]); w.w = cvt_pk_bf16(v1[2], v1[3]);
                        *(u32x4*)(rowp + bj * HALF) = w; } }
        } else {
            const int col0 = wc * 32 + 8 * fq;
#pragma unroll
            for (int ai = 0; ai < 2; ++ai)
#pragma unroll
                for (int m = 0; m < 4; ++m) { float* rowp = DTRAW + (size_t)(row0 + ai * HALF + m * 16) * 128 + col0;
                    *(f32x4*)(rowp) = acc[ai][0][m][0]; *(f32x4*)(rowp + 4) = acc[ai][0][m][1]; }
        }
    }
};
struct EpiBf16Plain {
    static constexpr bool PERM = true, AFTER_DRAIN = false, KSCALE = false;
    bf16_t* O; int ldc;
    __device__ __forceinline__ void operator()(const f32x4 (&acc)[2][2][4][2], const Unit& u, int wr, int wc, int fr, int fq) const {
        const int row0 = u.pm * BM + wr * 64 + fr, col0 = u.pn * BM + wc * 32 + 8 * fq;
#pragma unroll
        for (int ai = 0; ai < 2; ++ai)
#pragma unroll
            for (int m = 0; m < 4; ++m) { bf16_t* rowp = O + (size_t)(row0 + ai * HALF + m * 16) * ldc + col0;
#pragma unroll
                for (int bj = 0; bj < 2; ++bj) { const f32x4 v0 = acc[ai][bj][m][0], v1 = acc[ai][bj][m][1];
                    u32x4 w; w.x = cvt_pk_bf16(v0[0], v0[1]); w.y = cvt_pk_bf16(v0[2], v0[3]); w.z = cvt_pk_bf16(v1[0], v1[1]); w.w = cvt_pk_bf16(v1[2], v1[3]);
                    *(u32x4*)(rowp + bj * HALF) = w; } }
    }
};
struct EpiScIn {
    static constexpr bool PERM = true, AFTER_DRAIN = false, KSCALE = false;
    bf16_t* GC; const float* RSTD; float* SLAB;
    __device__ __forceinline__ void operator()(const f32x4 (&acc)[2][2][4][2], const Unit& u, int wr, int wc, int fr, int fq) const {
        const int j0 = u.pn * 64 + wc * 16 + fq * 4;
        if (u.pm >= M_MAIN_PANELS) {
            float* sl = SLAB + (size_t)(u.kt0 / u.nkt) * (256 * 16384) + (size_t)(wr * 64 + fr) * 16384 + j0;
#pragma unroll
            for (int ai = 0; ai < 2; ++ai)
#pragma unroll
                for (int m = 0; m < 4; ++m) { float* p = sl + (size_t)(ai * HALF + m * 16) * 16384;
                    *(f32x4*)(p) = acc[ai][0][m][0]; *(f32x4*)(p + 4096) = acc[ai][0][m][1]; *(f32x4*)(p + 8192) = acc[ai][1][m][0]; *(f32x4*)(p + 12288) = acc[ai][1][m][1]; }
            return;
        }
        const int row0 = u.pm * BM + wr * 64 + fr;
        float rsv[2][4];
#pragma unroll
        for (int ai = 0; ai < 2; ++ai)
#pragma unroll
            for (int m = 0; m < 4; ++m) rsv[ai][m] = RSTD[row0 + ai * HALF + m * 16];
#pragma unroll
        for (int ai = 0; ai < 2; ++ai)
#pragma unroll
            for (int m = 0; m < 4; ++m) { const int row = row0 + ai * HALF + m * 16; const float rs = rsv[ai][m], rs2 = rs * rs;
                const f32x4 g = acc[ai][0][m][0], b = acc[ai][0][m][1], c = acc[ai][1][m][0], v = acc[ai][1][m][1]; float gb[4], cv[4];
#pragma unroll
                for (int e = 0; e < 4; ++e) { const float x = g[e] * rs; gb[e] = x * __builtin_amdgcn_rcpf(1.f + __builtin_amdgcn_exp2f(-1.44269504f * x)) * (b[e] * rs); cv[e] = c[e] * v[e] * rs2; }
                u32x4 w; w.x = cvt_pk_bf16(gb[0], gb[1]); w.y = cvt_pk_bf16(gb[2], gb[3]); w.z = cvt_pk_bf16(cv[0], cv[1]); w.w = cvt_pk_bf16(cv[2], cv[3]);
                *(u32x4*)(GC + (size_t)row * 8192 + 2 * j0) = w; }
    }
};
struct EpiNone {
    static constexpr bool PERM = true, AFTER_DRAIN = false, KSCALE = false;
    __device__ __forceinline__ void operator()(const f32x4 (&acc)[2][2][4][2], const Unit&, int, int, int, int) const {
#pragma unroll
        for (int ai = 0; ai < 2; ++ai)
#pragma unroll
            for (int bj = 0; bj < 2; ++bj)
#pragma unroll
                for (int m = 0; m < 4; ++m) { asm volatile("" :: "v"(acc[ai][bj][m][0]), "v"(acc[ai][bj][m][1])); }
    }
};
__device__ __forceinline__ void kscale_prep(const float* CG, const Unit& u, PG8_LAS float* tbl) {
    int tid = threadIdx.x; asm volatile("" : "+v"(tid));
    if (tid < 256) { const float* p = CG + ((size_t)u.pm * BM + tid) * 8; const f32x4 a = *(const f32x4*)p, b = *(const f32x4*)(p + 4);
        f32x4 ra, rb; ra[0] = b[3]; ra[1] = a[0] * __builtin_amdgcn_rcpf(a[1]); ra[2] = a[1] * __builtin_amdgcn_rcpf(a[2]); ra[3] = a[2] * __builtin_amdgcn_rcpf(a[3]);
        rb[0] = a[3] * __builtin_amdgcn_rcpf(b[0]); rb[1] = b[0] * __builtin_amdgcn_rcpf(b[1]); rb[2] = b[1] * __builtin_amdgcn_rcpf(b[2]); rb[3] = b[2] * __builtin_amdgcn_rcpf(b[3]);
        *(PG8_LAS f32x4*)(tbl + tid * 8) = ra; *(PG8_LAS f32x4*)(tbl + tid * 8 + 4) = rb; }
}
__device__ __forceinline__ void kscale_step(f32x4 (&acc)[2][2][4][2], const PG8_LAS float* tbl, int g, int, int) {
    int tz = threadIdx.x; asm volatile("" : "+v"(tz)); const int wr = tz >> 8, fr = tz & 15;
#pragma unroll
    for (int ai = 0; ai < 2; ++ai)
#pragma unroll
        for (int m = 0; m < 4; ++m) { const int r = ai * HALF + wr * 64 + m * 16 + fr; const float ratio = tbl[r * 8 + g];
#pragma unroll
            for (int bj = 0; bj < 2; ++bj)
#pragma unroll
                for (int n = 0; n < 2; ++n) acc[ai][bj][m][n] = acc[ai][bj][m][n] * ratio; }
}
struct EpiResid {
    static constexpr bool PERM = true, AFTER_DRAIN = false, KSCALE = false;
    bf16_t* H; float* SSQ; float* SLAB;
    __device__ __forceinline__ void operator()(const f32x4 (&acc)[2][2][4][2], const Unit& u, int wr, int wc, int fr, int fq) const {
        const int row0 = u.pm * BM + wr * 64 + fr, col0 = u.pn * BM + wc * 32 + 8 * fq;
        if (u.pm >= M_MAIN_PANELS) {
            float* sl = SLAB + (size_t)(u.kt0 / u.nkt) * (256 * 4096) + (size_t)(wr * 64 + fr) * 4096 + col0;
#pragma unroll
            for (int ai = 0; ai < 2; ++ai)
#pragma unroll
                for (int m = 0; m < 4; ++m)
#pragma unroll
                    for (int bj = 0; bj < 2; ++bj) { float* p = sl + (size_t)(ai * HALF + m * 16) * 4096 + bj * HALF; *(f32x4*)p = acc[ai][bj][m][0]; *(f32x4*)(p + 4) = acc[ai][bj][m][1]; }
            return;
        }
        const unsigned off0 = ((unsigned)row0 * 4096u + (unsigned)col0) * 2u;
        const char* hb = (const char*)H;
#pragma unroll
        for (int ai = 0; ai < 2; ++ai) {
            u32x4 old[4][2];
#pragma unroll
            for (int m = 0; m < 4; ++m)
#pragma unroll
                for (int bj = 0; bj < 2; ++bj) old[m][bj] = *(const u32x4*)(hb + (off0 + (unsigned)((ai * HALF + m * 16) * 4096 + bj * HALF) * 2u));
#pragma unroll
            for (int m = 0; m < 4; ++m) { const int row = row0 + ai * HALF + m * 16; float ss = 0.f;
#pragma unroll
                for (int bj = 0; bj < 2; ++bj) { const u32x4 o = old[m][bj];
                    f32x4 v0 = acc[ai][bj][m][0], v1 = acc[ai][bj][m][1];
                    v0[0] += __uint_as_float(o.x << 16); v0[1] += __uint_as_float(o.x & 0xffff0000u); v0[2] += __uint_as_float(o.y << 16); v0[3] += __uint_as_float(o.y & 0xffff0000u);
                    v1[0] += __uint_as_float(o.z << 16); v1[1] += __uint_as_float(o.z & 0xffff0000u); v1[2] += __uint_as_float(o.w << 16); v1[3] += __uint_as_float(o.w & 0xffff0000u);
                    ss += (v0[0] * v0[0] + v0[1] * v0[1]) + (v0[2] * v0[2] + v0[3] * v0[3]) + (v1[0] * v1[0] + v1[1] * v1[1]) + (v1[2] * v1[2] + v1[3] * v1[3]);
                    u32x4 w; w.x = cvt_pk_bf16(v0[0], v0[1]); w.y = cvt_pk_bf16(v0[2], v0[3]); w.z = cvt_pk_bf16(v1[0], v1[1]); w.w = cvt_pk_bf16(v1[2], v1[3]);
                    *(u32x4*)((char*)H + (off0 + (unsigned)((ai * HALF + m * 16) * 4096 + bj * HALF) * 2u)) = w; }
                ss += __shfl_xor(ss, 16); ss += __shfl_xor(ss, 32);
                if (fq == 0) SSQ[(size_t)row * 64 + u.pn * 4 + wc] = ss; }
        }
    }
};

struct EpiResidN {
    static constexpr bool PERM = true, AFTER_DRAIN = false, KSCALE = true;
    EpiResid R; const float* CG;
    __device__ __forceinline__ void prep(const Unit& u, PG8_LAS float* tbl) const { kscale_prep(CG, u, tbl); }
    __device__ __forceinline__ void operator()(f32x4 (&acc)[2][2][4][2], const Unit& u, int, int, int, int, const PG8_LAS float* tbl) const {
        int tz = threadIdx.x; asm volatile("" : "+v"(tz)); const int wid = tz >> 6, lane = tz & 63, wr = wid >> 2, wc = wid & 3, fr = lane & 15, fq = lane >> 4;
        const int g = (u.pm >= M_MAIN_PANELS) ? (u.kt0 >> 4) : 7;
#pragma unroll
        for (int ai = 0; ai < 2; ++ai)
#pragma unroll
            for (int m = 0; m < 4; ++m) { const PG8_LAS float* tr = tbl + (ai * HALF + wr * 64 + m * 16 + fr) * 8; float c = tr[0];
                for (int k = 7; k > g; --k) c *= tr[k];
#pragma unroll
                for (int bj = 0; bj < 2; ++bj)
#pragma unroll
                    for (int n = 0; n < 2; ++n) acc[ai][bj][m][n] = acc[ai][bj][m][n] * c; }
        R(acc, u, wr, wc, fr, fq);
    }
};

template <class Epi, class Sched, bool ALIGN_EPI = false, bool SP2 = false>
__device__ __forceinline__ void gemm_phase(PG8_LAS unsigned char* lds, const Gemm g, const Sched& S, const Epi& E) {
    const int tid = threadIdx.x, wid = __builtin_amdgcn_readfirstlane(tid >> 6), lane = tid & 63, wr = wid >> 2, wc = wid & 3, fr = lane & 15, fq = lane >> 4;
    const int K = g.K;
    unsigned voffA, voffB;
    { int R, C; stage_rc(tid * 16, R, C); const int Rb = Epi::PERM ? ((R & ~31) + perm32(R & 31)) : R; voffA = (unsigned)(R * K + C) * 2u; voffB = (unsigned)(Rb * K + C) * 2u; }
    const size_t rstep = (size_t)64 * K * 2;
    const size_t kstep = (size_t)(BK * 2);
    const size_t hstep = (size_t)HALF * K * 2;
    const size_t tstep = 2 * hstep;
    const unsigned ldsw = (unsigned)wid * 1024u;
    const int aoff = lds_byte(wr * 64 + fr, fq * 8), boff = lds_byte(wc * 32 + fr, fq * 8);
#define PG8_SA(b, h) (((b) * 2 + (h)) * HTB)
#define PG8_SB(b, h) ((4 + (b) * 2 + (h)) * HTB)
#define PG8_STAGE(bufoff, gbase, voff) do { _Pragma("unroll") for (int _i = 0; _i < 2; ++_i) \
        __builtin_amdgcn_global_load_lds((const unsigned*)((const char*)(gbase) + (size_t)_i * rstep + (voff)), (PG8_LAS unsigned*)(lds + (bufoff) + ldsw + _i * 8192), 16, 0, 0); } while (0)
#define PG8_LDA(dst, b, h) do { _Pragma("unroll") for (int m = 0; m < 4; ++m) _Pragma("unroll") for (int k = 0; k < 2; ++k) dst[m][k] = *(const PG8_LAS bf16x8*)(lds + PG8_SA(b, h) + aoff + m * 2048 + k * 1024); } while (0)
#define PG8_LDB(dst, b, h) do { _Pragma("unroll") for (int n = 0; n < 2; ++n) _Pragma("unroll") for (int k = 0; k < 2; ++k) dst[n][k] = *(const PG8_LAS bf16x8*)(lds + PG8_SB(b, h) + boff + n * 2048 + k * 1024); } while (0)
#define PG8_MMA(ai, bj, At, Bt) do { __builtin_amdgcn_s_setprio(1); _Pragma("unroll") for (int m = 0; m < 4; ++m) _Pragma("unroll") for (int n = 0; n < 2; ++n) _Pragma("unroll") for (int k = 0; k < 2; ++k) \
        acc[ai][bj][m][n] = __builtin_amdgcn_mfma_f32_16x16x32_bf16(Bt[n][k], At[m][k], acc[ai][bj][m][n], 0, 0, 0); __builtin_amdgcn_s_setprio(0); } while (0)
#define PG8_WAIT_V(n) asm volatile("s_waitcnt vmcnt(" #n ")" ::: "memory")
#define PG8_WAIT_L(n) asm volatile("s_waitcnt lgkmcnt(" #n ")" ::: "memory")
#define PG8_BAR __builtin_amdgcn_s_barrier()
#define PG8_SCHED __builtin_amdgcn_sched_barrier(0)
    Unit cur, nxt; int ui = 0;
    if (!S.next(0, cur)) return;
    PG8_LAS float* const ktbl = (PG8_LAS float*)(lds + STAGE_BYTES);
    f32x4 acc[2][2][4][2];
#pragma unroll
    for (int a = 0; a < 2; ++a)
#pragma unroll
        for (int b = 0; b < 2; ++b)
#pragma unroll
            for (int m = 0; m < 4; ++m)
#pragma unroll
                for (int n = 0; n < 2; ++n) acc[a][b][m][n] = (f32x4){0.f, 0.f, 0.f, 0.f};
    bf16x8 At[4][2], B0[2][2], B1[2][2];
    const char* cA = (const char*)g.A + (size_t)cur.pm * tstep + (size_t)cur.kt0 * kstep; const char* cB = (const char*)g.Bt + (size_t)cur.pn * tstep + (size_t)cur.kt0 * kstep;
    S.a_ready(cur);
    if constexpr (Epi::KSCALE) E.prep(cur, ktbl);
    if constexpr (SP2) {
        PG8_STAGE(PG8_SB(0, 0), cB, voffB); PG8_STAGE(PG8_SB(0, 1), cB + hstep, voffB); PG8_STAGE(PG8_SA(0, 0), cA, voffA); PG8_STAGE(PG8_SA(0, 1), cA + hstep, voffA);
        if (wr == 1) PG8_BAR;
        PG8_WAIT_V(2); PG8_BAR;
        PG8_STAGE(PG8_SB(1, 0), cB + kstep, voffB); PG8_STAGE(PG8_SA(1, 0), cA + kstep, voffA); PG8_STAGE(PG8_SB(1, 1), cB + hstep + kstep, voffB);
        PG8_WAIT_V(6); PG8_BAR;
    } else {
        PG8_STAGE(PG8_SB(0, 0), cB, voffB); PG8_STAGE(PG8_SA(0, 0), cA, voffA); PG8_STAGE(PG8_SB(0, 1), cB + hstep, voffB); PG8_STAGE(PG8_SA(0, 1), cA + hstep, voffA);
        if (wr == 1) PG8_BAR;
        PG8_WAIT_V(4); PG8_BAR;
        PG8_STAGE(PG8_SB(1, 0), cB + kstep, voffB); PG8_STAGE(PG8_SA(1, 0), cA + kstep, voffA); PG8_STAGE(PG8_SB(1, 1), cB + hstep + kstep, voffB);
        PG8_WAIT_V(6); PG8_BAR;
    }
    for (;;) {
        const unsigned kclaim = S.fetch(ui);
        bool has_next = false; const char* nA = cA; const char* nB = cB;
        const int nt = cur.nkt;
        for (int t = 0; t < nt; t += 2) {
            const bool last = (t == nt - 2);
            if (t == (nt > 4 ? 2 : 0)) S.commit(ui, kclaim);
            if (last) { has_next = S.resolve(ui + 1, nxt);
                if (has_next) { nA = (const char*)g.A + (size_t)nxt.pm * tstep + (size_t)nxt.kt0 * kstep; nB = (const char*)g.Bt + (size_t)nxt.pn * tstep + (size_t)nxt.kt0 * kstep; } }
            const char* a1 = cA + (size_t)(t + 1) * kstep;
            const char* a2 = last ? nA : cA + (size_t)(t + 2) * kstep; const char* b2 = last ? nB : cB + (size_t)(t + 2) * kstep;
            const char* a3 = a2 + kstep; const char* b3 = b2 + kstep;
            if (last && has_next) S.a_ready(nxt);
            if constexpr (Epi::KSCALE) { const int kt = cur.kt0 + t; if (t > 0 && (kt & 15) == 0) kscale_step(acc, ktbl + (ui & 1) * 2048, kt >> 4, wr, fr); }
            if constexpr (SP2) {
            PG8_LDB(B0, 0, 0); PG8_LDB(B1, 0, 1); PG8_SCHED; PG8_LDA(At, 0, 0); PG8_STAGE(PG8_SA(1, 1), a1 + hstep, voffA);
            PG8_WAIT_V(8); PG8_WAIT_L(0); PG8_BAR; PG8_MMA(0, 0, At, B0); PG8_MMA(0, 1, At, B1); PG8_BAR; PG8_SCHED;
            PG8_LDA(At, 0, 1); PG8_STAGE(PG8_SB(0, 0), b2, voffB); PG8_STAGE(PG8_SB(0, 1), b2 + hstep, voffB); PG8_STAGE(PG8_SA(0, 0), a2, voffA);
            PG8_WAIT_V(8); PG8_WAIT_L(0); PG8_BAR; PG8_MMA(1, 0, At, B0); PG8_MMA(1, 1, At, B1); PG8_BAR; PG8_SCHED;
            PG8_LDB(B0, 1, 0); PG8_LDB(B1, 1, 1); PG8_SCHED; PG8_LDA(At, 1, 0); PG8_STAGE(PG8_SA(0, 1), a2 + hstep, voffA);
            PG8_WAIT_V(8); PG8_WAIT_L(0); PG8_BAR; PG8_MMA(0, 0, At, B0); PG8_MMA(0, 1, At, B1); PG8_BAR; PG8_SCHED;
            PG8_LDA(At, 1, 1); PG8_STAGE(PG8_SB(1, 0), b3, voffB); PG8_STAGE(PG8_SB(1, 1), b3 + hstep, voffB); PG8_STAGE(PG8_SA(1, 0), a3, voffA);
            PG8_WAIT_V(8); PG8_WAIT_L(0); PG8_BAR; PG8_MMA(1, 0, At, B0); PG8_MMA(1, 1, At, B1); PG8_BAR; PG8_SCHED;
            } else {
            PG8_LDB(B0, 0, 0); PG8_SCHED; PG8_LDA(At, 0, 0); PG8_STAGE(PG8_SA(1, 1), a1 + hstep, voffA);
            PG8_WAIT_L(8); PG8_BAR; PG8_WAIT_L(0); PG8_MMA(0, 0, At, B0); PG8_BAR; PG8_SCHED;
            PG8_LDB(B1, 0, 1); PG8_STAGE(PG8_SB(0, 0), b2, voffB);
            PG8_BAR; PG8_WAIT_L(0); PG8_MMA(0, 1, At, B1); PG8_BAR;
            PG8_LDA(At, 0, 1); PG8_STAGE(PG8_SA(0, 0), a2, voffA);
            PG8_BAR; PG8_WAIT_L(0); PG8_MMA(1, 0, At, B0); PG8_BAR; PG8_SCHED;
            PG8_STAGE(PG8_SB(0, 1), b2 + hstep, voffB);
            PG8_WAIT_V(6); PG8_BAR; PG8_MMA(1, 1, At, B1); PG8_BAR;
            PG8_LDB(B0, 1, 0); PG8_SCHED; PG8_LDA(At, 1, 0); PG8_STAGE(PG8_SA(0, 1), a2 + hstep, voffA);
            PG8_WAIT_L(8); PG8_BAR; PG8_WAIT_L(0); PG8_MMA(0, 0, At, B0); PG8_BAR; PG8_SCHED;
            PG8_LDB(B1, 1, 1); PG8_STAGE(PG8_SB(1, 0), b3, voffB);
            PG8_BAR; PG8_WAIT_L(0); PG8_MMA(0, 1, At, B1); PG8_BAR;
            PG8_LDA(At, 1, 1); PG8_STAGE(PG8_SA(1, 0), a3, voffA);
            PG8_BAR; PG8_WAIT_L(0); PG8_MMA(1, 0, At, B0); PG8_BAR; PG8_SCHED;
            PG8_STAGE(PG8_SB(1, 1), b3 + hstep, voffB);
            PG8_WAIT_V(6); PG8_BAR; PG8_MMA(1, 1, At, B1); PG8_BAR;
            }
        }
        if constexpr (ALIGN_EPI) { if (wr == 0) PG8_BAR; }
        if constexpr (Epi::KSCALE) { E(acc, cur, wr, wc, fr, fq, ktbl + (ui & 1) * 2048); if (has_next) E.prep(nxt, ktbl + ((ui + 1) & 1) * 2048); }
        else E(acc, cur, wr, wc, fr, fq);
        S.done(cur);
        if (!has_next) break;
#pragma unroll
        for (int a = 0; a < 2; ++a)
#pragma unroll
            for (int b = 0; b < 2; ++b)
#pragma unroll
                for (int m = 0; m < 4; ++m)
#pragma unroll
                    for (int n = 0; n < 2; ++n) acc[a][b][m][n] = (f32x4){0.f, 0.f, 0.f, 0.f};
        cur = nxt; cA = nA; cB = nB; ++ui;
        if constexpr (ALIGN_EPI) { if (wr == 1) PG8_BAR; }
    }
    PG8_WAIT_V(0);
    if constexpr (!ALIGN_EPI) { if (wr == 0) PG8_BAR; }
    PG8_BAR;
#undef PG8_SA
#undef PG8_SB
#undef PG8_STAGE
#undef PG8_LDA
#undef PG8_LDB
#undef PG8_MMA
#undef PG8_WAIT_V
#undef PG8_WAIT_L
#undef PG8_BAR
#undef PG8_SCHED
}
}

constexpr int D = 4096, DI = 8192, NH = 128, HD = 64, NG = 8, DS = 128, CONVD = 10240;
constexpr int SSD_PROJ = 18560, SSD_PROJ_PAD = 18688, SC_PROJ = 16384;
constexpr int NB = 4, SEQ = 4096, NMETA = 16, NSB = 8, LS = 16;
constexpr int ROW_META = 16384, ROW_SAMPLE = 16448, M_REAL = 16576, M_PAD = 16640, M_MAIN = 16384;
#ifndef G2_WGM
#define G2_WGM 2
#endif
constexpr int NSEG = 1036;
constexpr float EPS = 1e-5f;
constexpr int NWAVES = 8;

constexpr size_t MiB = 1u << 20;
constexpr size_t WS_CTL = 0, CTL_ZERO_BYTES = 1 * MiB;
constexpr size_t SZ_W_SSD_IN1 = (size_t)SSD_PROJ_PAD * D * 2, SZ_W_SSD_OUT1 = (size_t)D * DI * 2, SZ_W_SC_IN1 = (size_t)SC_PROJ * D * 2, SZ_W_SC_OUT1 = (size_t)D * D * 2;
constexpr size_t WS_W_SSD_IN = 1 * MiB;
constexpr size_t WS_W_SSD_OUT = WS_W_SSD_IN + 2 * SZ_W_SSD_IN1;
constexpr size_t WS_W_SC_IN = WS_W_SSD_OUT + 2 * SZ_W_SSD_OUT1;
constexpr size_t WS_W_SC_OUT = WS_W_SC_IN + 2 * SZ_W_SC_IN1;
constexpr size_t WS_H = WS_W_SC_OUT + 2 * SZ_W_SC_OUT1;
constexpr size_t WS_SSQ = WS_H + (size_t)M_PAD * D * 2;
constexpr size_t WS_PROJ = WS_SSQ + (size_t)M_PAD * 64 * 4;
constexpr size_t SZ_Z = (size_t)M_PAD * DI * 2, SZ_XBC = (size_t)M_PAD * CONVD * 2, SZ_DT = (size_t)M_PAD * NH * 4;
constexpr size_t WS_Z = WS_PROJ, WS_XBC = WS_Z + SZ_Z, WS_DTRAW = WS_XBC + SZ_XBC;
constexpr size_t WS_GC = WS_PROJ;
constexpr size_t WS_XACT = WS_DTRAW + SZ_DT;
constexpr size_t WS_YN = WS_XACT;
constexpr size_t WS_DT = WS_XACT + SZ_XBC;
constexpr size_t WS_Y = WS_DT + SZ_DT;
constexpr size_t WS_YSQ = WS_Y + SZ_Z;
constexpr size_t WS_RSTD = WS_YSQ + 4 * SZ_DT;
constexpr size_t WS_SLAB = WS_RSTD + (size_t)M_PAD * 4;
constexpr size_t WS_CG = WS_SLAB + (size_t)16 * 256 * 4096 * 4;
constexpr size_t WS_END = WS_CG + (size_t)M_PAD * 8 * 4;
static_assert((size_t)M_PAD * SC_PROJ * 2 <= SZ_Z + SZ_XBC + SZ_DT, "SC projection overlays the SSD projection region");
static_assert(WS_END % 256 == 0 && WS_XACT % 256 == 0 && WS_Y % 256 == 0, "alignment");
constexpr int CW_BAR = 4096;

constexpr size_t O_YP = 0, O_YS = O_YP + (size_t)NB * SEQ * D, O_SSM_P = O_YS + (size_t)NSB * LS * D, O_CONV_P = O_SSM_P + (size_t)2 * NB * NH * HD * DS,
                 O_SC_P = O_CONV_P + (size_t)2 * NB * 3 * CONVD, O_SSM_S = O_SC_P + (size_t)2 * NB * 2 * D, O_CONV_S = O_SSM_S + (size_t)2 * NSB * NH * HD * DS,
                 O_SC_S = O_CONV_S + (size_t)2 * NSB * 3 * CONVD, O_END = O_SC_S + (size_t)2 * NSB * 2 * D;

constexpr int RING_OFF = 0, RING_BYTES = 131072;
constexpr int LDS_BYTES = 163840;
constexpr int SMALL_OFF = 147456;
constexpr int LDSCTL_OFF = LDS_BYTES - 512, MISC_OFF = LDSCTL_OFF + 320;

#define GAS __attribute__((address_space(1)))
#define LAS __attribute__((address_space(3)))
typedef unsigned short bf16;
typedef unsigned v4u __attribute__((ext_vector_type(4)));
typedef unsigned v2u __attribute__((ext_vector_type(2)));
typedef float f32x4 __attribute__((ext_vector_type(4)));
typedef float f32x2 __attribute__((ext_vector_type(2)));
typedef GAS unsigned gu32;
#define RLX_AGENT __ATOMIC_RELAXED, __HIP_MEMORY_SCOPE_AGENT
#define LDS_WAIT() asm volatile("s_waitcnt lgkmcnt(0)" ::: "memory")
#define VM_WAIT() asm volatile("s_waitcnt vmcnt(0)" ::: "memory")
__device__ __forceinline__ unsigned pk2(float lo, float hi) { return pg8::cvt_pk_bf16(lo, hi); }
__device__ __forceinline__ float bflo(unsigned u) { return __uint_as_float(u << 16); }
__device__ __forceinline__ float bfhi(unsigned u) { return __uint_as_float(u & 0xffff0000u); }
__device__ __forceinline__ void unpack8(const v4u w, float (&f)[8]) { f[0] = bflo(w.x); f[1] = bfhi(w.x); f[2] = bflo(w.y); f[3] = bfhi(w.y); f[4] = bflo(w.z); f[5] = bfhi(w.z); f[6] = bflo(w.w); f[7] = bfhi(w.w); }
__device__ __forceinline__ v4u pack8(const float (&f)[8]) { v4u o; o.x = pk2(f[0], f[1]); o.y = pk2(f[2], f[3]); o.z = pk2(f[4], f[5]); o.w = pk2(f[6], f[7]); return o; }
__device__ __forceinline__ float silu_f(float x) { return x * __builtin_amdgcn_rcpf(1.f + __expf(-x)); }
__device__ __forceinline__ float softplus_f(float x) { return fmaxf(x, 0.f) + log1pf(__expf(-fabsf(x))); }

#define XB_TMO      128
#define XB_XCNT(j)  (256  + 64 * (j))
#define XB_XSUB(j)  (1280 + 64 * (j))
#define XB_XGEN(j)  (2304 + 64 * (j))
#define XB_TOP      3328
#define XB_TOPGEN   3392
#define XCD_BAR_WORDS 3456
#define XB_SPIN_CAP (1u << 18)
__device__ __forceinline__ unsigned xb_ld(unsigned* p)              { return __hip_atomic_load(p, __ATOMIC_RELAXED, __HIP_MEMORY_SCOPE_AGENT); }
__device__ __forceinline__ unsigned xb_add(unsigned* p, unsigned v) { return __hip_atomic_fetch_add(p, v, __ATOMIC_RELAXED, __HIP_MEMORY_SCOPE_AGENT); }
__device__ __forceinline__ unsigned xb_xcc_id() { return (unsigned)__builtin_amdgcn_s_getreg((3 << 11) | 20) & 0xFu; }
#define XB_SPIN(cond, bar) do { unsigned _sp = 0; while (cond) { __builtin_amdgcn_s_sleep(1); \
    if ((++_sp & 255u) == 0u) { if (xb_ld(&(bar)[XB_TMO])) break; if (_sp > XB_SPIN_CAP) { atomicAdd(&(bar)[XB_TMO], 1u); break; } } } } while (0)
struct XcdBarrier { unsigned* bar; unsigned x; volatile LAS unsigned* st; };
__device__ __forceinline__ XcdBarrier xcd_barrier_post(unsigned* bar, volatile LAS unsigned* st) {
    XcdBarrier b; b.bar = bar; b.x = xb_xcc_id(); b.st = st;
    if (threadIdx.x == 0) (void)xb_add(&bar[XB_XCNT(b.x)], 1u);
    return b;
}
__device__ __forceinline__ void xcd_barrier_complete(unsigned* bar, unsigned x, unsigned& nloc, unsigned& nx) {
    const unsigned G = gridDim.x * gridDim.y * gridDim.z;
    unsigned sum, cnt, mine, sp = 0u;
    for (;;) {
        sum = 0u; cnt = 0u; mine = 0u;
#pragma unroll
        for (unsigned j = 0; j < 16; ++j) { const unsigned c = xb_ld(&bar[XB_XCNT(j)]); sum += c; cnt += (c > 0u) ? 1u : 0u; mine = (j == x) ? c : mine; }
        if (sum == G) break;
        __builtin_amdgcn_s_sleep(1);
        if ((++sp & 255u) == 0u) { if (xb_ld(&bar[XB_TMO])) break; if (sp > XB_SPIN_CAP) { atomicAdd(&bar[XB_TMO], 1u); break; } }
    }
    nloc = mine > 0u ? mine : 1u; nx = cnt > 0u ? cnt : 1u;
}
__device__ __forceinline__ void xcd_barrier(const XcdBarrier& b) {
    asm volatile("s_waitcnt vmcnt(0)" ::: "memory");
    __syncthreads();
    if (threadIdx.x == 0) {
        unsigned* bar = b.bar;
        __builtin_amdgcn_s_waitcnt(0);
        unsigned nloc = b.st[0], nx = b.st[1];
        if (nloc == 0u) { xcd_barrier_complete(bar, b.x, nloc, nx); b.st[0] = nloc; b.st[1] = nx; }
        const unsigned old = xb_add(&bar[XB_XSUB(b.x)], 1u);
        const unsigned gen = old / nloc;
        if (old + 1u == (gen + 1u) * nloc) {
            __builtin_amdgcn_fence(__ATOMIC_RELEASE, "agent");
            asm volatile("s_waitcnt vmcnt(0)" ::: "memory");
            const unsigned og = xb_add(&bar[XB_TOP], 1u);
            const unsigned tg = og / nx;
            if (og + 1u == (tg + 1u) * nx) xb_add(&bar[XB_TOPGEN], 1u);
            else XB_SPIN(xb_ld(&bar[XB_TOPGEN]) == tg, bar);
            __builtin_amdgcn_fence(__ATOMIC_ACQUIRE, "agent");
            xb_add(&bar[XB_XGEN(b.x)], 1u);
            asm volatile("s_waitcnt vmcnt(0)" ::: "memory");
        } else {
            XB_SPIN(xb_ld(&bar[XB_XGEN(b.x)]) == gen, bar);
            __builtin_amdgcn_fence(__ATOMIC_ACQUIRE, "agent");
            asm volatile("s_waitcnt vmcnt(0)" ::: "memory");
        }
    }
    __syncthreads();
}

struct Args { const float* in[19]; float* out; unsigned char* ws; int ph_lo, ph_hi; };
struct Frame {
    LAS unsigned char* lds;
    int tid, lane, wave, vcu, G;
    GAS unsigned char* ws; GAS float* out;
};
template <class T> __device__ __forceinline__ GAS T* uni(T* p) { const unsigned long long v = (unsigned long long)p; const unsigned lo = __builtin_amdgcn_readfirstlane((unsigned)v), hi = __builtin_amdgcn_readfirstlane((unsigned)(v >> 32)); return (GAS T*)(((unsigned long long)hi << 32) | lo); }
__device__ __forceinline__ float wave_sum(float v) {
#pragma unroll
    for (int o = 1; o < 64; o <<= 1) v += __shfl_xor(v, o);
    return v;
}

__host__ __device__ __forceinline__ int sc_in_row(int wcol) { const int type = wcol >> 12, j = wcol & 4095, pn = j >> 6, jj = j & 63; return 256 * pn + 128 * (type >> 1) + 32 * (jj >> 4) + 8 * ((jj >> 2) & 3) + 4 * (type & 1) + (jj & 3); }
template <int SCPERM>
__device__ __forceinline__ void p0_transpose_item(const float* W, int K, int N, const float* ksc, bf16* WT, LAS float* scr, int item, int lane) {
    const int nblk = N / 32, kb = item / nblk, nb = item % nblk, k0 = 64 * kb, n0 = 32 * nb;
#pragma unroll 8
    for (int i = 0; i < 32; ++i) { const int kk = 2 * i + (lane >> 5); scr[kk * 33 + (lane & 31)] = __builtin_nontemporal_load(W + (size_t)(k0 + kk) * N + n0 + (lane & 31)) * ksc[k0 + kk]; }
    LDS_WAIT(); asm volatile("" ::: "memory");
    const int c = lane & 7;
#pragma unroll
    for (int j = 0; j < 4; ++j) { const int n = (lane >> 3) + 8 * j; const LAS float* s = scr + (8 * c) * 33 + n;
        v4u o; o.x = pk2(s[0 * 33], s[1 * 33]); o.y = pk2(s[2 * 33], s[3 * 33]); o.z = pk2(s[4 * 33], s[5 * 33]); o.w = pk2(s[6 * 33], s[7 * 33]);
        const int drow = SCPERM ? sc_in_row(n0 + n) : (n0 + n);
        __builtin_nontemporal_store(o, (v4u*)(WT + (size_t)drow * K + k0 + 8 * c)); }
    LDS_WAIT(); asm volatile("" ::: "memory");
}
constexpr int I_A = (D / 64) * (SSD_PROJ / 32), I_B = (DI / 64) * (D / 32), I_C = (D / 64) * (SC_PROJ / 32), I_D = (D / 64) * (D / 32), I_L = I_A + I_B + I_C + I_D;
constexpr int LATE0_BEGIN = I_L, LATE0_COUNT = 26000;
constexpr int LATE1_BEGIN = I_L + I_A, LATE1_COUNT = 26000;
static_assert(LATE0_COUNT <= I_A && LATE1_COUNT <= I_B + I_C, "late ranges");
__device__ __forceinline__ void p0_item(Frame& F, const Args& A, LAS float* scr, int it) {
    const int j = it / I_L; int r = it % I_L;
    if (r < I_A) { p0_transpose_item<0>(A.in[7] + (size_t)j * D * SSD_PROJ, D, SSD_PROJ, A.in[6] + (size_t)(2 * j) * D, (bf16*)(F.ws + WS_W_SSD_IN + j * SZ_W_SSD_IN1), scr, r, F.lane); return; } r -= I_A;
    if (r < I_B) { p0_transpose_item<0>(A.in[14] + (size_t)j * DI * D, DI, D, A.in[13] + (size_t)j * DI, (bf16*)(F.ws + WS_W_SSD_OUT + j * SZ_W_SSD_OUT1), scr, r, F.lane); return; } r -= I_B;
    if (r < I_C) { p0_transpose_item<1>(A.in[15] + (size_t)j * D * SC_PROJ, D, SC_PROJ, A.in[6] + (size_t)(2 * j + 1) * D, (bf16*)(F.ws + WS_W_SC_IN + j * SZ_W_SC_IN1), scr, r, F.lane); return; } r -= I_C;
    { const float* W = A.in[17] + (size_t)j * D * D; bf16* WT = (bf16*)(F.ws + WS_W_SC_OUT + j * SZ_W_SC_OUT1);
      const int nblk = D / 32, kb = r / nblk, nb = r % nblk, k0 = 64 * kb, n0 = 32 * nb; const int lane = F.lane;
#pragma unroll 8
      for (int i = 0; i < 32; ++i) { const int kk = 2 * i + (lane >> 5); scr[kk * 33 + (lane & 31)] = __builtin_nontemporal_load(W + (size_t)(k0 + kk) * D + n0 + (lane & 31)); }
      LDS_WAIT(); asm volatile("" ::: "memory");
      const int c = lane & 7;
#pragma unroll
      for (int jj = 0; jj < 4; ++jj) { const int n = (lane >> 3) + 8 * jj; const LAS float* s = scr + (8 * c) * 33 + n;
          v4u o; o.x = pk2(s[0 * 33], s[1 * 33]); o.y = pk2(s[2 * 33], s[3 * 33]); o.z = pk2(s[4 * 33], s[5 * 33]); o.w = pk2(s[6 * 33], s[7 * 33]);
          __builtin_nontemporal_store(o, (v4u*)(WT + (size_t)(n0 + n) * D + k0 + 8 * c)); }
      LDS_WAIT(); asm volatile("" ::: "memory"); }
}
__device__ __forceinline__ void late_convert(Frame& F, const Args& A, int begin, int count) {
    constexpr int NWG1 = (M_PAD / 256) * (SSD_PROJ_PAD / 256);
    const int rem = NWG1 % F.G, c = (int)blockIdx.x;
    LAS float* scr = (LAS float*)(F.lds + RING_OFF + F.wave * 16384);
    if (rem == 0) { const int gw = F.vcu * NWAVES + F.wave; for (int it = gw; it < count; it += F.G * NWAVES) p0_item(F, A, scr, begin + it); return; }
    if (c < rem) return;
    const int rank = (c - rem) * NWAVES + F.wave, nw = (F.G - rem) * NWAVES;
    for (int it = rank; it < count; it += nw) p0_item(F, A, scr, begin + it);
}
__device__ __forceinline__ void p0_prologue(Frame& F, const Args& A) {
    LAS float* scr = (LAS float*)(F.lds + RING_OFF + F.wave * 16384);
    const int gw = F.vcu * NWAVES + F.wave, NGW = F.G * NWAVES;
    constexpr int N_EARLY = 2 * I_L - LATE0_COUNT - LATE1_COUNT;
    for (int e = gw; e < N_EARLY; e += NGW) {
        int it = e; if (it >= LATE0_BEGIN) it += LATE0_COUNT; if (it >= LATE1_BEGIN) it += LATE1_COUNT;
        p0_item(F, A, scr, it);
    }
    { const size_t gt = (size_t)F.vcu * 512 + F.tid, GT = (size_t)F.G * 512;
      for (size_t i = gt; i < (size_t)2 * 128 * D / 8; i += GT) { const size_t j = i / (128 * D / 8), o = i % (128 * D / 8);
          *(v4u*)(F.ws + WS_W_SSD_IN + j * SZ_W_SSD_IN1 + (size_t)SSD_PROJ * D * 2 + o * 16) = (v4u){0u, 0u, 0u, 0u}; } }
    bf16* H = (bf16*)(F.ws + WS_H); float* SSQ = (float*)(F.ws + WS_SSQ);
    for (int m = gw; m < M_PAD; m += NGW) {
        const float* src = nullptr;
        if (m < ROW_META) src = A.in[0] + (size_t)m * D;
        else if (m < ROW_SAMPLE) src = A.in[5] + (size_t)((m - ROW_META) & 15) * D;
        else if (m < M_REAL) src = A.in[1] + (size_t)(m - ROW_SAMPLE) * D;
        float s = 0.f;
        f32x4 xa[8], xb[8];
#pragma unroll
        for (int jj = 0; jj < 8; ++jj) {
            if (src) { xa[jj] = __builtin_nontemporal_load((const f32x4*)(src + 8 * (64 * jj + F.lane))); xb[jj] = __builtin_nontemporal_load((const f32x4*)(src + 8 * (64 * jj + F.lane) + 4)); }
            else { xa[jj] = (f32x4){0.f, 0.f, 0.f, 0.f}; xb[jj] = xa[jj]; } }
#pragma unroll
        for (int jj = 0; jj < 8; ++jj) {
            const float f[8] = {xa[jj][0], xa[jj][1], xa[jj][2], xa[jj][3], xb[jj][0], xb[jj][1], xb[jj][2], xb[jj][3]};
#pragma unroll
            for (int e = 0; e < 8; ++e) s += f[e] * f[e];
            *(v4u*)(H + (size_t)m * D + 8 * (64 * jj + F.lane)) = pack8(f);
        }
        s = wave_sum(s);
        SSQ[(size_t)m * 64 + F.lane] = (F.lane == 0) ? s : 0.f;
        if (F.lane == 0) ((float*)(F.ws + WS_RSTD))[m] = rsqrtf(s * (1.f / D) + EPS);
    }
}

struct Seg { int row0, b, k, is_sample, is_last; };
__device__ __forceinline__ Seg seg_decode(int seg) {
    Seg s;
    if (seg < NB * 257) { s.b = seg / 257; s.k = seg % 257; s.is_sample = 0; s.is_last = (s.k == 256);
        s.row0 = (s.k == 0) ? ROW_META + 16 * s.b : s.b * SEQ + 16 * (s.k - 1); }
    else { s.b = seg - NB * 257; s.k = -1; s.is_sample = 1; s.is_last = 1; s.row0 = ROW_SAMPLE + 16 * s.b; }
    return s;
}
__device__ __forceinline__ int seg_halo(const Seg& s, int d) {
    if (s.is_sample || s.k == 0) return -1;
    if (s.k == 1) return ROW_META + 16 * s.b + 16 - d;
    return s.row0 - d;
}
__device__ __forceinline__ float row_rstd8(const float* SSQ, int row, int sub) {
    float s = 0.f;
    if (row >= 0) { const f32x4 a = *(const f32x4*)(SSQ + (size_t)row * 64 + sub * 8), b = *(const f32x4*)(SSQ + (size_t)row * 64 + sub * 8 + 4);
        s = (a[0] + a[1]) + (a[2] + a[3]) + (b[0] + b[1]) + (b[2] + b[3]); }
    s += __shfl_xor(s, 1); s += __shfl_xor(s, 2); s += __shfl_xor(s, 4);
    return row >= 0 ? rsqrtf(s * (1.f / D) + EPS) : 0.f;
}

__device__ __forceinline__ void ssd_conv_phase(Frame& F, const Args& A, int j) {
    const GAS unsigned char* XBCb = F.ws + WS_XBC; GAS unsigned char* XACTb = F.ws + WS_XACT;
    const float* DTRAW = (const float*)(F.ws + WS_DTRAW); float* DT = (float*)(F.ws + WS_DT); const float* RSTD = (const float*)(F.ws + WS_RSTD);
    const float* cw = A.in[8] + (size_t)j * 4 * CONVD; const float* cb = A.in[9] + (size_t)j * CONVD; const float* dtb = A.in[10] + (size_t)j * NH;
    const float* st_in = A.in[3] + (size_t)j * NSB * 3 * CONVD;
    const int NHW = 2 * F.G, hw = 2 * F.vcu + (F.wave >> 2), tl = F.tid & 255;
    const int hpart = hw % 5, rank = hw / 5, nranks = (NHW - hpart + 4) / 5;
    const int c0 = hpart * 2048 + tl * 8; const unsigned voff = (unsigned)c0 * 2u;
#define XBC_ROW(r) (__builtin_nontemporal_load((const GAS v4u*)(XBCb + (size_t)(r) * (CONVD * 2) + voff)))
    float w[4][8], bias[8];
#pragma unroll
    for (int k = 0; k < 4; ++k) { const f32x4 a = *(const f32x4*)(cw + (size_t)k * CONVD + c0), b = *(const f32x4*)(cw + (size_t)k * CONVD + c0 + 4);
        w[k][0] = a[0]; w[k][1] = a[1]; w[k][2] = a[2]; w[k][3] = a[3]; w[k][4] = b[0]; w[k][5] = b[1]; w[k][6] = b[2]; w[k][7] = b[3]; }
    { const f32x4 a = *(const f32x4*)(cb + c0), b = *(const f32x4*)(cb + c0 + 4); bias[0] = a[0]; bias[1] = a[1]; bias[2] = a[2]; bias[3] = a[3]; bias[4] = b[0]; bias[5] = b[1]; bias[6] = b[2]; bias[7] = b[3]; }
    for (int seg = rank; seg < NSEG; seg += nranks) {
        const Seg s = seg_decode(seg);
        float r3[8], r2[8], r1[8];
#pragma unroll
        for (int d = 3; d >= 1; --d) {
            float (&dst)[8] = (d == 3) ? r3 : (d == 2) ? r2 : r1;
            if (s.is_sample) { const float* p = st_in + ((size_t)s.b * 3 + (3 - d)) * CONVD + c0; const f32x4 a = *(const f32x4*)p, b = *(const f32x4*)(p + 4);
                dst[0] = a[0]; dst[1] = a[1]; dst[2] = a[2]; dst[3] = a[3]; dst[4] = b[0]; dst[5] = b[1]; dst[6] = b[2]; dst[7] = b[3]; }
            else { const int hr = seg_halo(s, d);
                if (hr >= 0) { unpack8(XBC_ROW(hr), dst); const float rs = RSTD[hr];
#pragma unroll
                    for (int e = 0; e < 8; ++e) dst[e] *= rs; }
                else {
#pragma unroll
                    for (int e = 0; e < 8; ++e) dst[e] = 0.f; } }
        }
        v4u rawv[16]; float rsv[16];
#pragma unroll
        for (int i = 0; i < 16; ++i) { rawv[i] = XBC_ROW(s.row0 + i); rsv[i] = RSTD[s.row0 + i]; }
#pragma unroll
        for (int i = 0; i < 16; ++i) {
            float cur[8], o[8]; unpack8(rawv[i], cur); const float rs = rsv[i];
#pragma unroll
            for (int e = 0; e < 8; ++e) { cur[e] *= rs; const float v = __builtin_fmaf(w[3][e], cur[e], __builtin_fmaf(w[2][e], r1[e], __builtin_fmaf(w[1][e], r2[e], __builtin_fmaf(w[0][e], r3[e], bias[e])))); o[e] = silu_f(v);
                r3[e] = r2[e]; r2[e] = r1[e]; r1[e] = cur[e]; }
            *(GAS v4u*)(XACTb + (size_t)(s.row0 + i) * (CONVD * 2) + voff) = pack8(o);
        }
        if (s.is_last) {
            GAS float* ob = F.out + (s.is_sample ? O_CONV_S + ((size_t)j * NSB + s.b) * 3 * CONVD : O_CONV_P + ((size_t)j * NB + s.b) * 3 * CONVD) + c0;
            *(GAS f32x4*)(ob) = (f32x4){r3[0], r3[1], r3[2], r3[3]}; *(GAS f32x4*)(ob + 4) = (f32x4){r3[4], r3[5], r3[6], r3[7]};
            *(GAS f32x4*)(ob + CONVD) = (f32x4){r2[0], r2[1], r2[2], r2[3]}; *(GAS f32x4*)(ob + CONVD + 4) = (f32x4){r2[4], r2[5], r2[6], r2[7]};
            *(GAS f32x4*)(ob + 2 * CONVD) = (f32x4){r1[0], r1[1], r1[2], r1[3]}; *(GAS f32x4*)(ob + 2 * CONVD + 4) = (f32x4){r1[4], r1[5], r1[6], r1[7]};
        }
    }
#undef XBC_ROW
    for (size_t i = (size_t)F.vcu * 512 + F.tid; i < (size_t)M_REAL * (NH / 8); i += (size_t)F.G * 512) { const size_t row = i >> 4; const int h0 = (int)(i & 15) * 8; const float rs = RSTD[row];
        const f32x4 a = *(const f32x4*)(DTRAW + row * NH + h0), b = *(const f32x4*)(DTRAW + row * NH + h0 + 4);
        const f32x4 ba = *(const f32x4*)(dtb + h0), bb = *(const f32x4*)(dtb + h0 + 4);
        f32x4 oa, ob;
#pragma unroll
        for (int e = 0; e < 4; ++e) { oa[e] = softplus_f(a[e] * rs + ba[e]); ob[e] = softplus_f(b[e] * rs + bb[e]); }
        *(f32x4*)(DT + row * NH + h0) = oa; *(f32x4*)(DT + row * NH + h0 + 4) = ob; }
}

typedef short s16x4 __attribute__((ext_vector_type(4)));
typedef short bf16x8 __attribute__((ext_vector_type(8)));
#define MFMA16(a, b, c) __builtin_amdgcn_mfma_f32_16x16x32_bf16((a), (b), (c), 0, 0, 0)
__device__ __forceinline__ bf16x8 frag_row(const LAS unsigned char* base, int stride, int row, int kbyte) { return *(const LAS bf16x8*)(base + row * stride + kbyte); }
__device__ __forceinline__ bf16x8 frag_tr(const LAS unsigned char* base, int stride, int k0, int c0, int lane) {
    const int g = lane >> 4, i16 = lane & 15, qq = i16 >> 2, pp = i16 & 3;
    const LAS unsigned char* p = base + (k0 + 8 * g + qq) * stride + (c0 + 4 * pp) * 2;
    const s16x4 lo = __builtin_amdgcn_ds_read_tr16_b64_v4i16((LAS s16x4*)p);
    const s16x4 hi = __builtin_amdgcn_ds_read_tr16_b64_v4i16((LAS s16x4*)(p + 4 * stride));
    return __builtin_shufflevector(lo, hi, 0, 1, 2, 3, 4, 5, 6, 7);
}
__device__ __forceinline__ void ssd_scan_phase(Frame& F, const Args& A, int j) {
    constexpr int S128 = 272, S64 = 144;
    constexpr int OFF_B = 0, OFF_C = 17408, OFF_XD = 34816, OFF_XE = 53248, OFF_L = 71680, OFF_H = 90112, OFF_XD2 = 124928;
    constexpr int SM_ACS = 0, SM_EA = 128, SM_DTD = 256, SM_DTE = 384, SM_ETOT = 512, SM_V = 520, SM_U = 648, SM_STRIDE = 1040;
#define LDS_BARRIER() do { asm volatile("s_waitcnt lgkmcnt(0)" ::: "memory"); __builtin_amdgcn_s_barrier(); asm volatile("" ::: "memory"); } while (0)
    LAS unsigned char* const L = F.lds;
    LAS float* const SM = (LAS float*)(F.lds + SMALL_OFF);
    const bf16* XACT = (const bf16*)(F.ws + WS_XACT); const float* DT = (const float*)(F.ws + WS_DT); bf16* Y = (bf16*)(F.ws + WS_Y);
    const bf16* Z = (const bf16*)(F.ws + WS_Z); float* YSQ = (float*)(F.ws + WS_YSQ);
    LAS float* const PS = SM + 2 * SM_STRIDE;
    const float* a_log = A.in[11] + (size_t)j * NH; const float* d_skip = A.in[12] + (size_t)j * NH;
    const int tid = F.tid, lane = F.lane, w = F.wave, hh = w >> 2, pt = w & 3, q = lane >> 4, l16 = lane & 15;
    for (int item = F.vcu; item < (NB + NSB) * 64; item += F.G) {
        const int is_sample = item >= NB * 64, idx = is_sample ? item - NB * 64 : item, b = idx >> 6, hp = idx & 63, nblocks = is_sample ? 1 : 65;
        const int head = 2 * hp + hh, g = hp >> 3;
        const float Dh = d_skip[head];
        const int sm_h = (w == 4) ? 1 : (w == 6) ? 0 : -1;
        const int head_s = 2 * hp + (sm_h > 0 ? 1 : 0); const float A_own = -__expf(a_log[head_s]);
        f32x4 hacc[8];
        if (is_sample) { const float* sp = A.in[2] + ((((size_t)j * NSB + b) * NH + head) * HD + 16 * pt + l16) * DS + 4 * q;
#pragma unroll
            for (int n8 = 0; n8 < 8; ++n8) hacc[n8] = *(const f32x4*)(sp + 16 * n8); }
        else {
#pragma unroll
            for (int n8 = 0; n8 < 8; ++n8) hacc[n8] = (f32x4){0.f, 0.f, 0.f, 0.f}; }
        v4u pbc[4], px[2];
        int row0 = is_sample ? ROW_SAMPLE + 16 * b : ROW_META + 16 * b, nt = 16;
#define SCAN_PREFETCH(r0_, nt_) do { \
            _Pragma("unroll") for (int k_ = 0; k_ < 4; ++k_) { const int i_ = tid + 512 * k_, mat_ = i_ >> 10, r_ = (i_ >> 4) & 63, c8_ = i_ & 15; \
                pbc[k_] = (r_ < (nt_)) ? *(const v4u*)(XACT + (size_t)((r0_) + r_) * CONVD + DI + mat_ * (NG * DS) + g * DS + c8_ * 8) : (v4u){0u, 0u, 0u, 0u}; } \
            _Pragma("unroll") for (int k_ = 0; k_ < 2; ++k_) { const int i_ = tid + 512 * k_, h2_ = i_ >> 9, r_ = (i_ >> 3) & 63, c8_ = i_ & 7; \
                px[k_] = (r_ < (nt_)) ? *(const v4u*)(XACT + (size_t)((r0_) + r_) * CONVD + (2 * hp + h2_) * HD + c8_ * 8) : (v4u){0u, 0u, 0u, 0u}; } } while (0)
#define SCAN_DTLOAD(r0_, nt_) ((sm_h >= 0 && lane < (nt_)) ? DT[(size_t)((r0_) + lane) * NH + head_s] : 0.f)
#define SCAN_SMALL(dtv_, par_) do { if (sm_h >= 0) { const int hh = sm_h; LAS float* sm_ = SM + (par_) * SM_STRIDE; \
            const float dt_ = (dtv_); float acs_ = dt_ * (A_own * 1.44269504f); \
            _Pragma("unroll") for (int o_ = 1; o_ < 64; o_ <<= 1) { const float v_ = __shfl_up(acs_, o_); if (lane >= o_) acs_ += v_; } \
            const float r0_ = __shfl(acs_, 15), r1_ = __shfl(acs_, 31), r2_ = __shfl(acs_, 47), atot_ = __shfl(acs_, 63); \
            const float myr_ = lane < 16 ? r0_ : lane < 32 ? r1_ : lane < 48 ? r2_ : atot_;              \
            sm_[SM_ACS + hh * 64 + lane] = acs_; sm_[SM_EA + hh * 64 + lane] = __builtin_amdgcn_exp2f(acs_); sm_[SM_DTD + hh * 64 + lane] = dt_; sm_[SM_DTE + hh * 64 + lane] = dt_ * __builtin_amdgcn_exp2f(atot_ - acs_); \
            sm_[SM_V + hh * 64 + lane] = dt_ * __builtin_amdgcn_exp2f(myr_ - acs_); \
            sm_[SM_U + hh * 192 + lane] = __builtin_amdgcn_exp2f(fminf(acs_ - r0_, 0.f)); sm_[SM_U + hh * 192 + 64 + lane] = __builtin_amdgcn_exp2f(fminf(acs_ - r1_, 0.f)); sm_[SM_U + hh * 192 + 128 + lane] = __builtin_amdgcn_exp2f(fminf(acs_ - r2_, 0.f)); \
            if (lane == 0) sm_[SM_ETOT + hh] = __builtin_amdgcn_exp2f(atot_); } } while (0)
#define SCAN_STAGE(par_) do { const LAS float* sm_ = SM + (par_) * SM_STRIDE; \
            _Pragma("unroll") for (int k_ = 0; k_ < 4; ++k_) { const int i_ = tid + 512 * k_, mat_ = i_ >> 10, r_ = (i_ >> 4) & 63, c8_ = i_ & 15; \
                *(LAS v4u*)(L + (mat_ ? OFF_C : OFF_B) + r_ * S128 + c8_ * 16) = pbc[k_]; } \
            _Pragma("unroll") for (int k_ = 0; k_ < 2; ++k_) { const int i_ = tid + 512 * k_, h2_ = i_ >> 9, r_ = (i_ >> 3) & 63, c8_ = i_ & 7; \
                float f_[8], e_[8]; unpack8(px[k_], f_); const float se_ = sm_[SM_DTE + h2_ * 64 + r_]; \
                _Pragma("unroll") for (int e2_ = 0; e2_ < 8; ++e2_) { e_[e2_] = f_[e2_] * se_; } \
                *(LAS v4u*)(L + ((par_) ? OFF_XD2 : OFF_XD) + h2_ * 64 * S64 + r_ * S64 + c8_ * 16) = px[k_]; *(LAS v4u*)(L + OFF_XE + h2_ * 64 * S64 + r_ * S64 + c8_ * 16) = pack8(e_); } } while (0)
#define SCAN_WRITE_HS() do { _Pragma("unroll") for (int n8 = 0; n8 < 8; ++n8) { v2u hw_; hw_.x = pk2(hacc[n8][0], hacc[n8][1]); hw_.y = pk2(hacc[n8][2], hacc[n8][3]); \
            *(LAS v2u*)(L + OFF_H + hh * 64 * S128 + (16 * pt + l16) * S128 + (16 * n8 + 4 * q) * 2) = hw_; } } while (0)
        LDS_BARRIER();
        { const float dt0 = SCAN_DTLOAD(row0, nt); SCAN_PREFETCH(row0, nt); SCAN_SMALL(dt0, 0); }
        float dtA = (nblocks > 1) ? SCAN_DTLOAD(b * SEQ, 64) : 0.f;
        LDS_BARRIER();
        SCAN_STAGE(0);
        SCAN_WRITE_HS();
        int row0p = row0, ntp = nt;
        for (int blk = 0; blk < nblocks; ++blk) {
            const int par = blk & 1; const LAS float* sm = SM + par * SM_STRIDE;
            const bool has_next = blk + 1 < nblocks; const int row0n = b * SEQ + 64 * blk, ntn = 64;
            LDS_BARRIER();
            if (has_next) { SCAN_PREFETCH(row0n, ntn); }
            const float dtB = (blk + 2 < nblocks) ? SCAN_DTLOAD(b * SEQ + 64 * (blk + 1), 64) : 0.f;
            if (blk > 0 && sm_h >= 0) { const float sq = (PS[(sm_h * 4 + 0) * 64 + lane] + PS[(sm_h * 4 + 1) * 64 + lane]) + (PS[(sm_h * 4 + 2) * 64 + lane] + PS[(sm_h * 4 + 3) * 64 + lane]);
                if (lane < ntp) YSQ[(size_t)(row0p + lane) * NH + head_s] = sq; }
            v2u ez[4];
#pragma unroll
            for (int jt = 0; jt < 4; ++jt) { const int t = 16 * jt + l16; const size_t row = (size_t)(row0 + (t < nt ? t : 0));
                ez[jt] = *(const v2u*)(Z + row * DI + head * HD + 16 * pt + 4 * q); }
            { const int it_ = w >> 1, jt0 = 2 * (w & 1);
              if (it_ <= jt0 + 1) {
                  f32x4 g0 = (f32x4){0.f, 0.f, 0.f, 0.f}, g1 = g0;
                  bf16x8 ga[4], gb1[4], gb0[4];
#pragma unroll
                  for (int ks = 0; ks < 4; ++ks) { const int kb = (32 * ks + 8 * q) * 2;
                      ga[ks] = frag_row(L + OFF_B, S128, 16 * it_ + l16, kb); gb1[ks] = frag_row(L + OFF_C, S128, 16 * (jt0 + 1) + l16, kb);
                      gb0[ks] = (it_ <= jt0) ? frag_row(L + OFF_C, S128, 16 * jt0 + l16, kb) : ga[ks]; }
                  __builtin_amdgcn_sched_barrier(0);
#pragma unroll
                  for (int ks = 0; ks < 4; ++ks) { g1 = MFMA16(ga[ks], gb1[ks], g1); if (it_ <= jt0) g0 = MFMA16(ga[ks], gb0[ks], g0); }
#pragma unroll
                  for (int h2 = 0; h2 < 2; ++h2) {
#pragma unroll
                      for (int x = 0; x < 2; ++x) { const int jt = jt0 + x, t = 16 * jt + l16; const f32x4 gg = x ? g1 : g0; float v[4];
                          if (it_ > jt) { v[0] = 0.f; v[1] = 0.f; v[2] = 0.f; v[3] = 0.f; }
                          else if (it_ == jt) { const f32x4 as = *(const LAS f32x4*)(sm + SM_ACS + h2 * 64 + 16 * it_ + 4 * q), ds = *(const LAS f32x4*)(sm + SM_DTD + h2 * 64 + 16 * it_ + 4 * q); const float at = sm[SM_ACS + h2 * 64 + t];
#pragma unroll
                              for (int r = 0; r < 4; ++r) { const int s_ = 16 * it_ + 4 * q + r; v[r] = (s_ <= t) ? gg[r] * (ds[r] * __builtin_amdgcn_exp2f(at - as[r])) : 0.f; } }
                          else { const f32x4 vs = *(const LAS f32x4*)(sm + SM_V + h2 * 64 + 16 * it_ + 4 * q); const float ut = sm[SM_U + h2 * 192 + it_ * 64 + t];
#pragma unroll
                              for (int r = 0; r < 4; ++r) v[r] = gg[r] * (ut * vs[r]); }
                          if (it_ <= jt || ((it_ & 1) && it_ == jt + 1)) { v2u lw; lw.x = pk2(v[0], v[1]); lw.y = pk2(v[2], v[3]);
                              *(LAS v2u*)(L + OFF_L + h2 * 64 * S64 + t * S64 + (16 * it_ + 4 * q) * 2) = lw; } } } } }
            f32x4 yacc[4];
#pragma unroll
            for (int jt = 0; jt < 4; ++jt) yacc[jt] = (f32x4){0.f, 0.f, 0.f, 0.f};
#pragma unroll
            for (int kh = 0; kh < 2; ++kh) {
                bf16x8 ia[2], ib[2][4];
#pragma unroll
                for (int k2 = 0; k2 < 2; ++k2) { const int kb = (32 * (2 * kh + k2) + 8 * q) * 2; ia[k2] = frag_row(L + OFF_H + hh * 64 * S128, S128, 16 * pt + l16, kb);
#pragma unroll
                    for (int jt = 0; jt < 4; ++jt) ib[k2][jt] = frag_row(L + OFF_C, S128, 16 * jt + l16, kb); }
                __builtin_amdgcn_sched_barrier(0);
#pragma unroll
                for (int k2 = 0; k2 < 2; ++k2)
#pragma unroll
                    for (int jt = 0; jt < 4; ++jt) yacc[jt] = MFMA16(ia[k2], ib[k2][jt], yacc[jt]);
                __builtin_amdgcn_sched_barrier(0); }
#pragma unroll
            for (int jt = 0; jt < 4; ++jt) { const float ea = sm[SM_EA + hh * 64 + 16 * jt + l16]; yacc[jt] = yacc[jt] * ea; }
            { const float etot = sm[SM_ETOT + hh];
#pragma unroll
              for (int n8 = 0; n8 < 8; ++n8) hacc[n8] = hacc[n8] * etot;
#pragma unroll
              for (int ks = 0; ks < 2; ++ks) { bf16x8 ha[8]; const bf16x8 bb = frag_tr(L + OFF_XE + hh * 64 * S64, S64, 32 * ks, 16 * pt, lane);
#pragma unroll
                  for (int n8 = 0; n8 < 8; ++n8) ha[n8] = frag_tr(L + OFF_B, S128, 32 * ks, 16 * n8, lane);
                  __builtin_amdgcn_sched_barrier(0);
#pragma unroll
                  for (int n8 = 0; n8 < 8; ++n8) hacc[n8] = MFMA16(ha[n8], bb, hacc[n8]);
                  __builtin_amdgcn_sched_barrier(0); } }
            if (has_next) { SCAN_SMALL(dtA, par ^ 1); }
            dtA = dtB;
            LDS_BARRIER();
            { bf16x8 xa[2], lb[2][4];
#pragma unroll
              for (int ks = 0; ks < 2; ++ks) { xa[ks] = frag_tr(L + (par ? OFF_XD2 : OFF_XD) + hh * 64 * S64, S64, 32 * ks, 16 * pt, lane); const int kb = (32 * ks + 8 * q) * 2;
#pragma unroll
                  for (int jt = 0; jt < 4; ++jt) { if (ks == 1 && jt < 2) { lb[ks][jt] = xa[ks]; continue; }
                      lb[ks][jt] = frag_row(L + OFF_L + hh * 64 * S64, S64, 16 * jt + l16, kb); } }
              __builtin_amdgcn_sched_barrier(0);
#pragma unroll
              for (int ks = 0; ks < 2; ++ks)
#pragma unroll
                  for (int jt = 0; jt < 4; ++jt) { if (ks == 1 && jt < 2) continue; yacc[jt] = MFMA16(xa[ks], lb[ks][jt], yacc[jt]); } }
            SCAN_WRITE_HS();
#pragma unroll
            for (int jt = 0; jt < 4; ++jt) { const int t = 16 * jt + l16;
                const v2u xv = *(const LAS v2u*)(L + (par ? OFF_XD2 : OFF_XD) + hh * 64 * S64 + t * S64 + (16 * pt + 4 * q) * 2);
                const float o0 = (yacc[jt][0] + Dh * bflo(xv.x)) * bflo(ez[jt].x), o1 = (yacc[jt][1] + Dh * bfhi(xv.x)) * bfhi(ez[jt].x);
                const float o2 = (yacc[jt][2] + Dh * bflo(xv.y)) * bflo(ez[jt].y), o3 = (yacc[jt][3] + Dh * bfhi(xv.y)) * bfhi(ez[jt].y);
                float ss = (o0 * o0 + o1 * o1) + (o2 * o2 + o3 * o3); ss += __shfl_xor(ss, 16); ss += __shfl_xor(ss, 32);
                if (q == 0) PS[(hh * 4 + pt) * 64 + t] = ss;
                if (t < nt) { v2u ow; ow.x = pk2(o0, o1); ow.y = pk2(o2, o3);
                    *(v2u*)(Y + (size_t)(row0 + t) * DI + head * HD + 16 * pt + 4 * q) = ow; } }
            if (has_next) { SCAN_STAGE(par ^ 1); }
            row0p = row0; ntp = nt; row0 = row0n; nt = ntn;
        }
        LDS_BARRIER();
        if (sm_h >= 0) { const float sq = (PS[(sm_h * 4 + 0) * 64 + lane] + PS[(sm_h * 4 + 1) * 64 + lane]) + (PS[(sm_h * 4 + 2) * 64 + lane] + PS[(sm_h * 4 + 3) * 64 + lane]);
            if (lane < ntp) YSQ[(size_t)(row0p + lane) * NH + head_s] = sq; }
        { GAS float* op = F.out + (is_sample ? O_SSM_S + ((((size_t)j * NSB + b) * NH + head) * HD + 16 * pt + l16) * DS : O_SSM_P + ((((size_t)j * NB + b) * NH + head) * HD + 16 * pt + l16) * DS) + 4 * q;
#pragma unroll
          for (int n8 = 0; n8 < 8; ++n8) *(GAS f32x4*)(op + 16 * n8) = hacc[n8]; }
#undef SCAN_PREFETCH
#undef SCAN_DTLOAD
#undef SCAN_SMALL
#undef SCAN_STAGE
#undef SCAN_WRITE_HS
    }
}

__device__ __forceinline__ void ssd_scale_phase(Frame& F) {
    const float* YSQ = (const float*)(F.ws + WS_YSQ); float* CG = (float*)(F.ws + WS_CG);
    const int gw = F.vcu * NWAVES + F.wave, NGW = F.G * NWAVES;
    for (int m = gw; m < M_PAD; m += NGW) {
        f32x2 v = *(const f32x2*)(YSQ + (size_t)m * NH + 2 * F.lane);
        float sq = (m < M_REAL) ? v[0] + v[1] : 0.f;
        sq += __shfl_xor(sq, 1); sq += __shfl_xor(sq, 2); sq += __shfl_xor(sq, 4);
        if ((F.lane & 7) == 0) CG[(size_t)m * 8 + (F.lane >> 3)] = rsqrtf(sq * (1.f / 1024.f) + EPS);
    }
}

__device__ __forceinline__ void sc_tail_sum(const float* SLAB, int r, int type, int c0, float (&f)[8]) {
#pragma unroll
    for (int e = 0; e < 8; ++e) f[e] = 0.f;
#pragma unroll
    for (int k = 0; k < 4; ++k) { const float* p = SLAB + (size_t)k * (256 * 16384) + (size_t)r * 16384 + type * 4096 + c0; const f32x4 a = *(const f32x4*)p, b = *(const f32x4*)(p + 4);
        f[0] += a[0]; f[1] += a[1]; f[2] += a[2]; f[3] += a[3]; f[4] += b[0]; f[5] += b[1]; f[6] += b[2]; f[7] += b[3]; }
}
__device__ __forceinline__ void sc_elem_phase(Frame& F, const Args& A, int j) {
    const bf16* GC = (const bf16*)(F.ws + WS_GC); const float* SLAB = (const float*)(F.ws + WS_SLAB);
    bf16* Y = (bf16*)(F.ws + WS_Y); const float* RSTD = (const float*)(F.ws + WS_RSTD);
    const float* cw = A.in[16] + (size_t)j * 3 * D; const float* st_in = A.in[4] + (size_t)j * NSB * 2 * D;
    const bool tail_wg = (F.G > 24) && (F.vcu < 12);
    const int c0 = tail_wg ? F.wave * 512 + F.lane * 8 : F.tid * 8;
    float w[3][8];
#pragma unroll
    for (int k = 0; k < 3; ++k) { const f32x4 a = *(const f32x4*)(cw + (size_t)k * D + c0), b = *(const f32x4*)(cw + (size_t)k * D + c0 + 4);
        w[k][0] = a[0]; w[k][1] = a[1]; w[k][2] = a[2]; w[k][3] = a[3]; w[k][4] = b[0]; w[k][5] = b[1]; w[k][6] = b[2]; w[k][7] = b[3]; }
    if (tail_wg || F.G <= 24) {
        for (int t = tail_wg ? F.vcu : 0; t < 12; t += tail_wg ? 12 : 1) {
          for (int sl = tail_wg ? 0 : 0; sl < (tail_wg ? 1 : 8); ++sl) {
            const int cc = tail_wg ? c0 : sl * 512 + F.lane * 8;
            if (!tail_wg && F.wave != 0) continue;
            if (!tail_wg && F.vcu != 0) continue;
            const int seg = (t < 4) ? t * 257 : NB * 257 + (t - 4);
            const Seg s = seg_decode(seg);
            float ww[3][8];
#pragma unroll
            for (int k = 0; k < 3; ++k) { const f32x4 a = *(const f32x4*)(cw + (size_t)k * D + cc), b = *(const f32x4*)(cw + (size_t)k * D + cc + 4);
                ww[k][0] = a[0]; ww[k][1] = a[1]; ww[k][2] = a[2]; ww[k][3] = a[3]; ww[k][4] = b[0]; ww[k][5] = b[1]; ww[k][6] = b[2]; ww[k][7] = b[3]; }
            float r2[8], r1[8];
            if (s.is_sample) {
#pragma unroll
                for (int d = 2; d >= 1; --d) { float (&dst)[8] = (d == 2) ? r2 : r1; const float* p = st_in + ((size_t)s.b * 2 + (2 - d)) * D + cc; const f32x4 a = *(const f32x4*)p, b = *(const f32x4*)(p + 4);
                    dst[0] = a[0]; dst[1] = a[1]; dst[2] = a[2]; dst[3] = a[3]; dst[4] = b[0]; dst[5] = b[1]; dst[6] = b[2]; dst[7] = b[3]; } }
            else {
#pragma unroll
                for (int e = 0; e < 8; ++e) { r2[e] = 0.f; r1[e] = 0.f; } }
            for (int i = 0; i < 16; ++i) { const int row = s.row0 + i; const float rs = RSTD[row], rs2 = rs * rs;
                float gf[8], bf[8], cf[8], vf[8], o[8];
                sc_tail_sum(SLAB, row - ROW_META, 0, cc, gf); sc_tail_sum(SLAB, row - ROW_META, 1, cc, bf); sc_tail_sum(SLAB, row - ROW_META, 2, cc, cf); sc_tail_sum(SLAB, row - ROW_META, 3, cc, vf);
#pragma unroll
                for (int e = 0; e < 8; ++e) { const float cv = cf[e] * vf[e] * rs2; const float conv = ww[0][e] * r2[e] + ww[1][e] * r1[e] + ww[2][e] * cv;
                    o[e] = silu_f(gf[e] * rs) * (bf[e] * rs) * conv; r2[e] = r1[e]; r1[e] = cv; }
                *(v4u*)(Y + (size_t)row * D + cc) = pack8(o); }
            if (s.is_last) {
                GAS float* ob = F.out + O_SC_S + ((size_t)j * NSB + s.b) * 2 * D + cc;
                *(GAS f32x4*)(ob) = (f32x4){r2[0], r2[1], r2[2], r2[3]}; *(GAS f32x4*)(ob + 4) = (f32x4){r2[4], r2[5], r2[6], r2[7]};
                *(GAS f32x4*)(ob + D) = (f32x4){r1[0], r1[1], r1[2], r1[3]}; *(GAS f32x4*)(ob + D + 4) = (f32x4){r1[4], r1[5], r1[6], r1[7]}; }
          }
        }
        if (tail_wg) return;
    }
    const int nwg = tail_wg ? 0 : (F.G > 24 ? F.G - 12 : F.G), rank = (F.G > 24) ? F.vcu - 12 : F.vcu;
    for (int n = rank; n < NB * 256; n += nwg) {
        const int b = n >> 8, k = (n & 255) + 1; const int row0 = b * SEQ + 16 * (k - 1);
        float r2[8], r1[8];
#pragma unroll
        for (int d = 2; d >= 1; --d) {
            float (&dst)[8] = (d == 2) ? r2 : r1;
            const int hr = (k == 1) ? ROW_META + 16 * b + 16 - d : row0 - d;
            if (hr >= ROW_META) { float cf[8], vf[8]; sc_tail_sum(SLAB, hr - ROW_META, 2, c0, cf); sc_tail_sum(SLAB, hr - ROW_META, 3, c0, vf); const float rs = RSTD[hr], rs2 = rs * rs;
#pragma unroll
                for (int e = 0; e < 8; ++e) dst[e] = cf[e] * vf[e] * rs2; }
            else { const v4u q0 = *(const v4u*)(GC + (size_t)hr * 8192 + 2 * c0), q1 = *(const v4u*)(GC + (size_t)hr * 8192 + 2 * c0 + 8);
                dst[0] = bflo(q0.z); dst[1] = bfhi(q0.z); dst[2] = bflo(q0.w); dst[3] = bfhi(q0.w); dst[4] = bflo(q1.z); dst[5] = bfhi(q1.z); dst[6] = bflo(q1.w); dst[7] = bfhi(q1.w); }
        }
        v4u q0v[16], q1v[16];
#pragma unroll
        for (int i = 0; i < 16; ++i) { const size_t off = (size_t)(row0 + i) * D + c0; q0v[i] = __builtin_nontemporal_load((const v4u*)(GC + 2 * off)); q1v[i] = __builtin_nontemporal_load((const v4u*)(GC + 2 * off + 8)); }
#pragma unroll
        for (int i = 0; i < 16; ++i) { const size_t off = (size_t)(row0 + i) * D + c0; const v4u q0 = q0v[i], q1 = q1v[i];
            const float gb[8] = {bflo(q0.x), bfhi(q0.x), bflo(q0.y), bfhi(q0.y), bflo(q1.x), bfhi(q1.x), bflo(q1.y), bfhi(q1.y)};
            const float cv[8] = {bflo(q0.z), bfhi(q0.z), bflo(q0.w), bfhi(q0.w), bflo(q1.z), bfhi(q1.z), bflo(q1.w), bfhi(q1.w)}; float o[8];
#pragma unroll
            for (int e = 0; e < 8; ++e) { o[e] = gb[e] * __builtin_fmaf(w[2][e], cv[e], __builtin_fmaf(w[1][e], r1[e], w[0][e] * r2[e])); r2[e] = r1[e]; r1[e] = cv[e]; }
            *(v4u*)(Y + off) = pack8(o); }
        if (k == 256) {
            GAS float* ob = F.out + O_SC_P + ((size_t)j * NB + b) * 2 * D + c0;
            *(GAS f32x4*)(ob) = (f32x4){r2[0], r2[1], r2[2], r2[3]}; *(GAS f32x4*)(ob + 4) = (f32x4){r2[4], r2[5], r2[6], r2[7]};
            *(GAS f32x4*)(ob + D) = (f32x4){r1[0], r1[1], r1[2], r1[3]}; *(GAS f32x4*)(ob + D + 4) = (f32x4){r1[4], r1[5], r1[6], r1[7]}; }
    }
}

__device__ __forceinline__ void final_phase(Frame& F, const Args& A) {
    const bf16* H = (const bf16*)(F.ws + WS_H); const float* RSTD = (const float*)(F.ws + WS_RSTD); const float* fw = A.in[18];
    const int gw = F.vcu * NWAVES + F.wave, NGW = F.G * NWAVES;
    for (int mm = gw; mm < NB * SEQ + NSB * LS; mm += NGW) {
        const int m = (mm < NB * SEQ) ? mm : mm + (ROW_SAMPLE - ROW_META);
        const float rs = RSTD[m];
        GAS float* orow = F.out + (size_t)mm * D;
        v4u hv[8];
#pragma unroll
        for (int jj = 0; jj < 8; ++jj) hv[jj] = __builtin_nontemporal_load((const v4u*)(H + (size_t)m * D + 8 * (64 * jj + F.lane)));
#pragma unroll
        for (int jj = 0; jj < 8; ++jj) { const int c = 8 * (64 * jj + F.lane); float f[8]; unpack8(hv[jj], f);
            const f32x4 wa = *(const f32x4*)(fw + c), wb = *(const f32x4*)(fw + c + 4);
            __builtin_nontemporal_store((f32x4){f[0] * rs * wa[0], f[1] * rs * wa[1], f[2] * rs * wa[2], f[3] * rs * wa[3]}, (GAS f32x4*)(orow + c));
            __builtin_nontemporal_store((f32x4){f[4] * rs * wb[0], f[5] * rs * wb[1], f[6] * rs * wb[2], f[7] * rs * wb[3]}, (GAS f32x4*)(orow + c + 4)); }
    }
}

__device__ __forceinline__ void tail_fixup_phase(Frame& F) {
    bf16* H = (bf16*)(F.ws + WS_H); float* SSQ = (float*)(F.ws + WS_SSQ); const float* SLAB = (const float*)(F.ws + WS_SLAB); float* RSTD = (float*)(F.ws + WS_RSTD);
    LAS float* red = (LAS float*)(F.lds + SMALL_OFF);
    for (int r = F.vcu; r < 256; r += F.G) {
        const int row = ROW_META + r; const int c = F.tid * 8;
        float f[8]; unpack8(*(const v4u*)(H + (size_t)row * D + c), f);
#pragma unroll
        for (int k = 0; k < 16; ++k) { const float* p = SLAB + (size_t)k * (256 * 4096) + (size_t)r * 4096 + c; const f32x4 a = *(const f32x4*)p, b = *(const f32x4*)(p + 4);
            f[0] += a[0]; f[1] += a[1]; f[2] += a[2]; f[3] += a[3]; f[4] += b[0]; f[5] += b[1]; f[6] += b[2]; f[7] += b[3]; }
        float ss = 0.f;
#pragma unroll
        for (int e = 0; e < 8; ++e) ss += f[e] * f[e];
        *(v4u*)(H + (size_t)row * D + c) = pack8(f);
        ss = wave_sum(ss);
        __syncthreads();
        if (F.lane == 0) red[F.wave] = ss;
        __syncthreads();
        if (F.tid < 64) { float t = 0.f;
#pragma unroll
            for (int k = 0; k < NWAVES; ++k) t += red[k];
            SSQ[(size_t)row * 64 + F.tid] = (F.tid == 0) ? t : 0.f; if (F.tid == 0) RSTD[row] = rsqrtf(t * (1.f / D) + EPS); }
    }
    { const int gw = F.vcu * NWAVES + F.wave, NGW = F.G * NWAVES;
      for (int m = gw; m < M_MAIN; m += NGW) { const float t = wave_sum(SSQ[(size_t)m * 64 + F.lane]); if (F.lane == 0) RSTD[m] = rsqrtf(t * (1.f / D) + EPS); } }
}

enum { T_PRO = 0, T_G1 = 1, T_CONV = 2, T_SCAN = 3, T_NORM = 4, T_G2 = 5, T_FIX2 = 6, T_G3 = 7, T_SCE = 8, T_G4 = 9, T_FIX4 = 10, T_FIN = 11 };
constexpr int N_PHASES = 22;
#ifndef PROBE_TYPES
#define PROBE_TYPES 0
#endif
#define REPS(T) (((PROBE_TYPES >> (T)) & 1) ? 2 : 1)

__global__ void __launch_bounds__(NWAVES * 64, 2) trunk_fwd(Args args) {
    extern __shared__ __attribute__((aligned(16))) unsigned char lds[];
    Frame F;
    F.lds = (LAS unsigned char*)lds;
    F.tid = threadIdx.x; F.lane = F.tid & 63; F.wave = __builtin_amdgcn_readfirstlane(F.tid >> 6);
    F.G = gridDim.x; { const int bx = blockIdx.x; F.vcu = (F.G % 8 == 0) ? (bx % 8) * (F.G / 8) + bx / 8 : bx; }
    const Args& A = args;
    F.ws = uni(args.ws); F.out = uni(args.out);
    for (int u = F.tid; u < (LDS_BYTES - LDSCTL_OFF) / 4; u += NWAVES * 64) ((LAS unsigned*)(F.lds + LDSCTL_OFF))[u] = 0u;
    __syncthreads();
    XcdBarrier bar; bar.bar = (unsigned*)(F.ws + WS_CTL) + CW_BAR; bar.x = 0; bar.st = nullptr;
    const int lo = args.ph_lo, hi = args.ph_hi;
    if (hi - lo > 1) bar = xcd_barrier_post((unsigned*)(F.ws + WS_CTL) + CW_BAR, (volatile LAS unsigned*)(F.lds + MISC_OFF) + 8);
#ifndef PH_OFF
#define PH_OFF(k) 0
#endif
#define IN(k) (!PH_OFF(k) && lo <= (k) && (k) < hi)
#define SEAM(k) do { if (IN(k) && IN((k) + 1)) xcd_barrier(bar); } while (0)

    if (IN(0)) { for (int rep = 0; rep < REPS(T_PRO); ++rep) p0_prologue(F, A); } SEAM(0);

#define LAYER_PAIR(lp) do {\
        const int pb = 1 + 10 * lp;\
        if (IN(pb + 0)) {\
            pg8::Gemm g{(const pg8::bf16_t*)(F.ws + WS_H), (const pg8::bf16_t*)(F.ws + WS_W_SSD_IN + lp * SZ_W_SSD_IN1), M_PAD, SSD_PROJ_PAD, D};\
            pg8::StaticOrder S; S.init(M_PAD, SSD_PROJ_PAD, D, F.G, (int)blockIdx.x);\
            pg8::EpiSsdIn E{(pg8::bf16_t*)(F.ws + WS_Z), (pg8::bf16_t*)(F.ws + WS_XBC), (float*)(F.ws + WS_DTRAW), (const float*)(F.ws + WS_RSTD)};\
            pg8::gemm_phase<pg8::EpiSsdIn, pg8::StaticOrder, true, true>(F.lds + RING_OFF, g, S, E);\
            if (REPS(T_G1) > 1) { pg8::EpiNone E0; pg8::gemm_phase<pg8::EpiNone, pg8::StaticOrder, true, true>(F.lds + RING_OFF, g, S, E0); }\
            late_convert(F, A, lp == 0 ? LATE0_BEGIN : LATE1_BEGIN, lp == 0 ? LATE0_COUNT : LATE1_COUNT);\
        } SEAM(pb + 0);\
        if (IN(pb + 1)) { for (int rep = 0; rep < REPS(T_CONV); ++rep) ssd_conv_phase(F, A, lp); } SEAM(pb + 1);\
        if (IN(pb + 2)) { for (int rep = 0; rep < REPS(T_SCAN); ++rep) ssd_scan_phase(F, A, lp); } SEAM(pb + 2);\
        if (IN(pb + 3)) { ssd_scale_phase(F); } SEAM(pb + 3);\
        if (IN(pb + 4)) {\
            pg8::Gemm g{(const pg8::bf16_t*)(F.ws + WS_Y), (const pg8::bf16_t*)(F.ws + WS_W_SSD_OUT + lp * SZ_W_SSD_OUT1), M_MAIN, D, DI};\
            pg8::TailSplitOrder S; S.init(M_MAIN, D, DI, F.G, (int)blockIdx.x); S.KS = 16; S.wgm = G2_WGM;\
            pg8::EpiResidN E{pg8::EpiResid{(pg8::bf16_t*)(F.ws + WS_H), (float*)(F.ws + WS_SSQ), (float*)(F.ws + WS_SLAB)}, (const float*)(F.ws + WS_CG)};\
            pg8::gemm_phase<pg8::EpiResidN, pg8::TailSplitOrder, true, true>(F.lds + RING_OFF, g, S, E);\
        } SEAM(pb + 4);\
        if (IN(pb + 5)) { tail_fixup_phase(F); } SEAM(pb + 5);\
        if (IN(pb + 6)) {\
            pg8::Gemm g{(const pg8::bf16_t*)(F.ws + WS_H), (const pg8::bf16_t*)(F.ws + WS_W_SC_IN + lp * SZ_W_SC_IN1), M_MAIN, SC_PROJ, D};\
            pg8::TailSplitOrder S; S.init(M_MAIN, SC_PROJ, D, F.G, (int)blockIdx.x); S.KS = 4;\
            pg8::EpiScIn E{(pg8::bf16_t*)(F.ws + WS_GC), (const float*)(F.ws + WS_RSTD), (float*)(F.ws + WS_SLAB)};\
            if (REPS(T_G3) > 1) { pg8::EpiNone E0; pg8::gemm_phase<pg8::EpiNone, pg8::TailSplitOrder, true, true>(F.lds + RING_OFF, g, S, E0); }\
            pg8::gemm_phase<pg8::EpiScIn, pg8::TailSplitOrder, true, true>(F.lds + RING_OFF, g, S, E);\
        } SEAM(pb + 6);\
        if (IN(pb + 7)) { for (int rep = 0; rep < REPS(T_SCE); ++rep) sc_elem_phase(F, A, lp); } SEAM(pb + 7);\
        if (IN(pb + 8)) {\
            pg8::Gemm g{(const pg8::bf16_t*)(F.ws + WS_Y), (const pg8::bf16_t*)(F.ws + WS_W_SC_OUT + lp * SZ_W_SC_OUT1), M_MAIN, D, D};\
            pg8::TailSplitOrder S; S.init(M_MAIN, D, D, F.G, (int)blockIdx.x); S.KS = 16;\
            pg8::EpiResid E{(pg8::bf16_t*)(F.ws + WS_H), (float*)(F.ws + WS_SSQ), (float*)(F.ws + WS_SLAB)};\
            if (REPS(T_G4) > 1) { pg8::EpiNone E0; pg8::gemm_phase<pg8::EpiNone, pg8::TailSplitOrder, true, true>(F.lds + RING_OFF, g, S, E0); }\
            pg8::gemm_phase<pg8::EpiResid, pg8::TailSplitOrder, true, true>(F.lds + RING_OFF, g, S, E);\
        } SEAM(pb + 8);\
        if (IN(pb + 9)) { tail_fixup_phase(F); } SEAM(pb + 9);\
    } while (0)
    LAYER_PAIR(0);
    LAYER_PAIR(1);
#undef LAYER_PAIR
    if (IN(21)) { for (int rep = 0; rep < REPS(T_FIN); ++rep) final_phase(F, A); }
#undef IN
#undef SEAM
}

extern "C" void kernel_launch(void* const* d_in, const int* in_sizes, int n_in, void* d_out, int out_size, void* d_ws, size_t ws_size, hipStream_t stream) {
    static int grid = 0;
    if (grid == 0) {
        if (n_in != 19 || (size_t)out_size != O_END || ws_size < WS_END) { fprintf(stderr, "kernel_launch: unexpected shapes: n_in %d out %d ws %zu (need %zu)\n", n_in, out_size, ws_size, (size_t)WS_END); grid = -1; return; }
        int dev = 0, cus = 0, per_cu = 0;
        if (hipGetDevice(&dev) != hipSuccess || hipDeviceGetAttribute(&cus, hipDeviceAttributeMultiprocessorCount, dev) != hipSuccess) { grid = -1; return; }
        if (hipFuncSetAttribute((const void*)trunk_fwd, hipFuncAttributeMaxDynamicSharedMemorySize, LDS_BYTES) != hipSuccess) { fprintf(stderr, "kernel_launch: hipFuncSetAttribute failed\n"); grid = -1; return; }
        if (hipOccupancyMaxActiveBlocksPerMultiprocessor(&per_cu, (const void*)trunk_fwd, NWAVES * 64, LDS_BYTES) != hipSuccess || per_cu < 1)
            fprintf(stderr, "kernel_launch: occupancy query reports %d workgroups per CU\n", per_cu);
        (void)hipGetLastError();
        grid = cus;
    }
    if (grid < 0) return;
    if (hipMemsetAsync((char*)d_ws + WS_CTL, 0, CTL_ZERO_BYTES, stream) != hipSuccess) return;
    Args a{};
    for (int i = 0; i < 19; ++i) a.in[i] = (const float*)d_in[i];
    a.out = (float*)d_out; a.ws = (unsigned char*)d_ws;
#if MK_N_LAUNCHES == 1
    a.ph_lo = 0; a.ph_hi = N_PHASES;
    hipLaunchKernelGGL(trunk_fwd, dim3(grid), dim3(NWAVES * 64), LDS_BYTES, stream, a);
#else
    for (int ph = 0; ph < N_PHASES; ++ph) { a.ph_lo = ph; a.ph_hi = ph + 1; hipLaunchKernelGGL(trunk_fwd, dim3(grid), dim3(NWAVES * 64), LDS_BYTES, stream, a); }
#endif
}
```

```cpp
#include <hip/hip_runtime.h>
#include <cstdio>
#include <cstdint>

#ifndef MK_N_LAUNCHES
#define MK_N_LAUNCHES 1
#endif

namespace pg8 {
#define PG8_LAS __attribute__((address_space(3)))
typedef unsigned short bf16_t;
typedef short bf16x8 __attribute__((ext_vector_type(8)));
typedef float f32x4 __attribute__((ext_vector_type(4)));
typedef unsigned u32x4 __attribute__((ext_vector_type(4)));
typedef unsigned u32x2 __attribute__((ext_vector_type(2)));
constexpr int M_MAIN_PANELS = 64;
constexpr int BM = 256, BK = 64, HALF = 128, HTB = HALF * BK * 2  , STAGE_BYTES = 8 * HTB, NXCD = 8, WGM = 8;

__host__ __device__ __forceinline__ int lds_byte(int r, int c) { const int st = (r >> 4) * 2 + (c >> 5), rr = r & 15, cc = c & 31, ob = rr * 64 + cc * 2; return st * 1024 + (ob ^ (((ob >> 9) & 1) << 5)); }
__host__ __device__ __forceinline__ void stage_rc(int b, int& R, int& C) { const int st = b / 1024, sb = b % 1024, swz = sb ^ (((sb >> 9) & 1) << 5); R = (st >> 1) * 16 + swz / 64; C = (st & 1) * 32 + (swz % 64) / 2; }
__host__ __device__ __forceinline__ int perm32(int rho) { const int n = rho >> 4, i = rho & 15; return 8 * (i >> 2) + 4 * n + (i & 3); }

struct Unit { int pm, pn, kt0, nkt; };
struct Gemm { const bf16_t* A; const bf16_t* Bt; int M, N, K; };

struct StaticOrder {
    int nM, nN, nwg, G, c, nktf, wgm;
    __host__ __device__ void init(int M, int N, int K, int G_, int c_) { nM = M / BM; nN = N / BM; nwg = nM * nN; G = G_; c = c_; nktf = K / BK; wgm = WGM; }
    __host__ __device__ __forceinline__ void main_unit(int L, Unit& u) const {
        int wgid = L; { const int q = nwg / NXCD, r = nwg % NXCD, xcd = wgid % NXCD, off = wgid / NXCD; wgid = (xcd < r ? xcd * (q + 1) : r * (q + 1) + (xcd - r) * q) + off; }
        const int nig = wgm * nN, ngrp = (nM / wgm) > 0 ? (nM / wgm) : 1; int gid = wgid / nig; gid = gid < ngrp ? gid : ngrp - 1;
        const int fm = gid * wgm, gsz = (gid == ngrp - 1) ? (nM - fm) : wgm, w = wgid - gid * nig;
        u.pm = fm + (w % gsz); u.pn = w / gsz; u.kt0 = 0; u.nkt = nktf;
    }
    __host__ __device__ __forceinline__ bool next(int i, Unit& u) const {
        const long L = (long)i * G + c; if (L >= nwg) return false;
        main_unit((int)L, u); return true;
    }
    __device__ __forceinline__ void a_ready(const Unit&) const {}
    __device__ __forceinline__ void done(const Unit&) const {}
    __device__ __forceinline__ unsigned fetch(int) const { return 0u; }
    __device__ __forceinline__ void commit(int, unsigned) const {}
    __device__ __forceinline__ bool resolve(int i, Unit& u) const { return next(i, u); }
};
struct TailSplitOrder : StaticOrder {
    int KS;
    __host__ __device__ __forceinline__ bool next(int i, Unit& u) const {
        const long L = (long)i * G + c; const bool is_main = L < nwg; const long mi = L - nwg;
        if (!is_main && mi >= (long)nN * KS) return false;
        Unit a; main_unit(is_main ? (int)L : 0, a);
        const int mn = nktf / KS, mpn = (int)(mi / KS), mks = (int)(mi % KS);
        u.pm = is_main ? a.pm : nM; u.pn = is_main ? a.pn : mpn; u.kt0 = is_main ? 0 : mks * mn; u.nkt = is_main ? nktf : mn;
        return true;
    }
    __device__ __forceinline__ bool resolve(int i, Unit& u) const { return next(i, u); }
};

struct DynOrder : TailSplitOrder {
    unsigned* ctr; PG8_LAS unsigned* slot; bool dyn;
    __device__ __forceinline__ void setup(unsigned* ctr_, PG8_LAS unsigned* slot_) { ctr = ctr_; slot = slot_; dyn = (G % 8 == 0) && G >= 8; }
    __device__ __forceinline__ bool entry(int k, Unit& u) const {
        const int x = c & 7; const int nmain = (nwg - x + 7) / 8; const bool is_main = k < nmain; const long mi = (long)(k - nmain) * 8 + x;
        if (!is_main && (KS == 0 || mi >= (long)nN * KS)) return false;
        Unit a; main_unit(is_main ? k * 8 + x : 0, a);
        const int ks_ = KS ? KS : 1, mn = nktf / ks_, mpn = (int)(mi / ks_), mks = (int)(mi % ks_);
        u.pm = is_main ? a.pm : nM; u.pn = is_main ? a.pn : mpn; u.kt0 = is_main ? 0 : mks * mn; u.nkt = is_main ? nktf : mn;
        return true;
    }
    __device__ __forceinline__ bool next(int i, Unit& u) const { return dyn ? entry(c >> 3, u) : TailSplitOrder::next(i, u); }
    __device__ __forceinline__ unsigned fetch(int) const { unsigned k = 0u; if (dyn && threadIdx.x == 0) k = (unsigned)(G >> 3) + __hip_atomic_fetch_add(ctr + 64 * (c & 7), 1u, __ATOMIC_RELAXED, __HIP_MEMORY_SCOPE_AGENT); return k; }
    __device__ __forceinline__ void commit(int ui, unsigned k) const { if (dyn && threadIdx.x == 0) slot[(ui + 1) & 1] = k; }
    __device__ __forceinline__ bool resolve(int i, Unit& u) const { if (!dyn) return TailSplitOrder::next(i, u); const int k = __builtin_amdgcn_readfirstlane((int)slot[i & 1]); return entry(k, u); }
};

__device__ __forceinline__ unsigned cvt_pk_bf16(float lo, float hi) { unsigned r; asm volatile("v_cvt_pk_bf16_f32 %0, %1, %2" : "=v"(r) : "v"(lo), "v"(hi)); return r; }
__device__ __forceinline__ unsigned cvt_pk_bf16_nv(float lo, float hi) { unsigned r; asm("v_cvt_pk_bf16_f32 %0, %1, %2" : "=v"(r) : "v"(lo), "v"(hi)); return r; }

struct EpiSsdIn {
    static constexpr bool PERM = true, AFTER_DRAIN = false, KSCALE = false;
    bf16_t* Z; bf16_t* XBC; float* DTRAW; const float* RSTD;
    __device__ __forceinline__ void operator()(const f32x4 (&acc)[2][2][4][2], const Unit& u, int wr, int wc, int fr, int fq) const {
        const int row0 = u.pm * BM + wr * 64 + fr;
        if (u.pn < 32) {
            const int col0 = u.pn * BM + wc * 32 + 8 * fq;
            float rsv[2][4];
#pragma unroll
            for (int ai = 0; ai < 2; ++ai)
#pragma unroll
                for (int m = 0; m < 4; ++m) rsv[ai][m] = RSTD[row0 + ai * HALF + m * 16];
#pragma unroll
            for (int ai = 0; ai < 2; ++ai)
#pragma unroll
                for (int m = 0; m < 4; ++m) { bf16_t* rowp = Z + (size_t)(row0 + ai * HALF + m * 16) * 8192 + col0; const float rs = rsv[ai][m];
#pragma unroll
                    for (int bj = 0; bj < 2; ++bj) { float g[8];
#pragma unroll
                        for (int e = 0; e < 8; ++e) { const float x = acc[ai][bj][m][e >> 2][e & 3] * rs; g[e] = x * __builtin_amdgcn_rcpf(1.f + __builtin_amdgcn_exp2f(-1.44269504f * x)); }
                        u32x4 w; w.x = cvt_pk_bf16(g[0], g[1]); w.y = cvt_pk_bf16(g[2], g[3]); w.z = cvt_pk_bf16(g[4], g[5]); w.w = cvt_pk_bf16(g[6], g[7]);
                        *(u32x4*)(rowp + bj * HALF) = w; } }
        } else if (u.pn < 72) {
            const int col0 = (u.pn - 32) * BM + wc * 32 + 8 * fq;
#pragma unroll
            for (int ai = 0; ai < 2; ++ai)
#pragma unroll
                for (int m = 0; m < 4; ++m) { bf16_t* rowp = XBC + (size_t)(row0 + ai * HALF + m * 16) * 10240 + col0;
#pragma unroll
                    for (int bj = 0; bj < 2; ++bj) { const f32x4 v0 = acc[ai][bj][m][0], v1 = acc[ai][bj][m][1];
                        u32x4 w; w.x = cvt_pk_bf16(v0[0], v0[1]); w.y = cvt_pk_bf16(v0[2], v0[3]); w.z = cvt_pk_bf16(v1[0], v1[1]); w.w = cvt_pk_bf16(v1[2], v1[3]);
                        *(u32x4*)(rowp + bj * HALF) = w; } }
        } else {
            const int col0 = wc * 32 + 8 * fq;
#pragma unroll
            for (int ai = 0; ai < 2; ++ai)
#pragma unroll
                for (int m = 0; m < 4; ++m) { float* rowp = DTRAW + (size_t)(row0 + ai * HALF + m * 16) * 128 + col0;
                    *(f32x4*)(rowp) = acc[ai][0][m][0]; *(f32x4*)(rowp + 4) = acc[ai][0][m][1]; }
        }
    }
};
struct EpiBf16Plain {
    static constexpr bool PERM = true, AFTER_DRAIN = false, KSCALE = false;
    bf16_t* O; int ldc;
    __device__ __forceinline__ void operator()(const f32x4 (&acc)[2][2][4][2], const Unit& u, int wr, int wc, int fr, int fq) const {
        const int row0 = u.pm * BM + wr * 64 + fr, col0 = u.pn * BM + wc * 32 + 8 * fq;
#pragma unroll
        for (int ai = 0; ai < 2; ++ai)
#pragma unroll
            for (int m = 0; m < 4; ++m) { bf16_t* rowp = O + (size_t)(row0 + ai * HALF + m * 16) * ldc + col0;
#pragma unroll
                for (int bj = 0; bj < 2; ++bj) { const f32x4 v0 = acc[ai][bj][m][0], v1 = acc[ai][bj][m][1];
                    u32x4 w; w.x = cvt_pk_bf16(v0[0], v0[1]); w.y = cvt_pk_bf16(v0[2], v0[3]); w.z = cvt_pk_bf16(v1[0], v1[1]); w.w = cvt_pk_bf16(v1[2], v1[3]);
                    *(u32x4*)(rowp + bj * HALF) = w; } }
    }
};
struct EpiScIn {
    static constexpr bool PERM = true, AFTER_DRAIN = false, KSCALE = false;
    bf16_t* GC; const float* RSTD; float* SLAB;
    __device__ __forceinline__ void operator()(const f32x4 (&acc)[2][2][4][2], const Unit& u, int wr, int wc, int fr, int fq) const {
        const int j0 = u.pn * 64 + wc * 16 + fq * 4;
        if (u.pm >= M_MAIN_PANELS) {
            int tz = threadIdx.x; asm volatile("" : "+v"(tz)); const int wid_ = tz >> 6, ln_ = tz & 63;
            bf16_t* sl = (bf16_t*)SLAB + (size_t)(u.kt0 / u.nkt) * (256 * 16384) + (unsigned)(((wid_ >> 2) * 64 + (ln_ & 15)) * 16384 + u.pn * 64 + (wid_ & 3) * 16 + (ln_ >> 4) * 4);
#pragma unroll
            for (int ai = 0; ai < 2; ++ai) {
                if (ai == 1 && wr == 1) continue;
#pragma unroll
                for (int m = 0; m < 4; ++m) { bf16_t* p = sl + (size_t)(ai * HALF + m * 16) * 16384;
#pragma unroll
                    for (int ty = 0; ty < 4; ++ty) { const f32x4 v = acc[ai][ty >> 1][m][ty & 1]; u32x2 w; w.x = cvt_pk_bf16_nv(v[0], v[1]); w.y = cvt_pk_bf16_nv(v[2], v[3]); *(u32x2*)(p + ty * 4096) = w; } } }
            return;
        }
        const int row0 = u.pm * BM + wr * 64 + fr;
        float rsv[2][4];
#pragma unroll
        for (int ai = 0; ai < 2; ++ai)
#pragma unroll
            for (int m = 0; m < 4; ++m) rsv[ai][m] = RSTD[row0 + ai * HALF + m * 16];
#pragma unroll
        for (int ai = 0; ai < 2; ++ai)
#pragma unroll
            for (int m = 0; m < 4; ++m) { const int row = row0 + ai * HALF + m * 16; const float rs = rsv[ai][m], rs2 = rs * rs;
                const f32x4 g = acc[ai][0][m][0], b = acc[ai][0][m][1], c = acc[ai][1][m][0], v = acc[ai][1][m][1]; float gb[4], cv[4];
#pragma unroll
                for (int e = 0; e < 4; ++e) { const float x = g[e] * rs; gb[e] = x * __builtin_amdgcn_rcpf(1.f + __builtin_amdgcn_exp2f(-1.44269504f * x)) * (b[e] * rs); cv[e] = c[e] * v[e] * rs2; }
                u32x4 w; w.x = cvt_pk_bf16(gb[0], gb[1]); w.y = cvt_pk_bf16(gb[2], gb[3]); w.z = cvt_pk_bf16(cv[0], cv[1]); w.w = cvt_pk_bf16(cv[2], cv[3]);
                *(u32x4*)(GC + (size_t)row * 8192 + 2 * j0) = w; }
    }
};
struct EpiNone {
    static constexpr bool PERM = true, AFTER_DRAIN = false, KSCALE = false;
    __device__ __forceinline__ void operator()(const f32x4 (&acc)[2][2][4][2], const Unit&, int, int, int, int) const {
#pragma unroll
        for (int ai = 0; ai < 2; ++ai)
#pragma unroll
            for (int bj = 0; bj < 2; ++bj)
#pragma unroll
                for (int m = 0; m < 4; ++m) { asm volatile("" :: "v"(acc[ai][bj][m][0]), "v"(acc[ai][bj][m][1])); }
    }
};
__device__ __forceinline__ void kscale_prep(const float* CG, const Unit& u, PG8_LAS float* tbl) {
    int tid = threadIdx.x; asm volatile("" : "+v"(tid));
    if (tid < 256) { const float* p = CG + ((size_t)u.pm * BM + tid) * 8; const f32x4 a = *(const f32x4*)p, b = *(const f32x4*)(p + 4);
        f32x4 ra, rb; ra[0] = b[3]; ra[1] = a[0] * __builtin_amdgcn_rcpf(a[1]); ra[2] = a[1] * __builtin_amdgcn_rcpf(a[2]); ra[3] = a[2] * __builtin_amdgcn_rcpf(a[3]);
        rb[0] = a[3] * __builtin_amdgcn_rcpf(b[0]); rb[1] = b[0] * __builtin_amdgcn_rcpf(b[1]); rb[2] = b[1] * __builtin_amdgcn_rcpf(b[2]); rb[3] = b[2] * __builtin_amdgcn_rcpf(b[3]);
        *(PG8_LAS f32x4*)(tbl + tid * 8) = ra; *(PG8_LAS f32x4*)(tbl + tid * 8 + 4) = rb; }
}
__device__ __forceinline__ void kscale_step(f32x4 (&acc)[2][2][4][2], const PG8_LAS float* tbl, int g, int, int) {
    int tz = threadIdx.x; asm volatile("" : "+v"(tz)); const int wr = tz >> 8, fr = tz & 15;
#pragma unroll
    for (int ai = 0; ai < 2; ++ai)
#pragma unroll
        for (int m = 0; m < 4; ++m) { const int r = ai * HALF + wr * 64 + m * 16 + fr; const float ratio = tbl[r * 8 + g];
#pragma unroll
            for (int bj = 0; bj < 2; ++bj)
#pragma unroll
                for (int n = 0; n < 2; ++n) acc[ai][bj][m][n] = acc[ai][bj][m][n] * ratio; }
}
template <bool BSLAB> struct EpiResidT {
    static constexpr bool PERM = true, AFTER_DRAIN = false, KSCALE = false;
    bf16_t* H; float* SSQ; float* SLAB;
    __device__ __forceinline__ void operator()(const f32x4 (&acc)[2][2][4][2], const Unit& u, int wr, int wc, int fr, int fq) const {
        const int row0 = u.pm * BM + wr * 64 + fr, col0 = u.pn * BM + wc * 32 + 8 * fq;
        if (u.pm >= M_MAIN_PANELS) {
            if constexpr (BSLAB) {
            int tz = threadIdx.x; asm volatile("" : "+v"(tz)); const int wid_ = tz >> 6, ln_ = tz & 63;
            bf16_t* sl = (bf16_t*)SLAB + (size_t)(u.kt0 / u.nkt) * (256 * 4096) + (unsigned)(((wid_ >> 2) * 64 + (ln_ & 15)) * 4096 + u.pn * BM + (wid_ & 3) * 32 + 8 * (ln_ >> 4));
#pragma unroll
            for (int ai = 0; ai < 2; ++ai) {
                if (ai == 1 && wr == 1) continue;
#pragma unroll
                for (int m = 0; m < 4; ++m)
#pragma unroll
                    for (int bj = 0; bj < 2; ++bj) { bf16_t* p = sl + (size_t)(ai * HALF + m * 16) * 4096 + bj * HALF; const f32x4 v0 = acc[ai][bj][m][0], v1 = acc[ai][bj][m][1];
                        u32x4 w; w.x = cvt_pk_bf16_nv(v0[0], v0[1]); w.y = cvt_pk_bf16_nv(v0[2], v0[3]); w.z = cvt_pk_bf16_nv(v1[0], v1[1]); w.w = cvt_pk_bf16_nv(v1[2], v1[3]); *(u32x4*)p = w; } }
            } else {
            float* sl = SLAB + (size_t)(u.kt0 / u.nkt) * (256 * 4096) + (size_t)(wr * 64 + fr) * 4096 + col0;
#pragma unroll
            for (int ai = 0; ai < 2; ++ai) {
                if (ai == 1 && wr == 1) continue;
#pragma unroll
                for (int m = 0; m < 4; ++m)
#pragma unroll
                    for (int bj = 0; bj < 2; ++bj) { float* p = sl + (size_t)(ai * HALF + m * 16) * 4096 + bj * HALF; *(f32x4*)p = acc[ai][bj][m][0]; *(f32x4*)(p + 4) = acc[ai][bj][m][1]; } }
            }
            return;
        }
        const unsigned off0 = ((unsigned)row0 * 4096u + (unsigned)col0) * 2u;
        const char* hb = (const char*)H;
#pragma unroll
        for (int ai = 0; ai < 2; ++ai) {
            u32x4 old[4][2];
#pragma unroll
            for (int m = 0; m < 4; ++m)
#pragma unroll
                for (int bj = 0; bj < 2; ++bj) old[m][bj] = *(const u32x4*)(hb + (off0 + (unsigned)((ai * HALF + m * 16) * 4096 + bj * HALF) * 2u));
#pragma unroll
            for (int m = 0; m < 4; ++m) { const int row = row0 + ai * HALF + m * 16; float ss = 0.f;
#pragma unroll
                for (int bj = 0; bj < 2; ++bj) { const u32x4 o = old[m][bj];
                    f32x4 v0 = acc[ai][bj][m][0], v1 = acc[ai][bj][m][1];
                    v0[0] += __uint_as_float(o.x << 16); v0[1] += __uint_as_float(o.x & 0xffff0000u); v0[2] += __uint_as_float(o.y << 16); v0[3] += __uint_as_float(o.y & 0xffff0000u);
                    v1[0] += __uint_as_float(o.z << 16); v1[1] += __uint_as_float(o.z & 0xffff0000u); v1[2] += __uint_as_float(o.w << 16); v1[3] += __uint_as_float(o.w & 0xffff0000u);
                    ss += (v0[0] * v0[0] + v0[1] * v0[1]) + (v0[2] * v0[2] + v0[3] * v0[3]) + (v1[0] * v1[0] + v1[1] * v1[1]) + (v1[2] * v1[2] + v1[3] * v1[3]);
                    u32x4 w; w.x = cvt_pk_bf16(v0[0], v0[1]); w.y = cvt_pk_bf16(v0[2], v0[3]); w.z = cvt_pk_bf16(v1[0], v1[1]); w.w = cvt_pk_bf16(v1[2], v1[3]);
                    *(u32x4*)((char*)H + (off0 + (unsigned)((ai * HALF + m * 16) * 4096 + bj * HALF) * 2u)) = w; }
                ss += __shfl_xor(ss, 16); ss += __shfl_xor(ss, 32);
                if (fq == 0) SSQ[(size_t)row * 64 + u.pn * 4 + wc] = ss; }
        }
    }
};
typedef EpiResidT<false> EpiResid;
typedef EpiResidT<true> EpiResidB;

struct EpiResidN {
    static constexpr bool PERM = true, AFTER_DRAIN = false, KSCALE = true;
    EpiResid R; const float* CG;
    __device__ __forceinline__ void prep(const Unit& u, PG8_LAS float* tbl) const { kscale_prep(CG, u, tbl); }
    __device__ __forceinline__ void operator()(f32x4 (&acc)[2][2][4][2], const Unit& u, int, int, int, int, const PG8_LAS float* tbl) const {
        int tz = threadIdx.x; asm volatile("" : "+v"(tz)); const int wid = tz >> 6, lane = tz & 63, wr = wid >> 2, wc = wid & 3, fr = lane & 15, fq = lane >> 4;
        const int g = (u.pm >= M_MAIN_PANELS) ? (u.kt0 >> 4) : 7;
#pragma unroll
        for (int ai = 0; ai < 2; ++ai)
#pragma unroll
            for (int m = 0; m < 4; ++m) { const PG8_LAS float* tr = tbl + (ai * HALF + wr * 64 + m * 16 + fr) * 8; float c = tr[0];
                for (int k = 7; k > g; --k) c *= tr[k];
#pragma unroll
                for (int bj = 0; bj < 2; ++bj)
#pragma unroll
                    for (int n = 0; n < 2; ++n) acc[ai][bj][m][n] = acc[ai][bj][m][n] * c; }
        R(acc, u, wr, wc, fr, fq);
    }
};

template <class Epi, class Sched, bool ALIGN_EPI = false, bool SP2 = false>
__device__ __forceinline__ void gemm_phase(PG8_LAS unsigned char* lds, const Gemm g, const Sched& S, const Epi& E) {
    const int tid = threadIdx.x, wid = __builtin_amdgcn_readfirstlane(tid >> 6), lane = tid & 63, wr = wid >> 2, wc = wid & 3, fr = lane & 15, fq = lane >> 4;
    const int K = g.K;
    unsigned voffA, voffB;
    { int R, C; stage_rc(tid * 16, R, C); const int Rb = Epi::PERM ? ((R & ~31) + perm32(R & 31)) : R; voffA = (unsigned)(R * K + C) * 2u; voffB = (unsigned)(Rb * K + C) * 2u; }
    const size_t rstep = (size_t)64 * K * 2;
    const size_t kstep = (size_t)(BK * 2);
    const size_t hstep = (size_t)HALF * K * 2;
    const size_t tstep = 2 * hstep;
    const unsigned ldsw = (unsigned)wid * 1024u;
    const int aoff = lds_byte(wr * 64 + fr, fq * 8), boff = lds_byte(wc * 32 + fr, fq * 8);
#define PG8_SA(b, h) (((b) * 2 + (h)) * HTB)
#define PG8_SB(b, h) ((4 + (b) * 2 + (h)) * HTB)
#define PG8_STAGE(bufoff, gbase, voff) do { _Pragma("unroll") for (int _i = 0; _i < 2; ++_i) \
        __builtin_amdgcn_global_load_lds((const unsigned*)((const char*)(gbase) + (size_t)_i * rstep + (voff)), (PG8_LAS unsigned*)(lds + (bufoff) + ldsw + _i * 8192), 16, 0, 0); } while (0)
#define PG8_LDA(dst, b, h) do { _Pragma("unroll") for (int m = 0; m < 4; ++m) _Pragma("unroll") for (int k = 0; k < 2; ++k) dst[m][k] = *(const PG8_LAS bf16x8*)(lds + PG8_SA(b, h) + aoff + m * 2048 + k * 1024); } while (0)
#define PG8_LDB(dst, b, h) do { _Pragma("unroll") for (int n = 0; n < 2; ++n) _Pragma("unroll") for (int k = 0; k < 2; ++k) dst[n][k] = *(const PG8_LAS bf16x8*)(lds + PG8_SB(b, h) + boff + n * 2048 + k * 1024); } while (0)
#define PG8_MMA(ai, bj, At, Bt) do { __builtin_amdgcn_s_setprio(1); _Pragma("unroll") for (int m = 0; m < 4; ++m) _Pragma("unroll") for (int n = 0; n < 2; ++n) _Pragma("unroll") for (int k = 0; k < 2; ++k) \
        acc[ai][bj][m][n] = __builtin_amdgcn_mfma_f32_16x16x32_bf16(Bt[n][k], At[m][k], acc[ai][bj][m][n], 0, 0, 0); __builtin_amdgcn_s_setprio(0); } while (0)
#define PG8_WAIT_V(n) asm volatile("s_waitcnt vmcnt(" #n ")" ::: "memory")
#define PG8_WAIT_L(n) asm volatile("s_waitcnt lgkmcnt(" #n ")" ::: "memory")
#define PG8_BAR __builtin_amdgcn_s_barrier()
#define PG8_SCHED __builtin_amdgcn_sched_barrier(0)
    Unit cur, nxt; int ui = 0;
    if (!S.next(0, cur)) return;
    PG8_LAS float* const ktbl = (PG8_LAS float*)(lds + STAGE_BYTES);
    f32x4 acc[2][2][4][2];
#pragma unroll
    for (int a = 0; a < 2; ++a)
#pragma unroll
        for (int b = 0; b < 2; ++b)
#pragma unroll
            for (int m = 0; m < 4; ++m)
#pragma unroll
                for (int n = 0; n < 2; ++n) acc[a][b][m][n] = (f32x4){0.f, 0.f, 0.f, 0.f};
    bf16x8 At[4][2], B0[2][2], B1[2][2];
    const char* cA = (const char*)g.A + (size_t)cur.pm * tstep + (size_t)cur.kt0 * kstep; const char* cB = (const char*)g.Bt + (size_t)cur.pn * tstep + (size_t)cur.kt0 * kstep;
    S.a_ready(cur);
    if constexpr (Epi::KSCALE) E.prep(cur, ktbl);
    if constexpr (SP2) {
        PG8_STAGE(PG8_SB(0, 0), cB, voffB); PG8_STAGE(PG8_SB(0, 1), cB + hstep, voffB); PG8_STAGE(PG8_SA(0, 0), cA, voffA); PG8_STAGE(PG8_SA(0, 1), cA + hstep, voffA);
        if (wr == 1) PG8_BAR;
        PG8_WAIT_V(2); PG8_BAR;
        PG8_STAGE(PG8_SB(1, 0), cB + kstep, voffB); PG8_STAGE(PG8_SA(1, 0), cA + kstep, voffA); PG8_STAGE(PG8_SB(1, 1), cB + hstep + kstep, voffB);
        PG8_WAIT_V(6); PG8_BAR;
    } else {
        PG8_STAGE(PG8_SB(0, 0), cB, voffB); PG8_STAGE(PG8_SA(0, 0), cA, voffA); PG8_STAGE(PG8_SB(0, 1), cB + hstep, voffB); PG8_STAGE(PG8_SA(0, 1), cA + hstep, voffA);
        if (wr == 1) PG8_BAR;
        PG8_WAIT_V(4); PG8_BAR;
        PG8_STAGE(PG8_SB(1, 0), cB + kstep, voffB); PG8_STAGE(PG8_SA(1, 0), cA + kstep, voffA); PG8_STAGE(PG8_SB(1, 1), cB + hstep + kstep, voffB);
        PG8_WAIT_V(6); PG8_BAR;
    }
    for (;;) {
        const unsigned kclaim = S.fetch(ui);
        bool has_next = false; const char* nA = cA; const char* nB = cB;
        const int nt = cur.nkt;
        for (int t = 0; t < nt; t += 2) {
            const bool last = (t == nt - 2);
            if (t == (nt > 4 ? 2 : 0)) S.commit(ui, kclaim);
            if (last) { has_next = S.resolve(ui + 1, nxt);
                if (has_next) { nA = (const char*)g.A + (size_t)nxt.pm * tstep + (size_t)nxt.kt0 * kstep; nB = (const char*)g.Bt + (size_t)nxt.pn * tstep + (size_t)nxt.kt0 * kstep; } }
            const char* a1 = cA + (size_t)(t + 1) * kstep;
            const char* a2 = last ? nA : cA + (size_t)(t + 2) * kstep; const char* b2 = last ? nB : cB + (size_t)(t + 2) * kstep;
            const char* a3 = a2 + kstep; const char* b3 = b2 + kstep;
            if (last && has_next) S.a_ready(nxt);
            if constexpr (Epi::KSCALE) { const int kt = cur.kt0 + t; if (t > 0 && (kt & 15) == 0) kscale_step(acc, ktbl + (ui & 1) * 2048, kt >> 4, wr, fr); }
            if constexpr (SP2) {
            PG8_LDB(B0, 0, 0); PG8_LDB(B1, 0, 1); PG8_SCHED; PG8_LDA(At, 0, 0); PG8_STAGE(PG8_SA(1, 1), a1 + hstep, voffA);
            PG8_WAIT_V(8); PG8_WAIT_L(0); PG8_BAR; PG8_MMA(0, 0, At, B0); PG8_MMA(0, 1, At, B1); PG8_BAR; PG8_SCHED;
            PG8_LDA(At, 0, 1); PG8_STAGE(PG8_SB(0, 0), b2, voffB); PG8_STAGE(PG8_SB(0, 1), b2 + hstep, voffB); PG8_STAGE(PG8_SA(0, 0), a2, voffA);
            PG8_WAIT_V(8); PG8_WAIT_L(0); PG8_BAR; PG8_MMA(1, 0, At, B0); PG8_MMA(1, 1, At, B1); PG8_BAR; PG8_SCHED;
            PG8_LDB(B0, 1, 0); PG8_LDB(B1, 1, 1); PG8_SCHED; PG8_LDA(At, 1, 0); PG8_STAGE(PG8_SA(0, 1), a2 + hstep, voffA);
            PG8_WAIT_V(8); PG8_WAIT_L(0); PG8_BAR; PG8_MMA(0, 0, At, B0); PG8_MMA(0, 1, At, B1); PG8_BAR; PG8_SCHED;
            PG8_LDA(At, 1, 1); PG8_STAGE(PG8_SB(1, 0), b3, voffB); PG8_STAGE(PG8_SB(1, 1), b3 + hstep, voffB); PG8_STAGE(PG8_SA(1, 0), a3, voffA);
            PG8_WAIT_V(8); PG8_WAIT_L(0); PG8_BAR; PG8_MMA(1, 0, At, B0); PG8_MMA(1, 1, At, B1); PG8_BAR; PG8_SCHED;
            } else {
            PG8_LDB(B0, 0, 0); PG8_SCHED; PG8_LDA(At, 0, 0); PG8_STAGE(PG8_SA(1, 1), a1 + hstep, voffA);
            PG8_WAIT_L(8); PG8_BAR; PG8_WAIT_L(0); PG8_MMA(0, 0, At, B0); PG8_BAR; PG8_SCHED;
            PG8_LDB(B1, 0, 1); PG8_STAGE(PG8_SB(0, 0), b2, voffB);
            PG8_BAR; PG8_WAIT_L(0); PG8_MMA(0, 1, At, B1); PG8_BAR;
            PG8_LDA(At, 0, 1); PG8_STAGE(PG8_SA(0, 0), a2, voffA);
            PG8_BAR; PG8_WAIT_L(0); PG8_MMA(1, 0, At, B0); PG8_BAR; PG8_SCHED;
            PG8_STAGE(PG8_SB(0, 1), b2 + hstep, voffB);
            PG8_WAIT_V(6); PG8_BAR; PG8_MMA(1, 1, At, B1); PG8_BAR;
            PG8_LDB(B0, 1, 0); PG8_SCHED; PG8_LDA(At, 1, 0); PG8_STAGE(PG8_SA(0, 1), a2 + hstep, voffA);
            PG8_WAIT_L(8); PG8_BAR; PG8_WAIT_L(0); PG8_MMA(0, 0, At, B0); PG8_BAR; PG8_SCHED;
            PG8_LDB(B1, 1, 1); PG8_STAGE(PG8_SB(1, 0), b3, voffB);
            PG8_BAR; PG8_WAIT_L(0); PG8_MMA(0, 1, At, B1); PG8_BAR;
            PG8_LDA(At, 1, 1); PG8_STAGE(PG8_SA(1, 0), a3, voffA);
            PG8_BAR; PG8_WAIT_L(0); PG8_MMA(1, 0, At, B0); PG8_BAR; PG8_SCHED;
            PG8_STAGE(PG8_SB(1, 1), b3 + hstep, voffB);
            PG8_WAIT_V(6); PG8_BAR; PG8_MMA(1, 1, At, B1); PG8_BAR;
            }
        }
        if constexpr (ALIGN_EPI) { if (wr == 0) PG8_BAR; }
        if constexpr (Epi::KSCALE) { E(acc, cur, wr, wc, fr, fq, ktbl + (ui & 1) * 2048); if (has_next) E.prep(nxt, ktbl + ((ui + 1) & 1) * 2048); }
        else E(acc, cur, wr, wc, fr, fq);
        S.done(cur);
        if (!has_next) break;
#pragma unroll
        for (int a = 0; a < 2; ++a)
#pragma unroll
            for (int b = 0; b < 2; ++b)
#pragma unroll
                for (int m = 0; m < 4; ++m)
#pragma unroll
                    for (int n = 0; n < 2; ++n) acc[a][b][m][n] = (f32x4){0.f, 0.f, 0.f, 0.f};
        cur = nxt; cA = nA; cB = nB; ++ui;
        if constexpr (ALIGN_EPI) { if (wr == 1) PG8_BAR; }
    }
    PG8_WAIT_V(0);
    if constexpr (!ALIGN_EPI) { if (wr == 0) PG8_BAR; }
    PG8_BAR;
#undef PG8_SA
#undef PG8_SB
#undef PG8_STAGE
#undef PG8_LDA
#undef PG8_LDB
#undef PG8_MMA
#undef PG8_WAIT_V
#undef PG8_WAIT_L
#undef PG8_BAR
#undef PG8_SCHED
}
}

constexpr int D = 4096, DI = 8192, NH = 128, HD = 64, NG = 8, DS = 128, CONVD = 10240;
constexpr int SSD_PROJ = 18560, SSD_PROJ_PAD = 18688, SC_PROJ = 16384;
constexpr int NB = 4, SEQ = 4096, NMETA = 16, NSB = 8, LS = 16;
constexpr int ROW_META = 16384, ROW_SAMPLE = 16448, M_REAL = 16576, M_PAD = 16640, M_MAIN = 16384;
#ifndef G2_WGM
#define G2_WGM 2
#endif
constexpr int NSEG = 1036;
constexpr float EPS = 1e-5f;
constexpr int NWAVES = 8;

constexpr size_t MiB = 1u << 20;
constexpr size_t WS_CTL = 0, CTL_ZERO_BYTES = 1 * MiB;
constexpr size_t SZ_W_SSD_IN1 = (size_t)SSD_PROJ_PAD * D * 2, SZ_W_SSD_OUT1 = (size_t)D * DI * 2, SZ_W_SC_IN1 = (size_t)SC_PROJ * D * 2, SZ_W_SC_OUT1 = (size_t)D * D * 2;
constexpr size_t WS_W_SSD_IN = 1 * MiB;
constexpr size_t WS_W_SSD_OUT = WS_W_SSD_IN + 2 * SZ_W_SSD_IN1;
constexpr size_t WS_W_SC_IN = WS_W_SSD_OUT + 2 * SZ_W_SSD_OUT1;
constexpr size_t WS_W_SC_OUT = WS_W_SC_IN + 2 * SZ_W_SC_IN1;
constexpr size_t WS_H = WS_W_SC_OUT + 2 * SZ_W_SC_OUT1;
constexpr size_t WS_SSQ = WS_H + (size_t)M_PAD * D * 2;
constexpr size_t WS_PROJ = WS_SSQ + (size_t)M_PAD * 64 * 4;
constexpr size_t SZ_Z = (size_t)M_PAD * DI * 2, SZ_XBC = (size_t)M_PAD * CONVD * 2, SZ_DT = (size_t)M_PAD * NH * 4;
constexpr size_t WS_Z = WS_PROJ, WS_XBC = WS_Z + SZ_Z, WS_DTRAW = WS_XBC + SZ_XBC;
constexpr size_t WS_GC = WS_PROJ;
constexpr size_t WS_XACT = WS_DTRAW + SZ_DT;
constexpr size_t WS_YN = WS_XACT;
constexpr size_t WS_DT = WS_XACT + SZ_XBC;
constexpr size_t WS_Y = WS_DT + SZ_DT;
constexpr size_t WS_YSQ = WS_Y + SZ_Z;
constexpr size_t WS_RSTD = WS_YSQ + 4 * SZ_DT;
constexpr size_t WS_SLAB = WS_RSTD + (size_t)M_PAD * 4;
constexpr size_t WS_CG = WS_SLAB + (size_t)16 * 256 * 4096 * 4;
constexpr size_t WS_END = WS_CG + (size_t)M_PAD * 8 * 4;
static_assert((size_t)M_PAD * SC_PROJ * 2 <= SZ_Z + SZ_XBC + SZ_DT, "SC projection overlays the SSD projection region");
static_assert(WS_END % 256 == 0 && WS_XACT % 256 == 0 && WS_Y % 256 == 0, "alignment");
constexpr int CW_BAR = 4096;

constexpr size_t O_YP = 0, O_YS = O_YP + (size_t)NB * SEQ * D, O_SSM_P = O_YS + (size_t)NSB * LS * D, O_CONV_P = O_SSM_P + (size_t)2 * NB * NH * HD * DS,
                 O_SC_P = O_CONV_P + (size_t)2 * NB * 3 * CONVD, O_SSM_S = O_SC_P + (size_t)2 * NB * 2 * D, O_CONV_S = O_SSM_S + (size_t)2 * NSB * NH * HD * DS,
                 O_SC_S = O_CONV_S + (size_t)2 * NSB * 3 * CONVD, O_END = O_SC_S + (size_t)2 * NSB * 2 * D;

constexpr int RING_OFF = 0, RING_BYTES = 131072;
constexpr int LDS_BYTES = 163840;
constexpr int SMALL_OFF = 147456;
constexpr int LDSCTL_OFF = LDS_BYTES - 512, MISC_OFF = LDSCTL_OFF + 320;

#define GAS __attribute__((address_space(1)))
#define LAS __attribute__((address_space(3)))
typedef unsigned short bf16;
typedef unsigned v4u __attribute__((ext_vector_type(4)));
typedef unsigned v2u __attribute__((ext_vector_type(2)));
typedef float f32x4 __attribute__((ext_vector_type(4)));
typedef float f32x2 __attribute__((ext_vector_type(2)));
typedef GAS unsigned gu32;
#define RLX_AGENT __ATOMIC_RELAXED, __HIP_MEMORY_SCOPE_AGENT
#define LDS_WAIT() asm volatile("s_waitcnt lgkmcnt(0)" ::: "memory")
#define VM_WAIT() asm volatile("s_waitcnt vmcnt(0)" ::: "memory")
__device__ __forceinline__ unsigned pk2(float lo, float hi) { return pg8::cvt_pk_bf16(lo, hi); }
__device__ __forceinline__ float bflo(unsigned u) { return __uint_as_float(u << 16); }
__device__ __forceinline__ float bfhi(unsigned u) { return __uint_as_float(u & 0xffff0000u); }
__device__ __forceinline__ void unpack8(const v4u w, float (&f)[8]) { f[0] = bflo(w.x); f[1] = bfhi(w.x); f[2] = bflo(w.y); f[3] = bfhi(w.y); f[4] = bflo(w.z); f[5] = bfhi(w.z); f[6] = bflo(w.w); f[7] = bfhi(w.w); }
__device__ __forceinline__ v4u pack8(const float (&f)[8]) { v4u o; o.x = pk2(f[0], f[1]); o.y = pk2(f[2], f[3]); o.z = pk2(f[4], f[5]); o.w = pk2(f[6], f[7]); return o; }
__device__ __forceinline__ float silu_f(float x) { return x * __builtin_amdgcn_rcpf(1.f + __expf(-x)); }
__device__ __forceinline__ float softplus_f(float x) { return fmaxf(x, 0.f) + log1pf(__expf(-fabsf(x))); }

#define XB_TMO      128
#define XB_XCNT(j)  (256  + 64 * (j))
#define XB_XSUB(j)  (1280 + 64 * (j))
#define XB_XGEN(j)  (2304 + 64 * (j))
#define XB_TOP      3328
#define XB_TOPGEN   3392
#define XCD_BAR_WORDS 3456
#define XB_SPIN_CAP (1u << 18)
__device__ __forceinline__ unsigned xb_ld(unsigned* p)              { return __hip_atomic_load(p, __ATOMIC_RELAXED, __HIP_MEMORY_SCOPE_AGENT); }
__device__ __forceinline__ unsigned xb_add(unsigned* p, unsigned v) { return __hip_atomic_fetch_add(p, v, __ATOMIC_RELAXED, __HIP_MEMORY_SCOPE_AGENT); }
__device__ __forceinline__ unsigned xb_xcc_id() { return (unsigned)__builtin_amdgcn_s_getreg((3 << 11) | 20) & 0xFu; }
#define XB_SPIN(cond, bar) do { unsigned _sp = 0; while (cond) { __builtin_amdgcn_s_sleep(1); \
    if ((++_sp & 255u) == 0u) { if (xb_ld(&(bar)[XB_TMO])) break; if (_sp > XB_SPIN_CAP) { atomicAdd(&(bar)[XB_TMO], 1u); break; } } } } while (0)
struct XcdBarrier { unsigned* bar; unsigned x; volatile LAS unsigned* st; };
__device__ __forceinline__ XcdBarrier xcd_barrier_post(unsigned* bar, volatile LAS unsigned* st) {
    XcdBarrier b; b.bar = bar; b.x = xb_xcc_id(); b.st = st;
    if (threadIdx.x == 0) (void)xb_add(&bar[XB_XCNT(b.x)], 1u);
    return b;
}
__device__ __forceinline__ void xcd_barrier_complete(unsigned* bar, unsigned x, unsigned& nloc, unsigned& nx) {
    const unsigned G = gridDim.x * gridDim.y * gridDim.z;
    unsigned sum, cnt, mine, sp = 0u;
    for (;;) {
        sum = 0u; cnt = 0u; mine = 0u;
#pragma unroll
        for (unsigned j = 0; j < 16; ++j) { const unsigned c = xb_ld(&bar[XB_XCNT(j)]); sum += c; cnt += (c > 0u) ? 1u : 0u; mine = (j == x) ? c : mine; }
        if (sum == G) break;
        __builtin_amdgcn_s_sleep(1);
        if ((++sp & 255u) == 0u) { if (xb_ld(&bar[XB_TMO])) break; if (sp > XB_SPIN_CAP) { atomicAdd(&bar[XB_TMO], 1u); break; } }
    }
    nloc = mine > 0u ? mine : 1u; nx = cnt > 0u ? cnt : 1u;
}
__device__ __forceinline__ void xcd_barrier(const XcdBarrier& b) {
    asm volatile("s_waitcnt vmcnt(0)" ::: "memory");
    __syncthreads();
    if (threadIdx.x == 0) {
        unsigned* bar = b.bar;
        __builtin_amdgcn_s_waitcnt(0);
        unsigned nloc = b.st[0], nx = b.st[1];
        if (nloc == 0u) { xcd_barrier_complete(bar, b.x, nloc, nx); b.st[0] = nloc; b.st[1] = nx; }
        const unsigned old = xb_add(&bar[XB_XSUB(b.x)], 1u);
        const unsigned gen = old / nloc;
        if (old + 1u == (gen + 1u) * nloc) {
            __builtin_amdgcn_fence(__ATOMIC_RELEASE, "agent");
            asm volatile("s_waitcnt vmcnt(0)" ::: "memory");
            const unsigned og = xb_add(&bar[XB_TOP], 1u);
            const unsigned tg = og / nx;
            if (og + 1u == (tg + 1u) * nx) xb_add(&bar[XB_TOPGEN], 1u);
            else XB_SPIN(xb_ld(&bar[XB_TOPGEN]) == tg, bar);
            __builtin_amdgcn_fence(__ATOMIC_ACQUIRE, "agent");
            xb_add(&bar[XB_XGEN(b.x)], 1u);
            asm volatile("s_waitcnt vmcnt(0)" ::: "memory");
        } else {
            XB_SPIN(xb_ld(&bar[XB_XGEN(b.x)]) == gen, bar);
            __builtin_amdgcn_fence(__ATOMIC_ACQUIRE, "agent");
            asm volatile("s_waitcnt vmcnt(0)" ::: "memory");
        }
    }
    __syncthreads();
}

struct Args { const float* in[19]; float* out; unsigned char* ws; int ph_lo, ph_hi; };
struct Frame {
    LAS unsigned char* lds;
    int tid, lane, wave, vcu, G;
    GAS unsigned char* ws; GAS float* out;
};
template <class T> __device__ __forceinline__ GAS T* uni(T* p) { const unsigned long long v = (unsigned long long)p; const unsigned lo = __builtin_amdgcn_readfirstlane((unsigned)v), hi = __builtin_amdgcn_readfirstlane((unsigned)(v >> 32)); return (GAS T*)(((unsigned long long)hi << 32) | lo); }
__device__ __forceinline__ float wave_sum(float v) {
#pragma unroll
    for (int o = 1; o < 64; o <<= 1) v += __shfl_xor(v, o);
    return v;
}

__host__ __device__ __forceinline__ int sc_in_row(int wcol) { const int type = wcol >> 12, j = wcol & 4095, pn = j >> 6, jj = j & 63; return 256 * pn + 128 * (type >> 1) + 32 * (jj >> 4) + 8 * ((jj >> 2) & 3) + 4 * (type & 1) + (jj & 3); }
template <int SCPERM>
__device__ __forceinline__ void p0_transpose_item(const float* W, int K, int N, const float* ksc, bf16* WT, LAS float* scr, int item, int lane) {
    const int nblk = N / 32, kb = item / nblk, nb = item % nblk, k0 = 64 * kb, n0 = 32 * nb;
#pragma unroll
    for (int i = 0; i < 32; ++i) { const int kk = 2 * i + (lane >> 5); scr[kk * 33 + (lane & 31)] = __builtin_nontemporal_load(W + (size_t)(k0 + kk) * N + n0 + (lane & 31)) * ksc[k0 + kk]; }
    LDS_WAIT(); asm volatile("" ::: "memory");
    const int c = lane & 7;
#pragma unroll
    for (int j = 0; j < 4; ++j) { const int n = (lane >> 3) + 8 * j; const LAS float* s = scr + (8 * c) * 33 + n;
        v4u o; o.x = pk2(s[0 * 33], s[1 * 33]); o.y = pk2(s[2 * 33], s[3 * 33]); o.z = pk2(s[4 * 33], s[5 * 33]); o.w = pk2(s[6 * 33], s[7 * 33]);
        const int drow = SCPERM ? sc_in_row(n0 + n) : (n0 + n);
        __builtin_nontemporal_store(o, (v4u*)(WT + (size_t)drow * K + k0 + 8 * c)); }
    LDS_WAIT(); asm volatile("" ::: "memory");
}
constexpr int I_A = (D / 64) * (SSD_PROJ / 32), I_B = (DI / 64) * (D / 32), I_C = (D / 64) * (SC_PROJ / 32), I_D = (D / 64) * (D / 32), I_L = I_A + I_B + I_C + I_D;
constexpr int LATE0_BEGIN = I_L, LATE0_COUNT = 26000;
constexpr int LATE1_BEGIN = I_L + I_A, LATE1_COUNT = 26000;
static_assert(LATE0_COUNT <= I_A && LATE1_COUNT <= I_B + I_C, "late ranges");
__device__ __forceinline__ void p0_item(Frame& F, const Args& A, LAS float* scr, int it) {
    const int j = it / I_L; int r = it % I_L;
    if (r < I_A) { p0_transpose_item<0>(A.in[7] + (size_t)j * D * SSD_PROJ, D, SSD_PROJ, A.in[6] + (size_t)(2 * j) * D, (bf16*)(F.ws + WS_W_SSD_IN + j * SZ_W_SSD_IN1), scr, r, F.lane); return; } r -= I_A;
    if (r < I_B) { p0_transpose_item<0>(A.in[14] + (size_t)j * DI * D, DI, D, A.in[13] + (size_t)j * DI, (bf16*)(F.ws + WS_W_SSD_OUT + j * SZ_W_SSD_OUT1), scr, r, F.lane); return; } r -= I_B;
    if (r < I_C) { p0_transpose_item<1>(A.in[15] + (size_t)j * D * SC_PROJ, D, SC_PROJ, A.in[6] + (size_t)(2 * j + 1) * D, (bf16*)(F.ws + WS_W_SC_IN + j * SZ_W_SC_IN1), scr, r, F.lane); return; } r -= I_C;
    { const float* W = A.in[17] + (size_t)j * D * D; bf16* WT = (bf16*)(F.ws + WS_W_SC_OUT + j * SZ_W_SC_OUT1);
      const int nblk = D / 32, kb = r / nblk, nb = r % nblk, k0 = 64 * kb, n0 = 32 * nb; const int lane = F.lane;
#pragma unroll
      for (int i = 0; i < 32; ++i) { const int kk = 2 * i + (lane >> 5); scr[kk * 33 + (lane & 31)] = __builtin_nontemporal_load(W + (size_t)(k0 + kk) * D + n0 + (lane & 31)); }
      LDS_WAIT(); asm volatile("" ::: "memory");
      const int c = lane & 7;
#pragma unroll
      for (int jj = 0; jj < 4; ++jj) { const int n = (lane >> 3) + 8 * jj; const LAS float* s = scr + (8 * c) * 33 + n;
          v4u o; o.x = pk2(s[0 * 33], s[1 * 33]); o.y = pk2(s[2 * 33], s[3 * 33]); o.z = pk2(s[4 * 33], s[5 * 33]); o.w = pk2(s[6 * 33], s[7 * 33]);
          __builtin_nontemporal_store(o, (v4u*)(WT + (size_t)(n0 + n) * D + k0 + 8 * c)); }
      LDS_WAIT(); asm volatile("" ::: "memory"); }
}
__device__ __forceinline__ void late_convert(Frame& F, const Args& A, int begin, int count) {
    constexpr int NWG1 = (M_PAD / 256) * (SSD_PROJ_PAD / 256);
    const int rem = NWG1 % F.G, c = (int)blockIdx.x;
    LAS float* scr = (LAS float*)(F.lds + RING_OFF + F.wave * 16384);
    if (rem == 0) { const int gw = F.vcu * NWAVES + F.wave; for (int it = gw; it < count; it += F.G * NWAVES) p0_item(F, A, scr, begin + it); return; }
    if (c < rem) return;
    const int rank = (c - rem) * NWAVES + F.wave, nw = (F.G - rem) * NWAVES;
    for (int it = rank; it < count; it += nw) p0_item(F, A, scr, begin + it);
}
__device__ __forceinline__ void p0_prologue(Frame& F, const Args& A) {
    LAS float* scr = (LAS float*)(F.lds + RING_OFF + F.wave * 16384);
    const int gw = F.vcu * NWAVES + F.wave, NGW = F.G * NWAVES;
    constexpr int N_EARLY = 2 * I_L - LATE0_COUNT - LATE1_COUNT;
    for (int e = gw; e < N_EARLY; e += NGW) {
        int it = e; if (it >= LATE0_BEGIN) it += LATE0_COUNT; if (it >= LATE1_BEGIN) it += LATE1_COUNT;
        p0_item(F, A, scr, it);
    }
    { const size_t gt = (size_t)F.vcu * 512 + F.tid, GT = (size_t)F.G * 512;
      for (size_t i = gt; i < (size_t)2 * 128 * D / 8; i += GT) { const size_t j = i / (128 * D / 8), o = i % (128 * D / 8);
          *(v4u*)(F.ws + WS_W_SSD_IN + j * SZ_W_SSD_IN1 + (size_t)SSD_PROJ * D * 2 + o * 16) = (v4u){0u, 0u, 0u, 0u}; } }
    bf16* H = (bf16*)(F.ws + WS_H); float* SSQ = (float*)(F.ws + WS_SSQ);
    for (int m = gw; m < M_PAD; m += NGW) {
        const float* src = nullptr;
        if (m < ROW_META) src = A.in[0] + (size_t)m * D;
        else if (m < ROW_SAMPLE) src = A.in[5] + (size_t)((m - ROW_META) & 15) * D;
        else if (m < M_REAL) src = A.in[1] + (size_t)(m - ROW_SAMPLE) * D;
        float s = 0.f;
        f32x4 xa[8], xb[8];
#pragma unroll
        for (int jj = 0; jj < 8; ++jj) {
            if (src) { xa[jj] = __builtin_nontemporal_load((const f32x4*)(src + 8 * (64 * jj + F.lane))); xb[jj] = __builtin_nontemporal_load((const f32x4*)(src + 8 * (64 * jj + F.lane) + 4)); }
            else { xa[jj] = (f32x4){0.f, 0.f, 0.f, 0.f}; xb[jj] = xa[jj]; } }
#pragma unroll
        for (int jj = 0; jj < 8; ++jj) {
            const float f[8] = {xa[jj][0], xa[jj][1], xa[jj][2], xa[jj][3], xb[jj][0], xb[jj][1], xb[jj][2], xb[jj][3]};
#pragma unroll
            for (int e = 0; e < 8; ++e) s += f[e] * f[e];
            *(v4u*)(H + (size_t)m * D + 8 * (64 * jj + F.lane)) = pack8(f);
        }
        s = wave_sum(s);
        SSQ[(size_t)m * 64 + F.lane] = (F.lane == 0) ? s : 0.f;
        if (F.lane == 0) ((float*)(F.ws + WS_RSTD))[m] = rsqrtf(s * (1.f / D) + EPS);
    }
}

struct Seg { int row0, b, k, is_sample, is_last; };
__device__ __forceinline__ Seg seg_decode(int seg) {
    Seg s;
    if (seg < NB * 257) { s.b = seg / 257; s.k = seg % 257; s.is_sample = 0; s.is_last = (s.k == 256);
        s.row0 = (s.k == 0) ? ROW_META + 16 * s.b : s.b * SEQ + 16 * (s.k - 1); }
    else { s.b = seg - NB * 257; s.k = -1; s.is_sample = 1; s.is_last = 1; s.row0 = ROW_SAMPLE + 16 * s.b; }
    return s;
}
__device__ __forceinline__ int seg_halo(const Seg& s, int d) {
    if (s.is_sample || s.k == 0) return -1;
    if (s.k == 1) return ROW_META + 16 * s.b + 16 - d;
    return s.row0 - d;
}
__device__ __forceinline__ float row_rstd8(const float* SSQ, int row, int sub) {
    float s = 0.f;
    if (row >= 0) { const f32x4 a = *(const f32x4*)(SSQ + (size_t)row * 64 + sub * 8), b = *(const f32x4*)(SSQ + (size_t)row * 64 + sub * 8 + 4);
        s = (a[0] + a[1]) + (a[2] + a[3]) + (b[0] + b[1]) + (b[2] + b[3]); }
    s += __shfl_xor(s, 1); s += __shfl_xor(s, 2); s += __shfl_xor(s, 4);
    return row >= 0 ? rsqrtf(s * (1.f / D) + EPS) : 0.f;
}

__device__ __forceinline__ void ssd_conv_phase(Frame& F, const Args& A, int j) {
    const GAS unsigned char* XBCb = F.ws + WS_XBC; GAS unsigned char* XACTb = F.ws + WS_XACT;
    const float* DTRAW = (const float*)(F.ws + WS_DTRAW); float* DT = (float*)(F.ws + WS_DT); const float* RSTD = (const float*)(F.ws + WS_RSTD);
    const float* cw = A.in[8] + (size_t)j * 4 * CONVD; const float* cb = A.in[9] + (size_t)j * CONVD; const float* dtb = A.in[10] + (size_t)j * NH;
    const float* st_in = A.in[3] + (size_t)j * NSB * 3 * CONVD;
    const int NHW = 2 * F.G, hw = 2 * F.vcu + (F.wave >> 2), tl = F.tid & 255;
    const int hpart = hw % 5, rank = hw / 5, nranks = (NHW - hpart + 4) / 5;
    const int c0 = hpart * 2048 + tl * 8; const unsigned voff = (unsigned)c0 * 2u;
#define XBC_ROW(r) (__builtin_nontemporal_load((const GAS v4u*)(XBCb + (size_t)(r) * (CONVD * 2) + voff)))
    float w[4][8], bias[8];
#pragma unroll
    for (int k = 0; k < 4; ++k) { const f32x4 a = *(const f32x4*)(cw + (size_t)k * CONVD + c0), b = *(const f32x4*)(cw + (size_t)k * CONVD + c0 + 4);
        w[k][0] = a[0]; w[k][1] = a[1]; w[k][2] = a[2]; w[k][3] = a[3]; w[k][4] = b[0]; w[k][5] = b[1]; w[k][6] = b[2]; w[k][7] = b[3]; }
    { const f32x4 a = *(const f32x4*)(cb + c0), b = *(const f32x4*)(cb + c0 + 4); bias[0] = a[0]; bias[1] = a[1]; bias[2] = a[2]; bias[3] = a[3]; bias[4] = b[0]; bias[5] = b[1]; bias[6] = b[2]; bias[7] = b[3]; }
    for (int seg = rank; seg < NSEG; seg += nranks) {
        const Seg s = seg_decode(seg);
        float r3[8], r2[8], r1[8];
#pragma unroll
        for (int d = 3; d >= 1; --d) {
            float (&dst)[8] = (d == 3) ? r3 : (d == 2) ? r2 : r1;
            if (s.is_sample) { const float* p = st_in + ((size_t)s.b * 3 + (3 - d)) * CONVD + c0; const f32x4 a = *(const f32x4*)p, b = *(const f32x4*)(p + 4);
                dst[0] = a[0]; dst[1] = a[1]; dst[2] = a[2]; dst[3] = a[3]; dst[4] = b[0]; dst[5] = b[1]; dst[6] = b[2]; dst[7] = b[3]; }
            else { const int hr = seg_halo(s, d);
                if (hr >= 0) { unpack8(XBC_ROW(hr), dst); const float rs = RSTD[hr];
#pragma unroll
                    for (int e = 0; e < 8; ++e) dst[e] *= rs; }
                else {
#pragma unroll
                    for (int e = 0; e < 8; ++e) dst[e] = 0.f; } }
        }
        v4u rawv[16]; float rsv[16];
#pragma unroll
        for (int i = 0; i < 16; ++i) { rawv[i] = XBC_ROW(s.row0 + i); rsv[i] = RSTD[s.row0 + i]; }
#pragma unroll
        for (int i = 0; i < 16; ++i) {
            float cur[8], o[8]; unpack8(rawv[i], cur); const float rs = rsv[i];
#pragma unroll
            for (int e = 0; e < 8; ++e) { cur[e] *= rs; const float v = __builtin_fmaf(w[3][e], cur[e], __builtin_fmaf(w[2][e], r1[e], __builtin_fmaf(w[1][e], r2[e], __builtin_fmaf(w[0][e], r3[e], bias[e])))); o[e] = silu_f(v);
                r3[e] = r2[e]; r2[e] = r1[e]; r1[e] = cur[e]; }
            *(GAS v4u*)(XACTb + (size_t)(s.row0 + i) * (CONVD * 2) + voff) = pack8(o);
        }
        if (s.is_last) {
            GAS float* ob = F.out + (s.is_sample ? O_CONV_S + ((size_t)j * NSB + s.b) * 3 * CONVD : O_CONV_P + ((size_t)j * NB + s.b) * 3 * CONVD) + c0;
            *(GAS f32x4*)(ob) = (f32x4){r3[0], r3[1], r3[2], r3[3]}; *(GAS f32x4*)(ob + 4) = (f32x4){r3[4], r3[5], r3[6], r3[7]};
            *(GAS f32x4*)(ob + CONVD) = (f32x4){r2[0], r2[1], r2[2], r2[3]}; *(GAS f32x4*)(ob + CONVD + 4) = (f32x4){r2[4], r2[5], r2[6], r2[7]};
            *(GAS f32x4*)(ob + 2 * CONVD) = (f32x4){r1[0], r1[1], r1[2], r1[3]}; *(GAS f32x4*)(ob + 2 * CONVD + 4) = (f32x4){r1[4], r1[5], r1[6], r1[7]};
        }
    }
#undef XBC_ROW
    for (size_t i = (size_t)F.vcu * 512 + F.tid; i < (size_t)M_REAL * (NH / 8); i += (size_t)F.G * 512) { const size_t row = i >> 4; const int h0 = (int)(i & 15) * 8; const float rs = RSTD[row];
        const f32x4 a = *(const f32x4*)(DTRAW + row * NH + h0), b = *(const f32x4*)(DTRAW + row * NH + h0 + 4);
        const f32x4 ba = *(const f32x4*)(dtb + h0), bb = *(const f32x4*)(dtb + h0 + 4);
        f32x4 oa, ob;
#pragma unroll
        for (int e = 0; e < 4; ++e) { oa[e] = softplus_f(a[e] * rs + ba[e]); ob[e] = softplus_f(b[e] * rs + bb[e]); }
        *(f32x4*)(DT + row * NH + h0) = oa; *(f32x4*)(DT + row * NH + h0 + 4) = ob; }
}

typedef short s16x4 __attribute__((ext_vector_type(4)));
typedef short bf16x8 __attribute__((ext_vector_type(8)));
#define MFMA16(a, b, c) __builtin_amdgcn_mfma_f32_16x16x32_bf16((a), (b), (c), 0, 0, 0)
__device__ __forceinline__ bf16x8 frag_row(const LAS unsigned char* base, int stride, int row, int kbyte) { return *(const LAS bf16x8*)(base + row * stride + kbyte); }
__device__ __forceinline__ bf16x8 frag_tr(const LAS unsigned char* base, int stride, int k0, int c0, int lane) {
    const int g = lane >> 4, i16 = lane & 15, qq = i16 >> 2, pp = i16 & 3;
    const LAS unsigned char* p = base + (k0 + 8 * g + qq) * stride + (c0 + 4 * pp) * 2;
    const s16x4 lo = __builtin_amdgcn_ds_read_tr16_b64_v4i16((LAS s16x4*)p);
    const s16x4 hi = __builtin_amdgcn_ds_read_tr16_b64_v4i16((LAS s16x4*)(p + 4 * stride));
    return __builtin_shufflevector(lo, hi, 0, 1, 2, 3, 4, 5, 6, 7);
}
__device__ __forceinline__ float wave_prefix_sum_dpp(float x) {
    x += __builtin_bit_cast(float, __builtin_amdgcn_update_dpp(0, __builtin_bit_cast(int, x), 0x111, 0xf, 0xf, true));
    x += __builtin_bit_cast(float, __builtin_amdgcn_update_dpp(0, __builtin_bit_cast(int, x), 0x112, 0xf, 0xf, true));
    x += __builtin_bit_cast(float, __builtin_amdgcn_update_dpp(0, __builtin_bit_cast(int, x), 0x114, 0xf, 0xf, true));
    x += __builtin_bit_cast(float, __builtin_amdgcn_update_dpp(0, __builtin_bit_cast(int, x), 0x118, 0xf, 0xf, true));
    x += __builtin_bit_cast(float, __builtin_amdgcn_update_dpp(0, __builtin_bit_cast(int, x), 0x142, 0xa, 0xf, false));
    x += __builtin_bit_cast(float, __builtin_amdgcn_update_dpp(0, __builtin_bit_cast(int, x), 0x143, 0xc, 0xf, false));
    return x;
}
__device__ __forceinline__ void ssd_scan_phase(Frame& F, const Args& A, int j) {
    constexpr int S128 = 272, S64 = 144;
    constexpr int OFF_B = 0, OFF_C = 17408, OFF_XD = 34816, OFF_XE = 53248, OFF_L = 71680, OFF_H = 90112, OFF_XD2 = 124928;
    constexpr int SM_ACS = 0, SM_EA = 128, SM_DTD = 256, SM_DTE = 384, SM_ETOT = 512, SM_V = 520, SM_U = 648, SM_STRIDE = 1040;
#define LDS_BARRIER() do { asm volatile("s_waitcnt lgkmcnt(0)" ::: "memory"); __builtin_amdgcn_s_barrier(); asm volatile("" ::: "memory"); } while (0)
    LAS unsigned char* const L = F.lds;
    LAS float* const SM = (LAS float*)(F.lds + SMALL_OFF);
    const bf16* XACT = (const bf16*)(F.ws + WS_XACT); const float* DT = (const float*)(F.ws + WS_DT); bf16* Y = (bf16*)(F.ws + WS_Y);
    const bf16* Z = (const bf16*)(F.ws + WS_Z); float* YSQ = (float*)(F.ws + WS_YSQ);
    LAS float* const PS = SM + 2 * SM_STRIDE;
    const float* a_log = A.in[11] + (size_t)j * NH; const float* d_skip = A.in[12] + (size_t)j * NH;
    const int tid = F.tid, lane = F.lane, w = F.wave, hh = w >> 2, pt = w & 3, q = lane >> 4, l16 = lane & 15;
    for (int item = F.vcu; item < (NB + NSB) * 64; item += F.G) {
        const int is_sample = item >= NB * 64, idx = is_sample ? item - NB * 64 : item, b = idx >> 6, hp = idx & 63, nblocks = is_sample ? 1 : 65;
        const int head = 2 * hp + hh, g = hp >> 3;
        const float Dh = d_skip[head];
        const int sm_h = (w == 4) ? 1 : (w == 6) ? 0 : -1;
        const int head_s = 2 * hp + (sm_h > 0 ? 1 : 0); const float A_own = -__expf(a_log[head_s]);
        f32x4 hacc[8];
        if (is_sample) { const float* sp = A.in[2] + ((((size_t)j * NSB + b) * NH + head) * HD + 16 * pt + l16) * DS + 4 * q;
#pragma unroll
            for (int n8 = 0; n8 < 8; ++n8) hacc[n8] = *(const f32x4*)(sp + 16 * n8); }
        else {
#pragma unroll
            for (int n8 = 0; n8 < 8; ++n8) hacc[n8] = (f32x4){0.f, 0.f, 0.f, 0.f}; }
        v4u pbc[4], px[2];
        int row0 = is_sample ? ROW_SAMPLE + 16 * b : ROW_META + 16 * b, nt = 16;
#define SCAN_PREFETCH(r0_, nt_) do { \
            _Pragma("unroll") for (int k_ = 0; k_ < 4; ++k_) { const int i_ = tid + 512 * k_, mat_ = i_ >> 10, r_ = (i_ >> 4) & 63, c8_ = i_ & 15; \
                pbc[k_] = (r_ < (nt_)) ? *(const v4u*)(XACT + (size_t)((r0_) + r_) * CONVD + DI + mat_ * (NG * DS) + g * DS + c8_ * 8) : (v4u){0u, 0u, 0u, 0u}; } \
            _Pragma("unroll") for (int k_ = 0; k_ < 2; ++k_) { const int i_ = tid + 512 * k_, h2_ = i_ >> 9, r_ = (i_ >> 3) & 63, c8_ = i_ & 7; \
                px[k_] = (r_ < (nt_)) ? *(const v4u*)(XACT + (size_t)((r0_) + r_) * CONVD + (2 * hp + h2_) * HD + c8_ * 8) : (v4u){0u, 0u, 0u, 0u}; } } while (0)
#define SCAN_DTLOAD(r0_, nt_) ((sm_h >= 0 && lane < (nt_)) ? DT[(size_t)((r0_) + lane) * NH + head_s] : 0.f)
#define SCAN_SMALL(dtv_, par_) do { if (sm_h >= 0) { const int hh = sm_h; LAS float* sm_ = SM + (par_) * SM_STRIDE; \
            const float dt_ = (dtv_); float acs_ = dt_ * (A_own * 1.44269504f); \
            acs_ = wave_prefix_sum_dpp(acs_); \
            const float r0_ = __shfl(acs_, 15), r1_ = __shfl(acs_, 31), r2_ = __shfl(acs_, 47), atot_ = __shfl(acs_, 63); \
            const float myr_ = lane < 16 ? r0_ : lane < 32 ? r1_ : lane < 48 ? r2_ : atot_;              \
            sm_[SM_ACS + hh * 64 + lane] = acs_; sm_[SM_EA + hh * 64 + lane] = __builtin_amdgcn_exp2f(acs_); sm_[SM_DTD + hh * 64 + lane] = dt_; sm_[SM_DTE + hh * 64 + lane] = dt_ * __builtin_amdgcn_exp2f(atot_ - acs_); \
            sm_[SM_V + hh * 64 + lane] = dt_ * __builtin_amdgcn_exp2f(myr_ - acs_); \
            sm_[SM_U + hh * 192 + lane] = __builtin_amdgcn_exp2f(fminf(acs_ - r0_, 0.f)); sm_[SM_U + hh * 192 + 64 + lane] = __builtin_amdgcn_exp2f(fminf(acs_ - r1_, 0.f)); sm_[SM_U + hh * 192 + 128 + lane] = __builtin_amdgcn_exp2f(fminf(acs_ - r2_, 0.f)); \
            if (lane == 0) sm_[SM_ETOT + hh] = __builtin_amdgcn_exp2f(atot_); } } while (0)
#define SCAN_STAGE(par_) do { const LAS float* sm_ = SM + (par_) * SM_STRIDE; \
            _Pragma("unroll") for (int k_ = 0; k_ < 4; ++k_) { const int i_ = tid + 512 * k_, mat_ = i_ >> 10, r_ = (i_ >> 4) & 63, c8_ = i_ & 15; \
                *(LAS v4u*)(L + (mat_ ? OFF_C : OFF_B) + r_ * S128 + c8_ * 16) = pbc[k_]; } \
            _Pragma("unroll") for (int k_ = 0; k_ < 2; ++k_) { const int i_ = tid + 512 * k_, h2_ = i_ >> 9, r_ = (i_ >> 3) & 63, c8_ = i_ & 7; \
                float f_[8], e_[8]; unpack8(px[k_], f_); const float se_ = sm_[SM_DTE + h2_ * 64 + r_]; \
                _Pragma("unroll") for (int e2_ = 0; e2_ < 8; ++e2_) { e_[e2_] = f_[e2_] * se_; } \
                *(LAS v4u*)(L + ((par_) ? OFF_XD2 : OFF_XD) + h2_ * 64 * S64 + r_ * S64 + c8_ * 16) = px[k_]; *(LAS v4u*)(L + OFF_XE + h2_ * 64 * S64 + r_ * S64 + c8_ * 16) = pack8(e_); } } while (0)
#define SCAN_WRITE_HS() do { _Pragma("unroll") for (int n8 = 0; n8 < 8; ++n8) { v2u hw_; hw_.x = pk2(hacc[n8][0], hacc[n8][1]); hw_.y = pk2(hacc[n8][2], hacc[n8][3]); \
            *(LAS v2u*)(L + OFF_H + hh * 64 * S128 + (16 * pt + l16) * S128 + (16 * n8 + 4 * q) * 2) = hw_; } } while (0)
        LDS_BARRIER();
        { const float dt0 = SCAN_DTLOAD(row0, nt); SCAN_PREFETCH(row0, nt); SCAN_SMALL(dt0, 0); }
        float dtA = (nblocks > 1) ? SCAN_DTLOAD(b * SEQ, 64) : 0.f;
        LDS_BARRIER();
        SCAN_STAGE(0);
        SCAN_WRITE_HS();
        int row0p = row0, ntp = nt;
        for (int blk = 0; blk < nblocks; ++blk) {
            const int par = blk & 1; const LAS float* sm = SM + par * SM_STRIDE;
            const bool has_next = blk + 1 < nblocks; const int row0n = b * SEQ + 64 * blk, ntn = 64;
            LDS_BARRIER();
            if (has_next) { SCAN_PREFETCH(row0n, ntn); }
            const float dtB = (blk + 2 < nblocks) ? SCAN_DTLOAD(b * SEQ + 64 * (blk + 1), 64) : 0.f;
            if (blk > 0 && sm_h >= 0) { const float sq = (PS[(sm_h * 4 + 0) * 64 + lane] + PS[(sm_h * 4 + 1) * 64 + lane]) + (PS[(sm_h * 4 + 2) * 64 + lane] + PS[(sm_h * 4 + 3) * 64 + lane]);
                if (lane < ntp) YSQ[(size_t)(row0p + lane) * NH + head_s] = sq; }
            v2u ez[4];
#pragma unroll
            for (int jt = 0; jt < 4; ++jt) { const int t = 16 * jt + l16; const size_t row = (size_t)(row0 + (t < nt ? t : 0));
                ez[jt] = *(const v2u*)(Z + row * DI + head * HD + 16 * pt + 4 * q); }
            { const int it_ = w >> 1, jt0 = 2 * (w & 1);
              if (it_ <= jt0 + 1) {
                  f32x4 g0 = (f32x4){0.f, 0.f, 0.f, 0.f}, g1 = g0;
                  bf16x8 ga[4], gb1[4], gb0[4];
#pragma unroll
                  for (int ks = 0; ks < 4; ++ks) { const int kb = (32 * ks + 8 * q) * 2;
                      ga[ks] = frag_row(L + OFF_B, S128, 16 * it_ + l16, kb); gb1[ks] = frag_row(L + OFF_C, S128, 16 * (jt0 + 1) + l16, kb);
                      gb0[ks] = (it_ <= jt0) ? frag_row(L + OFF_C, S128, 16 * jt0 + l16, kb) : ga[ks]; }
                  __builtin_amdgcn_sched_barrier(0);
#pragma unroll
                  for (int ks = 0; ks < 4; ++ks) { g1 = MFMA16(ga[ks], gb1[ks], g1); if (it_ <= jt0) g0 = MFMA16(ga[ks], gb0[ks], g0); }
#pragma unroll
                  for (int h2 = 0; h2 < 2; ++h2) {
#pragma unroll
                      for (int x = 0; x < 2; ++x) { const int jt = jt0 + x, t = 16 * jt + l16; const f32x4 gg = x ? g1 : g0; float v[4];
                          if (it_ > jt) { v[0] = 0.f; v[1] = 0.f; v[2] = 0.f; v[3] = 0.f; }
                          else if (it_ == jt) { const f32x4 as = *(const LAS f32x4*)(sm + SM_ACS + h2 * 64 + 16 * it_ + 4 * q), ds = *(const LAS f32x4*)(sm + SM_DTD + h2 * 64 + 16 * it_ + 4 * q); const float at = sm[SM_ACS + h2 * 64 + t];
#pragma unroll
                              for (int r = 0; r < 4; ++r) { const int s_ = 16 * it_ + 4 * q + r; v[r] = (s_ <= t) ? gg[r] * (ds[r] * __builtin_amdgcn_exp2f(at - as[r])) : 0.f; } }
                          else { const f32x4 vs = *(const LAS f32x4*)(sm + SM_V + h2 * 64 + 16 * it_ + 4 * q); const float ut = sm[SM_U + h2 * 192 + it_ * 64 + t];
#pragma unroll
                              for (int r = 0; r < 4; ++r) v[r] = gg[r] * (ut * vs[r]); }
                          if (it_ <= jt || ((it_ & 1) && it_ == jt + 1)) { v2u lw; lw.x = pk2(v[0], v[1]); lw.y = pk2(v[2], v[3]);
                              *(LAS v2u*)(L + OFF_L + h2 * 64 * S64 + t * S64 + (16 * it_ + 4 * q) * 2) = lw; } } } } }
            f32x4 yacc[4];
#pragma unroll
            for (int jt = 0; jt < 4; ++jt) yacc[jt] = (f32x4){0.f, 0.f, 0.f, 0.f};
#pragma unroll
            for (int kh = 0; kh < 2; ++kh) {
                bf16x8 ia[2], ib[2][4];
#pragma unroll
                for (int k2 = 0; k2 < 2; ++k2) { const int kb = (32 * (2 * kh + k2) + 8 * q) * 2; ia[k2] = frag_row(L + OFF_H + hh * 64 * S128, S128, 16 * pt + l16, kb);
#pragma unroll
                    for (int jt = 0; jt < 4; ++jt) ib[k2][jt] = frag_row(L + OFF_C, S128, 16 * jt + l16, kb); }
                __builtin_amdgcn_sched_barrier(0);
#pragma unroll
                for (int k2 = 0; k2 < 2; ++k2)
#pragma unroll
                    for (int jt = 0; jt < 4; ++jt) yacc[jt] = MFMA16(ia[k2], ib[k2][jt], yacc[jt]);
                __builtin_amdgcn_sched_barrier(0); }
#pragma unroll
            for (int jt = 0; jt < 4; ++jt) { const float ea = sm[SM_EA + hh * 64 + 16 * jt + l16]; yacc[jt] = yacc[jt] * ea; }
            { const float etot = sm[SM_ETOT + hh];
#pragma unroll
              for (int n8 = 0; n8 < 8; ++n8) hacc[n8] = hacc[n8] * etot;
#pragma unroll
              for (int ks = 0; ks < 2; ++ks) { bf16x8 ha[8]; const bf16x8 bb = frag_tr(L + OFF_XE + hh * 64 * S64, S64, 32 * ks, 16 * pt, lane);
#pragma unroll
                  for (int n8 = 0; n8 < 8; ++n8) ha[n8] = frag_tr(L + OFF_B, S128, 32 * ks, 16 * n8, lane);
                  __builtin_amdgcn_sched_barrier(0);
#pragma unroll
                  for (int n8 = 0; n8 < 8; ++n8) hacc[n8] = MFMA16(ha[n8], bb, hacc[n8]);
                  __builtin_amdgcn_sched_barrier(0); } }
            if (has_next) { SCAN_SMALL(dtA, par ^ 1); }
            dtA = dtB;
            LDS_BARRIER();
            { bf16x8 xa[2], lb[2][4];
#pragma unroll
              for (int ks = 0; ks < 2; ++ks) { xa[ks] = frag_tr(L + (par ? OFF_XD2 : OFF_XD) + hh * 64 * S64, S64, 32 * ks, 16 * pt, lane); const int kb = (32 * ks + 8 * q) * 2;
#pragma unroll
                  for (int jt = 0; jt < 4; ++jt) { if (ks == 1 && jt < 2) { lb[ks][jt] = xa[ks]; continue; }
                      lb[ks][jt] = frag_row(L + OFF_L + hh * 64 * S64, S64, 16 * jt + l16, kb); } }
              __builtin_amdgcn_sched_barrier(0);
#pragma unroll
              for (int ks = 0; ks < 2; ++ks)
#pragma unroll
                  for (int jt = 0; jt < 4; ++jt) { if (ks == 1 && jt < 2) continue; yacc[jt] = MFMA16(xa[ks], lb[ks][jt], yacc[jt]); } }
            SCAN_WRITE_HS();
#pragma unroll
            for (int jt = 0; jt < 4; ++jt) { const int t = 16 * jt + l16;
                const v2u xv = *(const LAS v2u*)(L + (par ? OFF_XD2 : OFF_XD) + hh * 64 * S64 + t * S64 + (16 * pt + 4 * q) * 2);
                const float o0 = (yacc[jt][0] + Dh * bflo(xv.x)) * bflo(ez[jt].x), o1 = (yacc[jt][1] + Dh * bfhi(xv.x)) * bfhi(ez[jt].x);
                const float o2 = (yacc[jt][2] + Dh * bflo(xv.y)) * bflo(ez[jt].y), o3 = (yacc[jt][3] + Dh * bfhi(xv.y)) * bfhi(ez[jt].y);
                float ss = (o0 * o0 + o1 * o1) + (o2 * o2 + o3 * o3); ss += __shfl_xor(ss, 16); ss += __shfl_xor(ss, 32);
                if (q == 0) PS[(hh * 4 + pt) * 64 + t] = ss;
                if (t < nt) { v2u ow; ow.x = pk2(o0, o1); ow.y = pk2(o2, o3);
                    *(v2u*)(Y + (size_t)(row0 + t) * DI + head * HD + 16 * pt + 4 * q) = ow; } }
            if (has_next) { SCAN_STAGE(par ^ 1); }
            row0p = row0; ntp = nt; row0 = row0n; nt = ntn;
        }
        LDS_BARRIER();
        if (sm_h >= 0) { const float sq = (PS[(sm_h * 4 + 0) * 64 + lane] + PS[(sm_h * 4 + 1) * 64 + lane]) + (PS[(sm_h * 4 + 2) * 64 + lane] + PS[(sm_h * 4 + 3) * 64 + lane]);
            if (lane < ntp) YSQ[(size_t)(row0p + lane) * NH + head_s] = sq; }
        { GAS float* op = F.out + (is_sample ? O_SSM_S + ((((size_t)j * NSB + b) * NH + head) * HD + 16 * pt + l16) * DS : O_SSM_P + ((((size_t)j * NB + b) * NH + head) * HD + 16 * pt + l16) * DS) + 4 * q;
#pragma unroll
          for (int n8 = 0; n8 < 8; ++n8) *(GAS f32x4*)(op + 16 * n8) = hacc[n8]; }
#undef SCAN_PREFETCH
#undef SCAN_DTLOAD
#undef SCAN_SMALL
#undef SCAN_STAGE
#undef SCAN_WRITE_HS
    }
}

__device__ __forceinline__ void ssd_scale_phase(Frame& F) {
    const float* YSQ = (const float*)(F.ws + WS_YSQ); float* CG = (float*)(F.ws + WS_CG);
    const int gw = F.vcu * NWAVES + F.wave, NGW = F.G * NWAVES;
    for (int m0 = gw; m0 < M_PAD; m0 += 9 * NGW) { float sv[9];
#pragma unroll
        for (int i = 0; i < 9; ++i) { const int m = m0 + i * NGW; sv[i] = 0.f;
            if (m < M_REAL) { const f32x2 v = *(const f32x2*)(YSQ + (size_t)m * NH + 2 * F.lane); sv[i] = v[0] + v[1]; } }
#pragma unroll
        for (int i = 0; i < 9; ++i) { const int m = m0 + i * NGW; float sq = sv[i];
            sq += __shfl_xor(sq, 1); sq += __shfl_xor(sq, 2); sq += __shfl_xor(sq, 4);
            if (m < M_PAD && (F.lane & 7) == 0) CG[(size_t)m * 8 + (F.lane >> 3)] = rsqrtf(sq * (1.f / 1024.f) + EPS); }
    }
}

__device__ __forceinline__ void sc_tail_sum(const float* SLAB, int r, int type, int c0, float (&f)[8]) {
#pragma unroll
    for (int e = 0; e < 8; ++e) f[e] = 0.f;
#pragma unroll
    for (int k = 0; k < 4; ++k) { float t[8]; unpack8(*(const v4u*)((const bf16*)SLAB + (size_t)k * (256 * 16384) + (size_t)r * 16384 + type * 4096 + c0), t);
#pragma unroll
        for (int e = 0; e < 8; ++e) f[e] += t[e]; }
}
__device__ __forceinline__ void sc_elem_phase(Frame& F, const Args& A, int j) {
    const bf16* GC = (const bf16*)(F.ws + WS_GC); const float* SLAB = (const float*)(F.ws + WS_SLAB);
    bf16* Y = (bf16*)(F.ws + WS_Y); const float* RSTD = (const float*)(F.ws + WS_RSTD);
    const float* cw = A.in[16] + (size_t)j * 3 * D; const float* st_in = A.in[4] + (size_t)j * NSB * 2 * D;
    const int c0 = F.tid * 8;
    float w[3][8];
#pragma unroll
    for (int k = 0; k < 3; ++k) { const f32x4 a = *(const f32x4*)(cw + (size_t)k * D + c0), b = *(const f32x4*)(cw + (size_t)k * D + c0 + 4);
        w[k][0] = a[0]; w[k][1] = a[1]; w[k][2] = a[2]; w[k][3] = a[3]; w[k][4] = b[0]; w[k][5] = b[1]; w[k][6] = b[2]; w[k][7] = b[3]; }
    for (int r = F.vcu; r < 192; r += F.G) {
        const int row = ROW_META + r, i = r & 15; const bool samp = r >= 64; const int bs = samp ? (r - 64) >> 4 : 0;
        float r2[8], r1[8];
#pragma unroll
        for (int d = 2; d >= 1; --d) { float (&dst)[8] = (d == 2) ? r2 : r1;
            if (i >= d) { float cf[8], vf[8]; sc_tail_sum(SLAB, r - d, 2, c0, cf); sc_tail_sum(SLAB, r - d, 3, c0, vf); const float rs = RSTD[row - d], rs2 = rs * rs;
#pragma unroll
                for (int e = 0; e < 8; ++e) dst[e] = cf[e] * vf[e] * rs2; }
            else if (samp) { const float* p = st_in + ((size_t)bs * 2 + (2 + i - d)) * D + c0; const f32x4 a = *(const f32x4*)p, b = *(const f32x4*)(p + 4);
                dst[0] = a[0]; dst[1] = a[1]; dst[2] = a[2]; dst[3] = a[3]; dst[4] = b[0]; dst[5] = b[1]; dst[6] = b[2]; dst[7] = b[3]; }
            else {
#pragma unroll
                for (int e = 0; e < 8; ++e) dst[e] = 0.f; } }
        __builtin_amdgcn_sched_barrier(0);
        const float rs = RSTD[row], rs2 = rs * rs;
        float gf[8], bf[8], cf[8], vf[8], o[8], cv[8];
        sc_tail_sum(SLAB, r, 0, c0, gf); sc_tail_sum(SLAB, r, 1, c0, bf); sc_tail_sum(SLAB, r, 2, c0, cf); sc_tail_sum(SLAB, r, 3, c0, vf);
#pragma unroll
        for (int e = 0; e < 8; ++e) { cv[e] = cf[e] * vf[e] * rs2; const float conv = w[0][e] * r2[e] + w[1][e] * r1[e] + w[2][e] * cv[e];
            o[e] = silu_f(gf[e] * rs) * (bf[e] * rs) * conv; }
        *(v4u*)(Y + (size_t)row * D + c0) = pack8(o);
        if (samp && i == 15) {
            GAS float* ob = F.out + O_SC_S + ((size_t)j * NSB + bs) * 2 * D + c0;
            *(GAS f32x4*)(ob) = (f32x4){r1[0], r1[1], r1[2], r1[3]}; *(GAS f32x4*)(ob + 4) = (f32x4){r1[4], r1[5], r1[6], r1[7]};
            *(GAS f32x4*)(ob + D) = (f32x4){cv[0], cv[1], cv[2], cv[3]}; *(GAS f32x4*)(ob + D + 4) = (f32x4){cv[4], cv[5], cv[6], cv[7]}; }
        __builtin_amdgcn_sched_barrier(0);
    }
    for (int n = F.vcu; n < NB * 256; n += F.G) {
        const int b = n >> 8, k = (n & 255) + 1; const int row0 = b * SEQ + 16 * (k - 1);
        float r2[8], r1[8];
#pragma unroll
        for (int d = 2; d >= 1; --d) {
            float (&dst)[8] = (d == 2) ? r2 : r1;
            const int hr = (k == 1) ? ROW_META + 16 * b + 16 - d : row0 - d;
            if (hr >= ROW_META) { float cf[8], vf[8]; sc_tail_sum(SLAB, hr - ROW_META, 2, c0, cf); sc_tail_sum(SLAB, hr - ROW_META, 3, c0, vf); const float rs = RSTD[hr], rs2 = rs * rs;
#pragma unroll
                for (int e = 0; e < 8; ++e) dst[e] = cf[e] * vf[e] * rs2; }
            else { const v4u q0 = *(const v4u*)(GC + (size_t)hr * 8192 + 2 * c0), q1 = *(const v4u*)(GC + (size_t)hr * 8192 + 2 * c0 + 8);
                dst[0] = bflo(q0.z); dst[1] = bfhi(q0.z); dst[2] = bflo(q0.w); dst[3] = bfhi(q0.w); dst[4] = bflo(q1.z); dst[5] = bfhi(q1.z); dst[6] = bflo(q1.w); dst[7] = bfhi(q1.w); }
        }
        v4u q0v[16], q1v[16];
#pragma unroll
        for (int i = 0; i < 16; ++i) { const size_t off = (size_t)(row0 + i) * D + c0; q0v[i] = __builtin_nontemporal_load((const v4u*)(GC + 2 * off)); q1v[i] = __builtin_nontemporal_load((const v4u*)(GC + 2 * off + 8)); }
#pragma unroll
        for (int i = 0; i < 16; ++i) { const size_t off = (size_t)(row0 + i) * D + c0; const v4u q0 = q0v[i], q1 = q1v[i];
            const float gb[8] = {bflo(q0.x), bfhi(q0.x), bflo(q0.y), bfhi(q0.y), bflo(q1.x), bfhi(q1.x), bflo(q1.y), bfhi(q1.y)};
            const float cv[8] = {bflo(q0.z), bfhi(q0.z), bflo(q0.w), bfhi(q0.w), bflo(q1.z), bfhi(q1.z), bflo(q1.w), bfhi(q1.w)}; float o[8];
#pragma unroll
            for (int e = 0; e < 8; ++e) { o[e] = gb[e] * __builtin_fmaf(w[2][e], cv[e], __builtin_fmaf(w[1][e], r1[e], w[0][e] * r2[e])); r2[e] = r1[e]; r1[e] = cv[e]; }
            *(v4u*)(Y + off) = pack8(o); }
        if (k == 256) {
            GAS float* ob = F.out + O_SC_P + ((size_t)j * NB + b) * 2 * D + c0;
            *(GAS f32x4*)(ob) = (f32x4){r2[0], r2[1], r2[2], r2[3]}; *(GAS f32x4*)(ob + 4) = (f32x4){r2[4], r2[5], r2[6], r2[7]};
            *(GAS f32x4*)(ob + D) = (f32x4){r1[0], r1[1], r1[2], r1[3]}; *(GAS f32x4*)(ob + D + 4) = (f32x4){r1[4], r1[5], r1[6], r1[7]}; }
    }
}

__device__ __forceinline__ void final_phase(Frame& F, const Args& A) {
    const bf16* H = (const bf16*)(F.ws + WS_H); const float* RSTD = (const float*)(F.ws + WS_RSTD); const float* fw = A.in[18];
    const int gw = F.vcu * NWAVES + F.wave, NGW = F.G * NWAVES;
    for (int mm = gw; mm < NB * SEQ + NSB * LS; mm += NGW) {
        const int m = (mm < NB * SEQ) ? mm : mm + (ROW_SAMPLE - ROW_META);
        const float rs = RSTD[m];
        GAS float* orow = F.out + (size_t)mm * D;
        v4u hv[8];
#pragma unroll
        for (int jj = 0; jj < 8; ++jj) hv[jj] = __builtin_nontemporal_load((const v4u*)(H + (size_t)m * D + 8 * (64 * jj + F.lane)));
#pragma unroll
        for (int jj = 0; jj < 8; ++jj) { const int c = 8 * (64 * jj + F.lane); float f[8]; unpack8(hv[jj], f);
            const f32x4 wa = *(const f32x4*)(fw + c), wb = *(const f32x4*)(fw + c + 4);
            __builtin_nontemporal_store((f32x4){f[0] * rs * wa[0], f[1] * rs * wa[1], f[2] * rs * wa[2], f[3] * rs * wa[3]}, (GAS f32x4*)(orow + c));
            __builtin_nontemporal_store((f32x4){f[4] * rs * wb[0], f[5] * rs * wb[1], f[6] * rs * wb[2], f[7] * rs * wb[3]}, (GAS f32x4*)(orow + c + 4)); }
    }
}

template <bool BSLAB> __device__ __forceinline__ void tail_fixup_phase(Frame& F) {
    bf16* H = (bf16*)(F.ws + WS_H); float* SSQ = (float*)(F.ws + WS_SSQ); const float* SLAB = (const float*)(F.ws + WS_SLAB); float* RSTD = (float*)(F.ws + WS_RSTD);
    LAS float* red = (LAS float*)(F.lds + SMALL_OFF);
    for (int r = F.vcu; r < M_REAL - M_MAIN; r += F.G) {
        const int row = ROW_META + r; const int c = F.tid * 8;
        float f[8]; unpack8(*(const v4u*)(H + (size_t)row * D + c), f);
#pragma unroll
        for (int k = 0; k < 16; ++k) {
            if constexpr (BSLAB) { float t[8]; unpack8(*(const v4u*)((const bf16*)SLAB + (size_t)k * (256 * 4096) + (size_t)r * 4096 + c), t);
#pragma unroll
                for (int e = 0; e < 8; ++e) f[e] += t[e]; }
            else { const float* p = SLAB + (size_t)k * (256 * 4096) + (size_t)r * 4096 + c; const f32x4 a = *(const f32x4*)p, b = *(const f32x4*)(p + 4);
                f[0] += a[0]; f[1] += a[1]; f[2] += a[2]; f[3] += a[3]; f[4] += b[0]; f[5] += b[1]; f[6] += b[2]; f[7] += b[3]; } }
        float ss = 0.f;
#pragma unroll
        for (int e = 0; e < 8; ++e) ss += f[e] * f[e];
        *(v4u*)(H + (size_t)row * D + c) = pack8(f);
        ss = wave_sum(ss);
        __syncthreads();
        if (F.lane == 0) red[F.wave] = ss;
        __syncthreads();
        if (F.tid < 64) { float t = 0.f;
#pragma unroll
            for (int k = 0; k < NWAVES; ++k) t += red[k];
            SSQ[(size_t)row * 64 + F.tid] = (F.tid == 0) ? t : 0.f; if (F.tid == 0) RSTD[row] = rsqrtf(t * (1.f / D) + EPS); }
    }
    { const int gw = F.vcu * NWAVES + F.wave, NGW = F.G * NWAVES;
      for (int m0 = gw; m0 < M_MAIN; m0 += 8 * NGW) { float v[8];
#pragma unroll
          for (int i = 0; i < 8; ++i) { const int m = m0 + i * NGW; v[i] = (m < M_MAIN) ? SSQ[(size_t)m * 64 + F.lane] : 0.f; }
#pragma unroll
          for (int i = 0; i < 8; ++i) { const int m = m0 + i * NGW; const float t = wave_sum(v[i]); if (m < M_MAIN && F.lane == 0) RSTD[m] = rsqrtf(t * (1.f / D) + EPS); } } }
}

enum { T_PRO = 0, T_G1 = 1, T_CONV = 2, T_SCAN = 3, T_NORM = 4, T_G2 = 5, T_FIX2 = 6, T_G3 = 7, T_SCE = 8, T_G4 = 9, T_FIX4 = 10, T_FIN = 11 };
constexpr int N_PHASES = 22;
#ifndef PROBE_TYPES
#define PROBE_TYPES 0
#endif
#define REPS(T) (((PROBE_TYPES >> (T)) & 1) ? 2 : 1)

__global__ void __launch_bounds__(NWAVES * 64, 2) trunk_fwd(Args args) {
    extern __shared__ __attribute__((aligned(16))) unsigned char lds[];
    Frame F;
    F.lds = (LAS unsigned char*)lds;
    F.tid = threadIdx.x; F.lane = F.tid & 63; F.wave = __builtin_amdgcn_readfirstlane(F.tid >> 6);
    F.G = gridDim.x; { const int bx = blockIdx.x; F.vcu = (F.G % 8 == 0) ? (bx % 8) * (F.G / 8) + bx / 8 : bx; }
    const Args& A = args;
    F.ws = uni(args.ws); F.out = uni(args.out);
    for (int u = F.tid; u < (LDS_BYTES - LDSCTL_OFF) / 4; u += NWAVES * 64) ((LAS unsigned*)(F.lds + LDSCTL_OFF))[u] = 0u;
    __syncthreads();
    XcdBarrier bar; bar.bar = (unsigned*)(F.ws + WS_CTL) + CW_BAR; bar.x = 0; bar.st = nullptr;
    const int lo = args.ph_lo, hi = args.ph_hi;
    if (hi - lo > 1) bar = xcd_barrier_post((unsigned*)(F.ws + WS_CTL) + CW_BAR, (volatile LAS unsigned*)(F.lds + MISC_OFF) + 8);
#ifndef PH_OFF
#define PH_OFF(k) 0
#endif
#define IN(k) (!PH_OFF(k) && lo <= (k) && (k) < hi)
#define SEAM(k) do { if (IN(k) && IN((k) + 1)) xcd_barrier(bar); } while (0)

    if (IN(0)) { for (int rep = 0; rep < REPS(T_PRO); ++rep) p0_prologue(F, A); } SEAM(0);

#define LAYER_PAIR(lp) do {\
        const int pb = 1 + 10 * lp;\
        if (IN(pb + 0)) {\
            pg8::Gemm g{(const pg8::bf16_t*)(F.ws + WS_H), (const pg8::bf16_t*)(F.ws + WS_W_SSD_IN + lp * SZ_W_SSD_IN1), M_PAD, SSD_PROJ_PAD, D};\
            pg8::StaticOrder S; S.init(M_PAD, SSD_PROJ_PAD, D, F.G, (int)blockIdx.x);\
            pg8::EpiSsdIn E{(pg8::bf16_t*)(F.ws + WS_Z), (pg8::bf16_t*)(F.ws + WS_XBC), (float*)(F.ws + WS_DTRAW), (const float*)(F.ws + WS_RSTD)};\
            pg8::gemm_phase<pg8::EpiSsdIn, pg8::StaticOrder, true, true>(F.lds + RING_OFF, g, S, E);\
            if (REPS(T_G1) > 1) { pg8::EpiNone E0; pg8::gemm_phase<pg8::EpiNone, pg8::StaticOrder, true, true>(F.lds + RING_OFF, g, S, E0); }\
            late_convert(F, A, lp == 0 ? LATE0_BEGIN : LATE1_BEGIN, lp == 0 ? LATE0_COUNT : LATE1_COUNT);\
        } SEAM(pb + 0);\
        if (IN(pb + 1)) { for (int rep = 0; rep < REPS(T_CONV); ++rep) ssd_conv_phase(F, A, lp); } SEAM(pb + 1);\
        if (IN(pb + 2)) { for (int rep = 0; rep < REPS(T_SCAN); ++rep) ssd_scan_phase(F, A, lp); } SEAM(pb + 2);\
        if (IN(pb + 3)) { ssd_scale_phase(F); } SEAM(pb + 3);\
        if (IN(pb + 4)) {\
            pg8::Gemm g{(const pg8::bf16_t*)(F.ws + WS_Y), (const pg8::bf16_t*)(F.ws + WS_W_SSD_OUT + lp * SZ_W_SSD_OUT1), M_MAIN, D, DI};\
            pg8::TailSplitOrder S; S.init(M_MAIN, D, DI, F.G, (int)blockIdx.x); S.KS = 16; S.wgm = G2_WGM;\
            pg8::EpiResidN E{pg8::EpiResid{(pg8::bf16_t*)(F.ws + WS_H), (float*)(F.ws + WS_SSQ), (float*)(F.ws + WS_SLAB)}, (const float*)(F.ws + WS_CG)};\
            pg8::gemm_phase<pg8::EpiResidN, pg8::TailSplitOrder, true, true>(F.lds + RING_OFF, g, S, E);\
        } SEAM(pb + 4);\
        if (IN(pb + 5)) { tail_fixup_phase<false>(F); } SEAM(pb + 5);\
        if (IN(pb + 6)) {\
            pg8::Gemm g{(const pg8::bf16_t*)(F.ws + WS_H), (const pg8::bf16_t*)(F.ws + WS_W_SC_IN + lp * SZ_W_SC_IN1), M_MAIN, SC_PROJ, D};\
            pg8::TailSplitOrder S; S.init(M_MAIN, SC_PROJ, D, F.G, (int)blockIdx.x); S.KS = 4;\
            pg8::EpiScIn E{(pg8::bf16_t*)(F.ws + WS_GC), (const float*)(F.ws + WS_RSTD), (float*)(F.ws + WS_SLAB)};\
            if (REPS(T_G3) > 1) { pg8::EpiNone E0; pg8::gemm_phase<pg8::EpiNone, pg8::TailSplitOrder, true, true>(F.lds + RING_OFF, g, S, E0); }\
            pg8::gemm_phase<pg8::EpiScIn, pg8::TailSplitOrder, true, true>(F.lds + RING_OFF, g, S, E);\
        } SEAM(pb + 6);\
        if (IN(pb + 7)) { for (int rep = 0; rep < REPS(T_SCE); ++rep) sc_elem_phase(F, A, lp); } SEAM(pb + 7);\
        if (IN(pb + 8)) {\
            pg8::Gemm g{(const pg8::bf16_t*)(F.ws + WS_Y), (const pg8::bf16_t*)(F.ws + WS_W_SC_OUT + lp * SZ_W_SC_OUT1), M_MAIN, D, D};\
            pg8::TailSplitOrder S; S.init(M_MAIN, D, D, F.G, (int)blockIdx.x); S.KS = 16; S.wgm = 4;\
            pg8::EpiResidB E{(pg8::bf16_t*)(F.ws + WS_H), (float*)(F.ws + WS_SSQ), (float*)(F.ws + WS_SLAB)};\
            if (REPS(T_G4) > 1) { pg8::EpiNone E0; pg8::gemm_phase<pg8::EpiNone, pg8::TailSplitOrder, true, true>(F.lds + RING_OFF, g, S, E0); }\
            pg8::gemm_phase<pg8::EpiResidB, pg8::TailSplitOrder, true, true>(F.lds + RING_OFF, g, S, E);\
        } SEAM(pb + 8);\
        if (IN(pb + 9)) { tail_fixup_phase<true>(F); } SEAM(pb + 9);\
    } while (0)
    LAYER_PAIR(0);
    LAYER_PAIR(1);
#undef LAYER_PAIR
    if (IN(21)) { for (int rep = 0; rep < REPS(T_FIN); ++rep) final_phase(F, A); }
#undef IN
#undef SEAM
}

extern "C" void kernel_launch(void* const* d_in, const int* in_sizes, int n_in, void* d_out, int out_size, void* d_ws, size_t ws_size, hipStream_t stream) {
    static int grid = 0;
    if (grid == 0) {
        if (n_in != 19 || (size_t)out_size != O_END || ws_size < WS_END) { fprintf(stderr, "kernel_launch: unexpected shapes: n_in %d out %d ws %zu (need %zu)\n", n_in, out_size, ws_size, (size_t)WS_END); grid = -1; return; }
        int dev = 0, cus = 0, per_cu = 0;
        if (hipGetDevice(&dev) != hipSuccess || hipDeviceGetAttribute(&cus, hipDeviceAttributeMultiprocessorCount, dev) != hipSuccess) { grid = -1; return; }
        if (hipFuncSetAttribute((const void*)trunk_fwd, hipFuncAttributeMaxDynamicSharedMemorySize, LDS_BYTES) != hipSuccess) { fprintf(stderr, "kernel_launch: hipFuncSetAttribute failed\n"); grid = -1; return; }
        if (hipOccupancyMaxActiveBlocksPerMultiprocessor(&per_cu, (const void*)trunk_fwd, NWAVES * 64, LDS_BYTES) != hipSuccess || per_cu < 1)
            fprintf(stderr, "kernel_launch: occupancy query reports %d workgroups per CU\n", per_cu);
        (void)hipGetLastError();
        grid = cus;
    }
    if (grid < 0) return;
    if (hipMemsetAsync((char*)d_ws + WS_CTL, 0, CTL_ZERO_BYTES, stream) != hipSuccess) return;
    Args a{};
    for (int i = 0; i < 19; ++i) a.in[i] = (const float*)d_in[i];
    a.out = (float*)d_out; a.ws = (unsigned char*)d_ws;
#if MK_N_LAUNCHES == 1
    a.ph_lo = 0; a.ph_hi = N_PHASES;
    hipLaunchKernelGGL(trunk_fwd, dim3(grid), dim3(NWAVES * 64), LDS_BYTES, stream, a);
#else
    for (int ph = 0; ph < N_PHASES; ++ph) { a.ph_lo = ph; a.ph_hi = ph + 1; hipLaunchKernelGGL(trunk_fwd, dim3(grid), dim3(NWAVES * 64), LDS_BYTES, stream, a); }
#endif
}
```
